# Optimizing an MI355X kernel written in HIP

```python
import jax, jax.numpy as jnp
from jax import lax
import numpy as np

D_MODEL = 1024
BATCH = 4
SEQ = 8192
DEPTH = 2

HEAD_DIM = 64
N_MIXERS = 2
MOBA_HEADS = 16
MOBA_BLOCK = 256
MOBA_TOPK = 3
MOBA_Q_CHUNK = 32
DIL_GROUPS = ((128, 1), (512, 4), (2048, 16))
DIL_HEADS_PER_GROUP = 4
DIL_HEADS = DIL_HEADS_PER_GROUP * len(DIL_GROUPS)
DIL_BLOCK = 128
D_FF = 4 * D_MODEL
ROPE_THETA = 10000.0
LN_EPS = 1e-5
DEEPNORM_ALPHA = (2.0 * DEPTH) ** 0.25
DEEPNORM_BETA = (8.0 * DEPTH) ** -0.25
N_LAYERS_A = (DEPTH + N_MIXERS - 1) // N_MIXERS
N_LAYERS_B = DEPTH // N_MIXERS

kernel_name = "hybrid_moba_dilated_sqrelu_deepnorm"


def layer_norm(x, g, b):
    xf = x.astype(jnp.float32)
    mu = jnp.mean(xf, axis=-1, keepdims=True)
    var = jnp.mean(jnp.square(xf - mu), axis=-1, keepdims=True)
    y = (xf - mu) * lax.rsqrt(var + LN_EPS)
    return (y * g.astype(jnp.float32) + b.astype(jnp.float32)).astype(x.dtype)


def rotary_tables(seq, dtype):
    inv = 1.0 / (ROPE_THETA ** (jnp.arange(0, HEAD_DIM, 2, dtype=jnp.float32) / HEAD_DIM))
    ang = jnp.arange(seq, dtype=jnp.float32)[:, None] * inv[None, :]
    return jnp.cos(ang).astype(dtype), jnp.sin(ang).astype(dtype)


def apply_rotary(t, cos, sin):
    t1, t2 = jnp.split(t, 2, axis=-1)
    c = cos[None, :, None, :]
    s = sin[None, :, None, :]
    return jnp.concatenate([t1 * c - t2 * s, t2 * c + t1 * s], axis=-1)


def moba_attention(x, w_qkv, w_o, cos, sin):
    B, S, _ = x.shape
    H, dh, BLK, QC = MOBA_HEADS, HEAD_DIM, MOBA_BLOCK, MOBA_Q_CHUNK
    qkv = (x @ w_qkv).reshape(B, S, 3, H, dh)
    q = apply_rotary(qkv[:, :, 0], cos, sin) * (dh ** -0.5)
    k = apply_rotary(qkv[:, :, 1], cos, sin)
    v = qkv[:, :, 2]
    pad = (-S) % BLK
    Sp = S + pad
    nb = Sp // BLK
    padw = ((0, 0), (0, pad), (0, 0), (0, 0))
    q = jnp.pad(q, padw).transpose(0, 2, 1, 3)
    k = jnp.pad(k, padw).transpose(0, 2, 1, 3)
    v = jnp.pad(v, padw).transpose(0, 2, 1, 3)
    k_blk = k.reshape(B, H, nb, BLK, dh)
    v_blk = v.reshape(B, H, nb, BLK, dh)
    k_mean = jnp.mean(k_blk.astype(jnp.float32), axis=3).astype(k.dtype)

    gate = jnp.einsum('bhsd,bhnd->bhsn', q, k_mean).astype(jnp.float32)
    q_block = jnp.arange(Sp) // BLK
    past = jnp.arange(nb)[None, :] < q_block[:, None]
    gate = jnp.where(past[None, None], gate, -jnp.inf)
    kk = min(MOBA_TOPK, nb)
    sel_score, sel_idx = lax.top_k(gate, kk)
    sel_valid = jnp.isfinite(sel_score)

    nc = Sp // QC
    q_c = q.reshape(B, H, nc, QC, dh).transpose(2, 0, 1, 3, 4)
    idx_c = sel_idx.reshape(B, H, nc, QC, kk).transpose(2, 0, 1, 3, 4)
    val_c = sel_valid.reshape(B, H, nc, QC, kk).transpose(2, 0, 1, 3, 4)
    b_ix = jnp.arange(B)[:, None, None, None]
    h_ix = jnp.arange(H)[None, :, None, None]
    key_off = jnp.arange(BLK)

    def one_chunk(args):
        c, qc, idx, valid = args
        kg = k_blk[b_ix, h_ix, idx]
        vg = v_blk[b_ix, h_ix, idx]
        s_past = jnp.einsum('bhqd,bhqnkd->bhqnk', qc, kg).astype(jnp.float32)
        s_past = jnp.where(valid[..., None], s_past, -jnp.inf).reshape(B, H, QC, kk * BLK)
        start = c * QC
        blk = start // BLK
        k_own = lax.dynamic_index_in_dim(k_blk, blk, axis=2, keepdims=False)
        v_own = lax.dynamic_index_in_dim(v_blk, blk, axis=2, keepdims=False)
        s_own = jnp.einsum('bhqd,bhkd->bhqk', qc, k_own).astype(jnp.float32)
        q_off = start % BLK + jnp.arange(QC)
        causal = key_off[None, :] <= q_off[:, None]
        s_own = jnp.where(causal[None, None], s_own, -jnp.inf)
        p = jax.nn.softmax(jnp.concatenate([s_past, s_own], axis=-1), axis=-1).astype(v.dtype)
        p_past = p[..., :kk * BLK].reshape(B, H, QC, kk, BLK)
        p_own = p[..., kk * BLK:]
        return (jnp.einsum('bhqnk,bhqnkd->bhqd', p_past, vg)
                + jnp.einsum('bhqk,bhkd->bhqd', p_own, v_own))

    out = lax.map(one_chunk, (jnp.arange(nc, dtype=jnp.int32), q_c, idx_c, val_c))
    out = out.transpose(1, 0, 3, 2, 4).reshape(B, Sp, H * dh)[:, :S]
    return out @ w_o


def dilated_group(q, k, v, window, dilation):
    B, S, Hg, dh = q.shape
    span = window // dilation
    WB = DIL_BLOCK
    assert span <= WB
    L = S // dilation
    Lp = -(-L // WB) * WB
    nblk = Lp // WB

    def to_blocks(t):
        t = t.reshape(B, L, dilation, Hg, dh).transpose(0, 2, 1, 3, 4)
        t = jnp.pad(t, ((0, 0), (0, 0), (0, Lp - L), (0, 0), (0, 0)))
        return t.reshape(B, dilation, nblk, WB, Hg, dh)

    def with_prev(t):
        prev = jnp.pad(t, ((0, 0), (0, 0), (1, 0), (0, 0), (0, 0), (0, 0)))[:, :, :-1]
        return jnp.concatenate([prev, t], axis=3)

    qb = to_blocks(q)
    kw = with_prev(to_blocks(k))
    vw = with_prev(to_blocks(v))
    s = jnp.einsum('brnqhd,brnkhd->brnhqk', qb, kw).astype(jnp.float32)
    qi = jnp.arange(nblk)[:, None, None] * WB + jnp.arange(WB)[None, :, None]
    ki = jnp.arange(nblk)[:, None, None] * WB - WB + jnp.arange(2 * WB)[None, None, :]
    dist = qi - ki
    mask = (dist >= 0) & (dist <= span) & (ki >= 0)
    s = jnp.where(mask[None, None, :, None], s, -jnp.inf)
    lse = jax.nn.logsumexp(s, axis=-1)
    p = jnp.exp(s - lse[..., None]).astype(v.dtype)
    o = jnp.einsum('brnhqk,brnkhd->brnqhd', p, vw)
    o = o.reshape(B, dilation, Lp, Hg, dh)[:, :, :L].transpose(0, 2, 1, 3, 4).reshape(B, S, Hg, dh)
    lse = lse.transpose(0, 1, 2, 4, 3).reshape(B, dilation, Lp, Hg)[:, :, :L]
    lse = lse.transpose(0, 2, 1, 3).reshape(B, S, Hg)
    return o, lse


def dilated_attention(x, w_qkv, w_o, cos, sin):
    B, S, _ = x.shape
    G, Hg, dh = len(DIL_GROUPS), DIL_HEADS_PER_GROUP, HEAD_DIM
    qkv = (x @ w_qkv).reshape(B, S, 3, DIL_HEADS, dh)
    q = apply_rotary(qkv[:, :, 0], cos, sin) * (dh ** -0.5)
    k = apply_rotary(qkv[:, :, 1], cos, sin)
    v = qkv[:, :, 2]
    outs, lses = [], []
    for g, (window, dilation) in enumerate(DIL_GROUPS):
        hs = slice(g * Hg, (g + 1) * Hg)
        o_g, lse_g = dilated_group(q[:, :, hs], k[:, :, hs], v[:, :, hs], window, dilation)
        outs.append(o_g)
        lses.append(lse_g)
    alpha = jax.nn.softmax(jnp.stack(lses, axis=0), axis=0).astype(x.dtype)
    o = jnp.stack(outs, axis=0) * alpha[..., None]
    o = o.transpose(1, 2, 0, 3, 4).reshape(B, S, G * Hg * dh)
    return o @ w_o


def sq_relu_mlp(x, w_in, w_out):
    return jnp.square(jax.nn.relu(x @ w_in)) @ w_out


def setup_inputs(seed: int = 0) -> dict:
    key = jax.random.key(seed)
    ks = jax.random.split(key, 12)
    f32 = jnp.float32
    moba_w = MOBA_HEADS * HEAD_DIM
    dil_w = DIL_HEADS * HEAD_DIM
    x = jax.random.normal(ks[0], (BATCH, SEQ, D_MODEL), f32)
    moba_w_qkv = jax.random.normal(ks[1], (N_LAYERS_A, D_MODEL, 3 * moba_w), f32) * D_MODEL ** -0.5
    moba_w_o = jax.random.normal(ks[2], (N_LAYERS_A, moba_w, D_MODEL), f32) * (moba_w ** -0.5 * DEEPNORM_BETA)
    dil_w_qkv = jax.random.normal(ks[3], (N_LAYERS_B, D_MODEL, 3 * dil_w), f32) * D_MODEL ** -0.5
    dil_w_o = jax.random.normal(ks[4], (N_LAYERS_B, dil_w, D_MODEL), f32) * (dil_w ** -0.5 * DEEPNORM_BETA)
    mlp_w_in = jax.random.normal(ks[5], (DEPTH, D_MODEL, D_FF), f32) * D_MODEL ** -0.5
    mlp_w_out = jax.random.normal(ks[6], (DEPTH, D_FF, D_MODEL), f32) * (D_FF ** -0.5 * DEEPNORM_BETA)
    ln_mix_g = 1.0 + 0.02 * jax.random.normal(ks[7], (DEPTH, D_MODEL), f32)
    ln_mix_b = 0.02 * jax.random.normal(ks[8], (DEPTH, D_MODEL), f32)
    ln_mlp_g = 1.0 + 0.02 * jax.random.normal(ks[9], (DEPTH, D_MODEL), f32)
    ln_mlp_b = 0.02 * jax.random.normal(ks[10], (DEPTH, D_MODEL), f32)
    return {"x": x, "moba_w_qkv": moba_w_qkv, "moba_w_o": moba_w_o,
            "dil_w_qkv": dil_w_qkv, "dil_w_o": dil_w_o,
            "mlp_w_in": mlp_w_in, "mlp_w_out": mlp_w_out,
            "ln_mix_g": ln_mix_g, "ln_mix_b": ln_mix_b,
            "ln_mlp_g": ln_mlp_g, "ln_mlp_b": ln_mlp_b}


def reference(x, moba_w_qkv, moba_w_o, dil_w_qkv, dil_w_o, mlp_w_in, mlp_w_out,
              ln_mix_g, ln_mix_b, ln_mlp_g, ln_mlp_b):
    S = x.shape[1]
    cos, sin = rotary_tables(S, x.dtype)
    h = x
    for i in range(DEPTH):
        j = i // N_MIXERS
        if i % N_MIXERS == 0:
            mix = moba_attention(h, moba_w_qkv[j], moba_w_o[j], cos, sin)
        else:
            mix = dilated_attention(h, dil_w_qkv[j], dil_w_o[j], cos, sin)
        h = layer_norm(DEEPNORM_ALPHA * h + mix, ln_mix_g[i], ln_mix_b[i])
        h = layer_norm(DEEPNORM_ALPHA * h + sq_relu_mlp(h, mlp_w_in[i], mlp_w_out[i]),
                       ln_mlp_g[i], ln_mlp_b[i])
    return h
```

```cpp
#include <hip/hip_runtime.h>
#include <hip/hip_cooperative_groups.h>
#include <cstdio>
#include <cstdint>
namespace cg = cooperative_groups;
namespace pg8 {
#define PG8_LAS __attribute__((address_space(3)))
typedef unsigned short bf16_t;
typedef short bf16x8 __attribute__((ext_vector_type(8)));
typedef float f32x4 __attribute__((ext_vector_type(4)));
typedef unsigned u32x4 __attribute__((ext_vector_type(4)));
constexpr int BM = 256, BK = 64, HALF = 128, HTB = HALF * BK * 2  , STAGE_BYTES = 8 * HTB, NXCD = 8, WGM = 4;

__host__ __device__ __forceinline__ int lds_byte(int r, int c) { const int st = (r >> 4) * 2 + (c >> 5), rr = r & 15, cc = c & 31, ob = rr * 64 + cc * 2; return st * 1024 + (ob ^ (((ob >> 9) & 1) << 5)); }
__host__ __device__ __forceinline__ void stage_rc(int b, int& R, int& C) { const int st = b / 1024, sb = b % 1024, swz = sb ^ (((sb >> 9) & 1) << 5); R = (st >> 1) * 16 + swz / 64; C = (st & 1) * 32 + (swz % 64) / 2; }
__host__ __device__ __forceinline__ int perm32(int rho) { const int n = rho >> 4, i = rho & 15; return 8 * (i >> 2) + 4 * n + (i & 3); }

struct Unit { int pm, pn; };
struct Gemm { const bf16_t* A; const bf16_t* Bt; int M, N, K; };

struct StaticOrder {
    int nM, nN, nwg, G, c;
    __host__ __device__ void init(int M, int N, int G_, int c_) { nM = M / BM; nN = N / BM; nwg = nM * nN; G = G_; c = c_; }
    __host__ __device__ bool next(int i, Unit& u) const {
        const long L = (long)i * G + c; if (L >= nwg) return false;
        int wgid = (int)L; { const int q = nwg / NXCD, r = nwg % NXCD, xcd = wgid % NXCD, off = wgid / NXCD; wgid = (xcd < r ? xcd * (q + 1) : r * (q + 1) + (xcd - r) * q) + off; }
        const int nig = WGM * nN, gid = wgid / nig, fm = gid * WGM, gsz = (nM - fm) < WGM ? (nM - fm) : WGM;
        u.pm = fm + ((wgid % nig) % gsz); u.pn = (wgid % nig) / gsz; return true;
    }
    __device__ __forceinline__ void a_ready(const Unit&) const {}
    __device__ __forceinline__ void done(const Unit&) const {}
};


__device__ __forceinline__ unsigned cvt_pk_bf16(float lo, float hi) { unsigned r; asm volatile("v_cvt_pk_bf16_f32 %0, %1, %2" : "=v"(r) : "v"(lo), "v"(hi)); return r; }
typedef float f32x2 __attribute__((ext_vector_type(2)));

template <class Epi, class Sched, bool ALIGN_EPI = false, bool SP2 = false>
__device__ __forceinline__ void gemm_phase(PG8_LAS unsigned char* lds, const Gemm g, const Sched& S, const Epi& E) {
    int tid_ = threadIdx.x; asm volatile("" : "+v"(tid_));
    const int tid = tid_, wid = __builtin_amdgcn_readfirstlane(tid >> 6), lane = tid & 63, wr = wid >> 2, wc = wid & 3, fr = lane & 15, fq = lane >> 4;
    const int K = g.K, nt = K / BK;
    unsigned voffA[2], voffB[2];
#pragma unroll
    for (int i = 0; i < 2; ++i) { int R, C; stage_rc(tid * 16 + i * 8192, R, C); const int Rb = Epi::PERM ? ((R & ~31) + perm32(R & 31)) : R;
        voffA[i] = (unsigned)(R * K + C) * 2u; voffB[i] = (unsigned)(Rb * K + C) * 2u; }
    const size_t kstep = (size_t)(BK * 2);
    const size_t hstep = (size_t)HALF * K * 2;
    const size_t tstep = 2 * hstep;
    const unsigned ldsw = (unsigned)wid * 1024u;
    const int aoff = lds_byte(wr * 64 + fr, fq * 8), boff = lds_byte(wc * 32 + fr, fq * 8);
#define PG8_SA(b, h) (((b) * 2 + (h)) * HTB)
#define PG8_SB(b, h) ((4 + (b) * 2 + (h)) * HTB)
#define PG8_STAGE(bufoff, gbase, voff) do { _Pragma("unroll") for (int _i = 0; _i < 2; ++_i) \
        __builtin_amdgcn_global_load_lds((const unsigned*)((const char*)(gbase) + (voff)[_i]), (PG8_LAS unsigned*)(lds + (bufoff) + ldsw + _i * 8192), 16, 0, 0); } while (0)
#define PG8_LDA(dst, b, h) do { _Pragma("unroll") for (int m = 0; m < 4; ++m) _Pragma("unroll") for (int k = 0; k < 2; ++k) dst[m][k] = *(const PG8_LAS bf16x8*)(lds + PG8_SA(b, h) + aoff + m * 2048 + k * 1024); } while (0)
#define PG8_LDB(dst, b, h) do { _Pragma("unroll") for (int n = 0; n < 2; ++n) _Pragma("unroll") for (int k = 0; k < 2; ++k) dst[n][k] = *(const PG8_LAS bf16x8*)(lds + PG8_SB(b, h) + boff + n * 2048 + k * 1024); } while (0)
#define PG8_MMA(ai, bj, At, Bt) do { __builtin_amdgcn_s_setprio(1); _Pragma("unroll") for (int m = 0; m < 4; ++m) _Pragma("unroll") for (int n = 0; n < 2; ++n) _Pragma("unroll") for (int k = 0; k < 2; ++k) \
        acc[ai][bj][m][n] = __builtin_amdgcn_mfma_f32_16x16x32_bf16(Bt[n][k], At[m][k], acc[ai][bj][m][n], 0, 0, 0); __builtin_amdgcn_s_setprio(0); } while (0)
#define PG8_WAIT_V(n) asm volatile("s_waitcnt vmcnt(" #n ")" ::: "memory")
#define PG8_WAIT_L(n) asm volatile("s_waitcnt lgkmcnt(" #n ")" ::: "memory")
#define PG8_BAR __builtin_amdgcn_s_barrier()
#define PG8_SCHED __builtin_amdgcn_sched_barrier(0)
    Unit cur, nxt; int ui = 0;
    if (!S.next(0, cur)) return;
    f32x4 acc[2][2][4][2];
#pragma unroll
    for (int a = 0; a < 2; ++a)
#pragma unroll
        for (int b = 0; b < 2; ++b)
#pragma unroll
            for (int m = 0; m < 4; ++m)
#pragma unroll
                for (int n = 0; n < 2; ++n) acc[a][b][m][n] = (f32x4){0.f, 0.f, 0.f, 0.f};
    bf16x8 At[4][2], B0[2][2], B1[2][2];
    const char* cA = (const char*)g.A + (size_t)cur.pm * tstep; const char* cB = (const char*)g.Bt + (size_t)cur.pn * tstep;
    S.a_ready(cur);
    if constexpr (SP2) {
        PG8_STAGE(PG8_SB(0, 0), cB, voffB); PG8_STAGE(PG8_SB(0, 1), cB + hstep, voffB); PG8_STAGE(PG8_SA(0, 0), cA, voffA); PG8_STAGE(PG8_SA(0, 1), cA + hstep, voffA);
        if (wr == 1) PG8_BAR;
        PG8_WAIT_V(2); PG8_BAR;
        PG8_STAGE(PG8_SB(1, 0), cB + kstep, voffB); PG8_STAGE(PG8_SA(1, 0), cA + kstep, voffA); PG8_STAGE(PG8_SB(1, 1), cB + hstep + kstep, voffB);
        PG8_WAIT_V(6); PG8_BAR;
    } else {
        PG8_STAGE(PG8_SB(0, 0), cB, voffB); PG8_STAGE(PG8_SA(0, 0), cA, voffA); PG8_STAGE(PG8_SB(0, 1), cB + hstep, voffB); PG8_STAGE(PG8_SA(0, 1), cA + hstep, voffA);
        if (wr == 1) PG8_BAR;
        PG8_WAIT_V(4); PG8_BAR;
        PG8_STAGE(PG8_SB(1, 0), cB + kstep, voffB); PG8_STAGE(PG8_SA(1, 0), cA + kstep, voffA); PG8_STAGE(PG8_SB(1, 1), cB + hstep + kstep, voffB);
        PG8_WAIT_V(6); PG8_BAR;
    }
    for (;;) {
        const bool has_next = S.next(ui + 1, nxt);
        const char* nA = has_next ? (const char*)g.A + (size_t)nxt.pm * tstep : cA; const char* nB = has_next ? (const char*)g.Bt + (size_t)nxt.pn * tstep : cB;
        for (int t = 0; t < nt; t += 2) {
            const bool last = (t == nt - 2);
            const char* a1 = cA + (size_t)(t + 1) * kstep;
            const char* a2 = last ? nA : cA + (size_t)(t + 2) * kstep; const char* b2 = last ? nB : cB + (size_t)(t + 2) * kstep;
            const char* a3 = a2 + kstep; const char* b3 = b2 + kstep;
            if (last && has_next) S.a_ready(nxt);
            if constexpr (SP2) {
            PG8_LDB(B0, 0, 0); PG8_LDB(B1, 0, 1); PG8_SCHED; PG8_LDA(At, 0, 0); PG8_STAGE(PG8_SA(1, 1), a1 + hstep, voffA);
            PG8_WAIT_V(8); PG8_WAIT_L(0); PG8_BAR; PG8_MMA(0, 0, At, B0); PG8_MMA(0, 1, At, B1); PG8_BAR; PG8_SCHED;
            PG8_LDA(At, 0, 1); PG8_STAGE(PG8_SB(0, 0), b2, voffB); PG8_STAGE(PG8_SB(0, 1), b2 + hstep, voffB); PG8_STAGE(PG8_SA(0, 0), a2, voffA);
            PG8_WAIT_V(8); PG8_WAIT_L(0); PG8_BAR; PG8_MMA(1, 0, At, B0); PG8_MMA(1, 1, At, B1); PG8_BAR; PG8_SCHED;
            PG8_LDB(B0, 1, 0); PG8_LDB(B1, 1, 1); PG8_SCHED; PG8_LDA(At, 1, 0); PG8_STAGE(PG8_SA(0, 1), a2 + hstep, voffA);
            PG8_WAIT_V(8); PG8_WAIT_L(0); PG8_BAR; PG8_MMA(0, 0, At, B0); PG8_MMA(0, 1, At, B1); PG8_BAR; PG8_SCHED;
            PG8_LDA(At, 1, 1); PG8_STAGE(PG8_SB(1, 0), b3, voffB); PG8_STAGE(PG8_SB(1, 1), b3 + hstep, voffB); PG8_STAGE(PG8_SA(1, 0), a3, voffA);
            PG8_WAIT_V(8); PG8_WAIT_L(0); PG8_BAR; PG8_MMA(1, 0, At, B0); PG8_MMA(1, 1, At, B1); PG8_BAR; PG8_SCHED;
            } else {
            PG8_LDB(B0, 0, 0); PG8_SCHED; PG8_LDA(At, 0, 0); PG8_STAGE(PG8_SA(1, 1), a1 + hstep, voffA);
            PG8_WAIT_L(8); PG8_BAR; PG8_WAIT_L(0); PG8_MMA(0, 0, At, B0); PG8_BAR; PG8_SCHED;
            PG8_LDB(B1, 0, 1); PG8_STAGE(PG8_SB(0, 0), b2, voffB);
            PG8_BAR; PG8_WAIT_L(0); PG8_MMA(0, 1, At, B1); PG8_BAR;
            PG8_LDA(At, 0, 1); PG8_STAGE(PG8_SA(0, 0), a2, voffA);
            PG8_BAR; PG8_WAIT_L(0); PG8_MMA(1, 0, At, B0); PG8_BAR; PG8_SCHED;
            PG8_STAGE(PG8_SB(0, 1), b2 + hstep, voffB);
            PG8_WAIT_V(6); PG8_BAR; PG8_MMA(1, 1, At, B1); PG8_BAR;
            PG8_LDB(B0, 1, 0); PG8_SCHED; PG8_LDA(At, 1, 0); PG8_STAGE(PG8_SA(0, 1), a2 + hstep, voffA);
            PG8_WAIT_L(8); PG8_BAR; PG8_WAIT_L(0); PG8_MMA(0, 0, At, B0); PG8_BAR; PG8_SCHED;
            PG8_LDB(B1, 1, 1); PG8_STAGE(PG8_SB(1, 0), b3, voffB);
            PG8_BAR; PG8_WAIT_L(0); PG8_MMA(0, 1, At, B1); PG8_BAR;
            PG8_LDA(At, 1, 1); PG8_STAGE(PG8_SA(1, 0), a3, voffA);
            PG8_BAR; PG8_WAIT_L(0); PG8_MMA(1, 0, At, B0); PG8_BAR; PG8_SCHED;
            PG8_STAGE(PG8_SB(1, 1), b3 + hstep, voffB);
            PG8_WAIT_V(6); PG8_BAR; PG8_MMA(1, 1, At, B1); PG8_BAR;
            }
        }
        if constexpr (ALIGN_EPI) { if (wr == 0) PG8_BAR; }
        if constexpr (!Epi::AFTER_DRAIN) { E(acc, cur, wr, wc, fr, fq); S.done(cur); }
        if (!has_next) break;
#pragma unroll
        for (int a = 0; a < 2; ++a)
#pragma unroll
            for (int b = 0; b < 2; ++b)
#pragma unroll
                for (int m = 0; m < 4; ++m)
#pragma unroll
                    for (int n = 0; n < 2; ++n) acc[a][b][m][n] = (f32x4){0.f, 0.f, 0.f, 0.f};
        cur = nxt; cA = nA; cB = nB; ++ui;
        if constexpr (ALIGN_EPI) { if (wr == 1) PG8_BAR; }
    }
    PG8_WAIT_V(0);
    if constexpr (!ALIGN_EPI) { if (wr == 0) PG8_BAR; }
    PG8_BAR;
    if constexpr (Epi::AFTER_DRAIN) { E.fused(acc, cur, wr, wc, fr, fq, lds, wid, lane); S.done(cur); }
#undef PG8_SA
#undef PG8_SB
#undef PG8_STAGE
#undef PG8_LDA
#undef PG8_LDB
#undef PG8_MMA
#undef PG8_WAIT_V
#undef PG8_WAIT_L
#undef PG8_BAR
#undef PG8_SCHED
}
}

#define LAS __attribute__((address_space(3)))
using pg8::bf16_t; using pg8::bf16x8; using pg8::f32x4; using pg8::u32x4; using pg8::Unit;
typedef float f32x16 __attribute__((ext_vector_type(16)));
typedef float f32x2_t __attribute__((ext_vector_type(2)));
typedef __bf16 bf16x2_t __attribute__((ext_vector_type(2)));
typedef unsigned u32x2 __attribute__((ext_vector_type(2)));
#define MFMA32(a, b, c) __builtin_amdgcn_mfma_f32_32x32x16_bf16((a), (b), (c), 0, 0, 0)

constexpr int BATCH = 4, SEQ = 8192, DM = 1024, MTOK = BATCH * SEQ, FF = 4096, NQKV0 = 3072, NQKV1 = 2304, D1 = 768;
constexpr float ALPHA = 1.41421356237309505f, LN_EPS = 1e-5f, QSCALE = 0.125f * 1.4426950408889634f;
constexpr int NWAVES = 8, NTHR = 512;
constexpr int LIST_CAP = 126976;

constexpr size_t MiB = 1u << 20;
constexpr size_t WS_CTL = 0, CTL_BYTES = 2 * MiB;
constexpr size_t WS_KM = 128 * 1024, WS_BAR = 16 * 1024;
constexpr size_t WS_COS = 505 * MiB, WS_SIN = 506 * MiB;
constexpr size_t WS_C12 = 640 * 1024, WS_ST = 1 * MiB;
constexpr int NC12 = 4096 + 4096 + 2304, C_WIN0 = 0, C_WIN1 = 4096, C_QKV1 = 8192;
constexpr size_t WS_WQKV0 = 3 * MiB, WS_WO0 = 9 * MiB, WS_WQKV1 = 11 * MiB, WS_WO1 = 15 * MiB + 512 * 1024, WS_WIN0 = 17 * MiB, WS_WOUT0 = 25 * MiB, WS_WIN1 = 33 * MiB, WS_WOUT1 = 41 * MiB;
constexpr size_t WS_HB = 49 * MiB;
constexpr size_t WS_Q = 113 * MiB, WS_K = 177 * MiB, WS_VT = 241 * MiB, WS_PO = 305 * MiB, WS_PL = 497 * MiB;
constexpr size_t WS_H = 113 * MiB, WS_Z = 369 * MiB, WS_HB2 = 433 * MiB;
constexpr size_t WS_Q1 = 113 * MiB, WS_K1 = 161 * MiB, WS_VT1 = 209 * MiB, WS_PO1 = 257 * MiB, WS_PL1 = 305 * MiB;
constexpr size_t WS_DUMP = 401 * MiB, WS_END = 507 * MiB;
constexpr size_t OUT_PO3 = 0, OUT_LIST = 64 * MiB;

#ifndef DUPU
#define DUPU 1
#endif
#ifndef DUPQ0
#define DUPQ0 1
#endif
#ifndef DUPQ1
#define DUPQ1 1
#endif
#ifndef DUPG
#define DUPG 1
#endif
#ifndef G_ALIGN
#define G_ALIGN true
#endif
#ifndef G_SP2
#define G_SP2 true
#endif
#ifndef PHM
#define PHM 0xFFFFFFFFu
#endif
constexpr int RING_BYTES = 131072, LDS_BYTES = 147456, LDS_MISC = LDS_BYTES - 1024;

__device__ __forceinline__ unsigned pk2(float lo, float hi) { f32x2_t v = {lo, hi}; bf16x2_t b = __builtin_convertvector(v, bf16x2_t); return __builtin_bit_cast(unsigned, b); }
__device__ __forceinline__ float bf_lo(unsigned u) { return __uint_as_float(u << 16); }
__device__ __forceinline__ float bf_hi(unsigned u) { return __uint_as_float(u & 0xffff0000u); }
__device__ __forceinline__ int crow(int i, int hh) { return (i & 3) + 8 * (i >> 2) + 4 * hh; }
__device__ __forceinline__ float wave_sum(float v) {
#pragma unroll
    for (int o = 1; o < 64; o <<= 1) v += __shfl_xor(v, o);
    return v;
}
#define LDS_WAIT() asm volatile("s_waitcnt lgkmcnt(0)" ::: "memory")
__device__ __forceinline__ int qkv_phys(int c) { return (c & ~255) + ((c & 32) ? 128 : 0) + (((c >> 6) & 3) << 5) + (c & 31); }
__device__ __forceinline__ int swz16(int r) { return (r & ~12) | ((r & 4) << 1) | ((r & 8) >> 1); }

#define ROW_STATS(st_, row_, mu_, rs_) do { const f32x2_t sv_ = *(const f32x2_t*)((st_) + (size_t)(row_) * 2); (mu_) = sv_.x * (1.0f / DM); (rs_) = 1.0f / sqrtf(sv_.y * (1.0f / DM) - (mu_) * (mu_) + LN_EPS); } while (0)
template <int LAYER> struct EpiQKV {
    static constexpr bool PERM = true, AFTER_DRAIN = false;
    bf16_t* Q; bf16_t* Kb; bf16_t* VT; float* KM; const float* cs; const float* sn; const float* st; const float* c1; const float* c2;
    __device__ __forceinline__ void operator()(const f32x4 (&acc)[2][2][4][2], const Unit& u, int wr, int wc, int fr, int fq) const {
        constexpr int NT = LAYER == 0 ? 4 : 3, PITCH = NT * 256, NH = NT * 4;
        const int which = u.pn / NT, hg = u.pn - which * NT, head = hg * 4 + wc, e0 = 8 * fq;
        const int dsh = LAYER == 0 ? 0 : 2 * hg;
        const int rowb = u.pm * 256 + wr * 64 + fr;
        f32x4 c1v[2][2], c2v[2][2]; f32x2_t svc = {0.f, 0.f}, svn = {0.f, 0.f};
        if (LAYER == 1) {
#pragma unroll
            for (int bj = 0; bj < 2; ++bj)
#pragma unroll
                for (int n = 0; n < 2; ++n) { const int cc = u.pn * 256 + bj * 128 + wc * 32 + e0 + 4 * n; c1v[bj][n] = *(const f32x4*)(c1 + cc); c2v[bj][n] = *(const f32x4*)(c2 + cc); }
            svc = *(const f32x2_t*)(st + (size_t)rowb * 2);
        }
#define QKV_AFF(a_, bj_, n_) (LAYER == 1 ? ((a_) - mu * c1v[bj_][n_]) * rstd + c2v[bj_][n_] : (a_))
        if (which < 2) {
            bf16_t* dst = which == 0 ? Q : Kb; const float sc = which == 0 ? QSCALE : 1.f;
            f32x4 ks[2][2];
#pragma unroll
            for (int a = 0; a < 2; ++a)
#pragma unroll
                for (int b = 0; b < 2; ++b) ks[a][b] = (f32x4){0.f, 0.f, 0.f, 0.f};
            f32x4 tc[4], tn[4];
            { const int t = rowb & 8191; tc[0] = *(const f32x4*)(cs + t * 32 + e0); tc[1] = *(const f32x4*)(cs + t * 32 + e0 + 4); tc[2] = *(const f32x4*)(sn + t * 32 + e0); tc[3] = *(const f32x4*)(sn + t * 32 + e0 + 4); }
#pragma unroll
            for (int q = 0; q < 8; ++q) {
                const int ai = q >> 2, m = q & 3;
                const int row = rowb + ai * 128 + m * 16, b = row >> 13, t = row & 8191;
                if (q + 1 < 8) { const int t2 = (rowb + ((q + 1) >> 2) * 128 + ((q + 1) & 3) * 16) & 8191;
                    tn[0] = *(const f32x4*)(cs + t2 * 32 + e0); tn[1] = *(const f32x4*)(cs + t2 * 32 + e0 + 4); tn[2] = *(const f32x4*)(sn + t2 * 32 + e0); tn[3] = *(const f32x4*)(sn + t2 * 32 + e0 + 4);
                    if (LAYER == 1) svn = *(const f32x2_t*)(st + (size_t)(rowb + ((q + 1) >> 2) * 128 + ((q + 1) & 3) * 16) * 2); }
                const int rr = ((t & ((1 << dsh) - 1)) << (13 - dsh)) | (t >> dsh);
                const f32x4 c0 = tc[0], c1_ = tc[1], s0 = tc[2], s1 = tc[3];
                const float mu = LAYER == 1 ? svc.x * (1.0f / DM) : 0.f, rstd = LAYER == 1 ? 1.0f / sqrtf(svc.y * (1.0f / DM) - mu * mu + LN_EPS) : 1.f;
                const f32x4 x1a = QKV_AFF(acc[ai][0][m][0], 0, 0), x1b = QKV_AFF(acc[ai][0][m][1], 0, 1), x2a = QKV_AFF(acc[ai][1][m][0], 1, 0), x2b = QKV_AFF(acc[ai][1][m][1], 1, 1);
                const f32x4 o1a = (x1a * c0 - x2a * s0) * sc, o1b = (x1b * c1_ - x2b * s1) * sc, o2a = (x2a * c0 + x1a * s0) * sc, o2b = (x2b * c1_ + x1b * s1) * sc;
                bf16_t* p = dst + (size_t)(b * 8192 + rr) * PITCH + head * 64 + e0;
                u32x4 w; w.x = pk2(o1a[0], o1a[1]); w.y = pk2(o1a[2], o1a[3]); w.z = pk2(o1b[0], o1b[1]); w.w = pk2(o1b[2], o1b[3]);
                __builtin_nontemporal_store(w, (u32x4*)p);
                w.x = pk2(o2a[0], o2a[1]); w.y = pk2(o2a[2], o2a[3]); w.z = pk2(o2b[0], o2b[1]); w.w = pk2(o2b[2], o2b[3]);
                __builtin_nontemporal_store(w, (u32x4*)(p + 32));
                if (LAYER == 0 && which == 1) { ks[0][0] += o1a; ks[0][1] += o1b; ks[1][0] += o2a; ks[1][1] += o2b; }
                asm volatile("" ::: "memory");
#pragma unroll
                for (int k = 0; k < 4; ++k) tc[k] = tn[k];
                svc = svn;
            }
            if (LAYER == 0 && which == 1) {
                const int b = u.pm >> 5, blk = u.pm & 31;
                float* kmp = KM + ((size_t)((b * 16 + head) * 32 + blk)) * 64; float kmv = 0.f;
#pragma unroll
                for (int a = 0; a < 2; ++a)
#pragma unroll
                    for (int n = 0; n < 2; ++n)
#pragma unroll
                        for (int i = 0; i < 4; ++i) {
                            float v = ks[a][n][i];
                            v += __shfl_xor(v, 1); v += __shfl_xor(v, 2); v += __shfl_xor(v, 4); v += __shfl_xor(v, 8);
                            if (fr == a * 8 + n * 4 + i) kmv = v;
                        }
                __hip_atomic_fetch_add(kmp + (fr >> 3) * 32 + e0 + (fr & 7), kmv * (1.0f / 256.0f), __ATOMIC_RELAXED, __HIP_MEMORY_SCOPE_AGENT);
            }
        } else {
#pragma unroll
            for (int q = 0; q < 8; ++q) {
                const int ai = q >> 2, m = q & 3;
                const int row = rowb + ai * 128 + m * 16, b = row >> 13, t = row & 8191;
                const int rr = ((t & ((1 << dsh) - 1)) << (13 - dsh)) | (t >> dsh);
                bf16_t* p = VT + ((size_t)(b * NH + head) * 64 + e0) * 8192 + swz16(rr);
                if (LAYER == 1 && q + 1 < 8) svn = *(const f32x2_t*)(st + (size_t)(rowb + ((q + 1) >> 2) * 128 + ((q + 1) & 3) * 16) * 2);
                const float mu = LAYER == 1 ? svc.x * (1.0f / DM) : 0.f, rstd = LAYER == 1 ? 1.0f / sqrtf(svc.y * (1.0f / DM) - mu * mu + LN_EPS) : 1.f;
#pragma unroll
                for (int bj = 0; bj < 2; ++bj)
#pragma unroll
                    for (int n = 0; n < 2; ++n) { const f32x4 yv = QKV_AFF(acc[ai][bj][m][n], bj, n);
#pragma unroll
                        for (int i = 0; i < 4; ++i) p[(size_t)(bj * 32 + 4 * n + i) * 8192] = (bf16_t)(pk2(yv[i], 0.f) & 0xffffu); }
                svc = svn;
            }
        }
#undef QKV_AFF
    }
};
struct EpiSqRelu {
    static constexpr bool PERM = true, AFTER_DRAIN = false;
    bf16_t* O; int ldc; const float* st; const float* c1; const float* c2;
    __device__ __forceinline__ void operator()(const f32x4 (&acc)[2][2][4][2], const Unit& u, int wr, int wc, int fr, int fq) const {
        const int row0 = u.pm * 256 + wr * 64 + fr, col0 = u.pn * 256 + wc * 32 + 8 * fq;
        f32x4 c1v[2][2], c2v[2][2]; float mus[8], rss[8];
#pragma unroll
        for (int bj = 0; bj < 2; ++bj)
#pragma unroll
            for (int n = 0; n < 2; ++n) { c1v[bj][n] = *(const f32x4*)(c1 + col0 + bj * 128 + 4 * n); c2v[bj][n] = *(const f32x4*)(c2 + col0 + bj * 128 + 4 * n); }
#pragma unroll
        for (int q = 0; q < 8; ++q) ROW_STATS(st, row0 + (q >> 2) * 128 + (q & 3) * 16, mus[q], rss[q]);
#pragma unroll
        for (int ai = 0; ai < 2; ++ai)
#pragma unroll
            for (int m = 0; m < 4; ++m) { const int row = row0 + ai * 128 + m * 16; bf16_t* rowp = O + (size_t)row * ldc + col0;
                const float mu = mus[ai * 4 + m], rstd = rss[ai * 4 + m];
#pragma unroll
                for (int bj = 0; bj < 2; ++bj) { f32x4 v0 = (acc[ai][bj][m][0] - mu * c1v[bj][0]) * rstd + c2v[bj][0], v1 = (acc[ai][bj][m][1] - mu * c1v[bj][1]) * rstd + c2v[bj][1];
#pragma unroll
                    for (int i = 0; i < 4; ++i) { const float a = fmaxf(v0[i], 0.f), b = fmaxf(v1[i], 0.f); v0[i] = a * a; v1[i] = b * b; }
                    u32x4 w; w.x = pk2(v0[0], v0[1]); w.y = pk2(v0[2], v0[3]); w.z = pk2(v1[0], v1[1]); w.w = pk2(v1[2], v1[3]);
                    __builtin_nontemporal_store(w, (u32x4*)(rowp + bj * 128)); } }
    }
};
template <int MODE> struct EpiResid {
    static constexpr bool PERM = true, AFTER_DRAIN = false;
    const bf16_t* R; bf16_t* Z; const float* stp; float* stc; const float* g; const float* b;
    __device__ __forceinline__ void operator()(const f32x4 (&acc)[2][2][4][2], const Unit& u, int wr, int wc, int fr, int fq) const {
        const int row0 = u.pm * 256 + wr * 64 + fr, col0 = u.pn * 256 + wc * 32 + 8 * fq;
        const bf16_t* src = MODE == 1 ? (const bf16_t*)Z : R;
        f32x4 gv[2][2], bv[2][2]; f32x2_t svc = {0.f, 0.f}, svn = {0.f, 0.f};
        u32x4 rc[2], rn[2]; float sq[8];
        rc[0] = *(const u32x4*)(src + (size_t)row0 * DM + col0); rc[1] = *(const u32x4*)(src + (size_t)row0 * DM + col0 + 128);
        if (MODE == 1) {
#pragma unroll
            for (int bj = 0; bj < 2; ++bj)
#pragma unroll
                for (int n = 0; n < 2; ++n) { gv[bj][n] = *(const f32x4*)(g + col0 + bj * 128 + 4 * n); bv[bj][n] = *(const f32x4*)(b + col0 + bj * 128 + 4 * n); }
            svc = *(const f32x2_t*)(stp + (size_t)row0 * 2);
        }
#pragma unroll
        for (int q = 0; q < 8; ++q) {
            const int ai = q >> 2, m = q & 3, row = row0 + ai * 128 + m * 16; const size_t off = (size_t)row * DM + col0;
            if (q + 1 < 8) { const int row2 = row0 + ((q + 1) >> 2) * 128 + ((q + 1) & 3) * 16; const size_t off2 = (size_t)row2 * DM + col0; rn[0] = *(const u32x4*)(src + off2); rn[1] = *(const u32x4*)(src + off2 + 128);
                if (MODE == 1) svn = *(const f32x2_t*)(stp + (size_t)row2 * 2); }
            const float mu = MODE == 1 ? svc.x * (1.0f / DM) : 0.f, rstd = MODE == 1 ? 1.0f / sqrtf(svc.y * (1.0f / DM) - mu * mu + LN_EPS) : 1.f;
            float s1 = 0.f, s2 = 0.f;
#pragma unroll
            for (int bj = 0; bj < 2; ++bj) { const u32x4 rv = rc[bj];
                f32x4 h0 = (f32x4){bf_lo(rv.x), bf_hi(rv.x), bf_lo(rv.y), bf_hi(rv.y)}, h1 = (f32x4){bf_lo(rv.z), bf_hi(rv.z), bf_lo(rv.w), bf_hi(rv.w)};
                if (MODE == 1) { h0 = (h0 - mu) * rstd * gv[bj][0] + bv[bj][0]; h1 = (h1 - mu) * rstd * gv[bj][1] + bv[bj][1]; }
                const f32x4 z0 = ALPHA * h0 + acc[ai][bj][m][0], z1 = ALPHA * h1 + acc[ai][bj][m][1];
                u32x4 w; w.x = pk2(z0[0], z0[1]); w.y = pk2(z0[2], z0[3]); w.z = pk2(z1[0], z1[1]); w.w = pk2(z1[2], z1[3]);
                __builtin_nontemporal_store(w, (u32x4*)(Z + off + bj * 128));
                const float r0 = bf_lo(w.x), r1 = bf_hi(w.x), r2 = bf_lo(w.y), r3 = bf_hi(w.y), r4 = bf_lo(w.z), r5 = bf_hi(w.z), r6 = bf_lo(w.w), r7 = bf_hi(w.w);
                s1 += ((r0 + r1) + (r2 + r3)) + ((r4 + r5) + (r6 + r7));
                s2 += ((r0 * r0 + r1 * r1) + (r2 * r2 + r3 * r3)) + ((r4 * r4 + r5 * r5) + (r6 * r6 + r7 * r7)); }
            s1 += __shfl_xor(s1, 16); s1 += __shfl_xor(s1, 32); s2 += __shfl_xor(s2, 16); s2 += __shfl_xor(s2, 32);
            sq[q] = (fq & 1) ? s2 : s1;
            asm volatile("" ::: "memory");
            rc[0] = rn[0]; rc[1] = rn[1]; svc = svn;
        }
#pragma unroll
        for (int p = 0; p < 4; ++p) {
            const int qa = 2 * p, qb = 2 * p + 1;
            const float val = (fq < 2) ? sq[qa] : sq[qb];
            const int rowp = row0 + ((fq < 2) ? ((qa >> 2) * 128 + (qa & 3) * 16) : ((qb >> 2) * 128 + (qb & 3) * 16));
            __hip_atomic_fetch_add(stc + (size_t)rowp * 2 + (fq & 1), val, __ATOMIC_RELAXED, __HIP_MEMORY_SCOPE_AGENT);
        }
    }
};

template <bool PERMQ, bool SCALED> __device__ __forceinline__ void transpose_item(const float* W, int K, int N, bf16_t* WT, LAS float* scr, int item, int lane, const float* gk, const float* bk, float* c1, float* c2) {
    const int nblk = N / 32, kb = item / nblk, nb = item % nblk, k0 = 64 * kb, n0 = 32 * nb;
    float p1 = 0.f, p2 = 0.f;
#pragma unroll 8
    for (int i = 0; i < 32; ++i) { const int kk = 2 * i + (lane >> 5); float v = W[(size_t)(k0 + kk) * N + n0 + (lane & 31)];
        if (SCALED) { p2 += v * bk[k0 + kk]; v *= gk[k0 + kk]; p1 += bf_lo(pk2(v, 0.f)); }
        scr[kk * 33 + (lane & 31)] = v; }
    LDS_WAIT();
    if (SCALED) { p1 += __shfl_xor(p1, 32); p2 += __shfl_xor(p2, 32);
        if (lane < 32) { const int oc = PERMQ ? qkv_phys(n0 + lane) : (n0 + lane); __hip_atomic_fetch_add(c1 + oc, p1, __ATOMIC_RELAXED, __HIP_MEMORY_SCOPE_AGENT); __hip_atomic_fetch_add(c2 + oc, p2, __ATOMIC_RELAXED, __HIP_MEMORY_SCOPE_AGENT); } }
    const int c = lane & 7;
#pragma unroll
    for (int j = 0; j < 4; ++j) { const int n = (lane >> 3) + 8 * j; const LAS float* sp = scr + (8 * c) * 33 + n;
        u32x4 o; o.x = pk2(sp[0 * 33], sp[1 * 33]); o.y = pk2(sp[2 * 33], sp[3 * 33]); o.z = pk2(sp[4 * 33], sp[5 * 33]); o.w = pk2(sp[6 * 33], sp[7 * 33]);
        const int orow = PERMQ ? qkv_phys(n0 + n) : (n0 + n);
        *(u32x4*)(WT + (size_t)orow * K + k0 + 8 * c) = o; }
    LDS_WAIT();
}

template <bool F32OUT> __device__ __forceinline__ void ln_phase(const bf16_t* Z, const float* g, const float* bt, bf16_t* ob, float* of, int gw, int ngw, int lane) {
    f32x4 gv[4], bv[4];
#pragma unroll
    for (int q = 0; q < 2; ++q) { gv[2 * q] = *(const f32x4*)(g + 512 * q + 8 * lane); gv[2 * q + 1] = *(const f32x4*)(g + 512 * q + 8 * lane + 4);
                                  bv[2 * q] = *(const f32x4*)(bt + 512 * q + 8 * lane); bv[2 * q + 1] = *(const f32x4*)(bt + 512 * q + 8 * lane + 4); }
    for (int row = gw; row < MTOK; row += ngw) {
        const bf16_t* zr = Z + (size_t)row * DM + 8 * lane;
        const u32x4 a = *(const u32x4*)zr, b = *(const u32x4*)(zr + 512);
        float v[16] = {bf_lo(a.x), bf_hi(a.x), bf_lo(a.y), bf_hi(a.y), bf_lo(a.z), bf_hi(a.z), bf_lo(a.w), bf_hi(a.w),
                       bf_lo(b.x), bf_hi(b.x), bf_lo(b.y), bf_hi(b.y), bf_lo(b.z), bf_hi(b.z), bf_lo(b.w), bf_hi(b.w)};
        float s = 0.f;
#pragma unroll
        for (int i = 0; i < 16; ++i) s += v[i];
        const float mean = wave_sum(s) * (1.0f / DM);
        float q = 0.f;
#pragma unroll
        for (int i = 0; i < 16; ++i) { v[i] -= mean; q += v[i] * v[i]; }
        const float rstd = 1.0f / sqrtf(wave_sum(q) * (1.0f / DM) + LN_EPS);
#pragma unroll
        for (int i = 0; i < 16; ++i) v[i] = v[i] * rstd * gv[i >> 2][i & 3] + bv[i >> 2][i & 3];
        if (F32OUT) {
            float* orow = of + (size_t)row * DM + 8 * lane;
            __builtin_nontemporal_store((f32x4){v[0], v[1], v[2], v[3]}, (f32x4*)orow); __builtin_nontemporal_store((f32x4){v[4], v[5], v[6], v[7]}, (f32x4*)(orow + 4));
            __builtin_nontemporal_store((f32x4){v[8], v[9], v[10], v[11]}, (f32x4*)(orow + 512)); __builtin_nontemporal_store((f32x4){v[12], v[13], v[14], v[15]}, (f32x4*)(orow + 516));
        } else {
            bf16_t* orow = ob + (size_t)row * DM + 8 * lane;
            u32x4 w; w.x = pk2(v[0], v[1]); w.y = pk2(v[2], v[3]); w.z = pk2(v[4], v[5]); w.w = pk2(v[6], v[7]); *(u32x4*)orow = w;
            w.x = pk2(v[8], v[9]); w.y = pk2(v[10], v[11]); w.z = pk2(v[12], v[13]); w.w = pk2(v[14], v[15]); *(u32x4*)(orow + 512) = w;
        }
    }
}

constexpr int KPB = 144;
template <int NKT, int MODE, int GT>
__device__ __forceinline__ void attn_rows(const LAS unsigned char* Kl, const LAS unsigned char* Vl, const int vpb, const bf16x8 (&qf)[4], const int r, const int hh, const int p0, const int p1,
                                          f32x16 (&o)[2], float& lse2) {
    constexpr int NG = (NKT + GT - 1) / GT;
    float mrun = -INFINITY, lrun = 0.f;
#pragma unroll
    for (int i = 0; i < 16; ++i) { o[0][i] = 0.f; o[1][i] = 0.f; }
#pragma unroll
    for (int grp = 0; grp < NG; ++grp) {
        constexpr int dummy = 0; (void)dummy;
        const int kt0 = grp * GT;
        const int nt = (NKT - kt0) < GT ? (NKT - kt0) : GT;
        const bool gact = MODE == 0 ? true : (MODE == 1 ? (kt0 <= p0) : (p1 != 0 || (p0 + kt0 + nt - 1 >= 4)));
        if (gact) {
            bf16x8 kf[GT][4];
#pragma unroll
            for (int q = 0; q < GT; ++q)
#pragma unroll
                for (int ks = 0; ks < 4; ++ks) if (q < nt) kf[q][ks] = *(const LAS bf16x8*)(Kl + ((kt0 + q) * 32 + r) * KPB + ks * 32 + hh * 16);
            f32x16 s[GT];
#pragma unroll
            for (int q = 0; q < GT; ++q)
#pragma unroll
                for (int i = 0; i < 16; ++i) s[q][i] = 0.f;
#pragma unroll
            for (int ks = 0; ks < 4; ++ks)
#pragma unroll
                for (int q = 0; q < GT; ++q) if (q < nt) s[q] = MFMA32(kf[q][ks], qf[ks], s[q]);
            bf16x8 vf[GT][2][2];
#pragma unroll
            for (int q = 0; q < GT; ++q)
#pragma unroll
                for (int s2 = 0; s2 < 2; ++s2)
#pragma unroll
                    for (int dt = 0; dt < 2; ++dt) if (q < nt) vf[q][s2][dt] = *(const LAS bf16x8*)(Vl + (dt * 32 + r) * vpb + ((kt0 + q) * 32 + s2 * 16 + hh * 8) * 2);
            if (MODE == 1) { if (p0 < 8) {
#pragma unroll
                for (int q = 0; q < GT; ++q) if (q < nt) { const int lim = (p0 - (kt0 + q)) * 32 + r;
#pragma unroll
                    for (int i = 0; i < 16; ++i) if (crow(i, hh) > lim) s[q][i] = -INFINITY; } } }
            if (MODE == 2) {
#pragma unroll
                for (int q = 0; q < GT; ++q) if (q < nt) { const int kt = kt0 + q;
                    if (kt == 0) {
#pragma unroll
                        for (int i = 0; i < 16; ++i) if (crow(i, hh) < r) s[q][i] = -INFINITY; }
                    if (kt == NKT - 1) {
#pragma unroll
                        for (int i = 0; i < 16; ++i) if (crow(i, hh) > r) s[q][i] = -INFINITY; } }
                if (p1 == 0) {
#pragma unroll
                    for (int q = 0; q < GT; ++q) if (q < nt) { if (p0 + kt0 + q < 4) {
#pragma unroll
                        for (int i = 0; i < 16; ++i) s[q][i] = -INFINITY; } } }
            }
            float mx = -INFINITY;
#pragma unroll
            for (int q = 0; q < GT; ++q) if (q < nt) {
#pragma unroll
                for (int i = 0; i < 16; ++i) mx = fmaxf(mx, s[q][i]); }
            mx = fmaxf(mx, __shfl_xor(mx, 32));
            const float mnew = fmaxf(mrun, mx);
            const float sc = __builtin_amdgcn_exp2f(mrun - mnew);
            mrun = mnew; lrun *= sc;
            if (grp > 0) {
#pragma unroll
                for (int i = 0; i < 16; ++i) { o[0][i] *= sc; o[1][i] *= sc; }
            }
#pragma unroll
            for (int q = 0; q < GT; ++q) if (q < nt) {
#pragma unroll
                for (int i = 0; i < 16; ++i) { const float p = __builtin_amdgcn_exp2f(s[q][i] - mnew); s[q][i] = p; lrun += p; }
#pragma unroll
                for (int s2 = 0; s2 < 2; ++s2) {
                    u32x4 pw; pw.x = pk2(s[q][8 * s2], s[q][8 * s2 + 1]); pw.y = pk2(s[q][8 * s2 + 2], s[q][8 * s2 + 3]); pw.z = pk2(s[q][8 * s2 + 4], s[q][8 * s2 + 5]); pw.w = pk2(s[q][8 * s2 + 6], s[q][8 * s2 + 7]);
                    const bf16x8 pf = __builtin_bit_cast(bf16x8, pw);
#pragma unroll
                    for (int dt = 0; dt < 2; ++dt) o[dt] = MFMA32(vf[q][s2][dt], pf, o[dt]);
                }
            }
        }
    }
    const float l = lrun + __shfl_xor(lrun, 32);
    const float inv = 1.0f / l;
#pragma unroll
    for (int i = 0; i < 16; ++i) { o[0][i] *= inv; o[1][i] *= inv; }
    lse2 = mrun + __builtin_amdgcn_logf(l);
}
__device__ __forceinline__ void store_o(bf16_t* dst, const f32x16 (&o)[2], int hh) {
#pragma unroll
    for (int dt = 0; dt < 2; ++dt)
#pragma unroll
        for (int g4 = 0; g4 < 4; ++g4) { u32x2 w; w.x = pk2(o[dt][4 * g4], o[dt][4 * g4 + 1]); w.y = pk2(o[dt][4 * g4 + 2], o[dt][4 * g4 + 3]); *(u32x2*)(dst + dt * 32 + 8 * g4 + 4 * hh) = w; }
}

constexpr int STG_PITCH = 144, STG_WAVE = 32 * STG_PITCH;
__device__ __forceinline__ void stage_o(LAS unsigned char* stg, const f32x16 (&o)[2], int r, int hh) {
#pragma unroll
    for (int dt = 0; dt < 2; ++dt)
#pragma unroll
        for (int g4 = 0; g4 < 4; ++g4) { u32x2 w; w.x = pk2(o[dt][4 * g4], o[dt][4 * g4 + 1]); w.y = pk2(o[dt][4 * g4 + 2], o[dt][4 * g4 + 3]); *(LAS u32x2*)(stg + r * STG_PITCH + dt * 64 + g4 * 16 + hh * 8) = w; }
    LDS_WAIT();
}
constexpr int STG8_PITCH = 80; constexpr float PO8_SCALE = 16.0f;
__device__ __forceinline__ void stage_o8(LAS unsigned char* stg, const f32x16 (&o)[2], int r, int hh) {
#pragma unroll
    for (int dt = 0; dt < 2; ++dt)
#pragma unroll
        for (int g4 = 0; g4 < 4; ++g4) {
            int w = __builtin_amdgcn_cvt_pk_fp8_f32(o[dt][4 * g4] * PO8_SCALE, o[dt][4 * g4 + 1] * PO8_SCALE, 0, false);
            w = __builtin_amdgcn_cvt_pk_fp8_f32(o[dt][4 * g4 + 2] * PO8_SCALE, o[dt][4 * g4 + 3] * PO8_SCALE, w, true);
            *(LAS int*)(stg + r * STG8_PITCH + dt * 32 + g4 * 8 + hh * 4) = w; }
    LDS_WAIT();
}
#define XB_TMO      128
#define XB_XCNT(j)  (256  + 64 * (j))
#define XB_XSUB(j)  (1280 + 64 * (j))
#define XB_XGEN(j)  (2304 + 64 * (j))
#define XB_TOP      3328
#define XB_TOPGEN   3392
#define XCD_BAR_WORDS 3456
#define XB_SPIN_CAP (1u << 18)

__device__ __forceinline__ unsigned xb_ld(unsigned* p)              { return __hip_atomic_load(p, __ATOMIC_RELAXED, __HIP_MEMORY_SCOPE_AGENT); }
__device__ __forceinline__ unsigned xb_add(unsigned* p, unsigned v) { return __hip_atomic_fetch_add(p, v, __ATOMIC_RELAXED, __HIP_MEMORY_SCOPE_AGENT); }
__device__ __forceinline__ unsigned xb_xcc_id() { return (unsigned)__builtin_amdgcn_s_getreg((3 << 11) | 20) & 0xFu; }
#define XB_SPIN(cond, bar) do { unsigned _sp = 0; while (cond) { __builtin_amdgcn_s_sleep(1); \
    if ((++_sp & 255u) == 0u) { if (xb_ld(&(bar)[XB_TMO])) break; if (_sp > XB_SPIN_CAP) { atomicAdd(&(bar)[XB_TMO], 1u); break; } } } } while (0)

struct XcdBarrier {
    unsigned* bar; unsigned x;
    volatile LAS unsigned* st;
};

__device__ __forceinline__ XcdBarrier xcd_barrier_post(unsigned* bar, volatile LAS unsigned* st) {
    XcdBarrier b; b.bar = bar; b.x = xb_xcc_id(); b.st = st;
    if (threadIdx.x == 0) (void)xb_add(&bar[XB_XCNT(b.x)], 1u);
    return b;
}
__device__ __forceinline__ void xcd_barrier_complete(unsigned* bar, unsigned x, unsigned& nloc, unsigned& nx) {
    const unsigned G = gridDim.x * gridDim.y * gridDim.z;
    unsigned sum, cnt, mine, sp = 0u;
    for (;;) {
        sum = 0u; cnt = 0u; mine = 0u;
#pragma unroll
        for (unsigned j = 0; j < 16; ++j) { const unsigned c = xb_ld(&bar[XB_XCNT(j)]); sum += c; cnt += (c > 0u) ? 1u : 0u; mine = (j == x) ? c : mine; }
        if (sum == G) break;
        __builtin_amdgcn_s_sleep(1);
        if ((++sp & 255u) == 0u) { if (xb_ld(&bar[XB_TMO])) break; if (sp > XB_SPIN_CAP) { atomicAdd(&bar[XB_TMO], 1u); break; } }
    }
    nloc = mine > 0u ? mine : 1u; nx = cnt > 0u ? cnt : 1u;
}

__device__ __forceinline__ void xcd_barrier(const XcdBarrier& b) {
    asm volatile("s_waitcnt vmcnt(0)" ::: "memory");
    __syncthreads();
    if (threadIdx.x == 0) {
        unsigned* bar = b.bar;
        __builtin_amdgcn_s_waitcnt(0);
        unsigned nloc = b.st[0], nx = b.st[1];
        if (nloc == 0u) { xcd_barrier_complete(bar, b.x, nloc, nx); b.st[0] = nloc; b.st[1] = nx; }
        const unsigned old = xb_add(&bar[XB_XSUB(b.x)], 1u);
        const unsigned gen = old / nloc;
        if (old + 1u == (gen + 1u) * nloc) {
            __builtin_amdgcn_fence(__ATOMIC_RELEASE, "agent");
            asm volatile("s_waitcnt vmcnt(0)" ::: "memory");
            const unsigned og = xb_add(&bar[XB_TOP], 1u);
            const unsigned tg = og / nx;
            if (og + 1u == (tg + 1u) * nx) xb_add(&bar[XB_TOPGEN], 1u);
            else XB_SPIN(xb_ld(&bar[XB_TOPGEN]) == tg, bar);
            __builtin_amdgcn_fence(__ATOMIC_ACQUIRE, "agent");
            xb_add(&bar[XB_XGEN(b.x)], 1u);
            asm volatile("s_waitcnt vmcnt(0)" ::: "memory");
        } else {
            XB_SPIN(xb_ld(&bar[XB_XGEN(b.x)]) == gen, bar);
            __builtin_amdgcn_fence(__ATOMIC_ACQUIRE, "agent");
            asm volatile("s_waitcnt vmcnt(0)" ::: "memory");
        }
    }
    __syncthreads();
}

struct Args { const float* in[11]; float* out; unsigned char* ws; int pad0, pad1; };

__global__ void __launch_bounds__(NTHR) hybrid_fwd(Args args) {
    extern __shared__ __attribute__((aligned(16))) unsigned char lds_raw[];
    LAS unsigned char* lds = (LAS unsigned char*)lds_raw;
    cg::grid_group grid = cg::this_grid();
    int tid = threadIdx.x, lane = tid & 63, wave = __builtin_amdgcn_readfirstlane(tid >> 6);
    const int G = gridDim.x, ngw = G * NWAVES; int gw = blockIdx.x * NWAVES + wave;
#define GRID_SYNC_CG() do { grid.sync(); asm volatile("" : "+v"(tid), "+v"(lane)); } while (0)
#define GRID_SYNC() do { xcd_barrier(xbar); asm volatile("" : "+v"(tid), "+v"(lane)); } while (0)
    if (tid < 2) ((LAS unsigned*)(lds + LDS_MISC + 256))[tid] = 0u;
    __syncthreads();
    const XcdBarrier xbar = xcd_barrier_post((unsigned*)(args.ws + WS_BAR), (volatile LAS unsigned*)(lds + LDS_MISC + 256));
    unsigned char* ws = args.ws;
    const float* x = args.in[0];
    bf16_t* Wqkv0 = (bf16_t*)(ws + WS_WQKV0); bf16_t* Wo0 = (bf16_t*)(ws + WS_WO0); bf16_t* Wqkv1 = (bf16_t*)(ws + WS_WQKV1); bf16_t* Wo1 = (bf16_t*)(ws + WS_WO1);
    float* cosT = (float*)(ws + WS_COS); float* sinT = (float*)(ws + WS_SIN);
    bf16_t* HB = (bf16_t*)(ws + WS_HB); bf16_t* Zb = (bf16_t*)(ws + WS_Z); bf16_t* Hm = (bf16_t*)(ws + WS_H);
    float* C1 = (float*)(ws + WS_C12); float* C2 = C1 + NC12; float* ST = (float*)(ws + WS_ST);
    unsigned* gcnt = (unsigned*)(ws + WS_CTL); float* KM = (float*)(ws + WS_KM);
    unsigned* LIST = (unsigned*)((unsigned char*)args.out + OUT_LIST); bf16_t* PO3 = (bf16_t*)((unsigned char*)args.out + OUT_PO3);

    if (PHM & 1u) {
        LAS float* scr = (LAS float*)(lds + wave * 16384);
        constexpr int I_QKV0 = (DM / 64) * (NQKV0 / 32), I_WO0 = (DM / 64) * (DM / 32), I_QKV1 = (DM / 64) * (NQKV1 / 32), I_WO1 = (D1 / 64) * (DM / 32), I_IN = (DM / 64) * (FF / 32), I_OUT = (FF / 64) * (DM / 32);
        constexpr int NITEMS = I_QKV0 + I_WO0 + I_QKV1 + I_WO1 + 2 * I_IN + 2 * I_OUT;
        for (int it = gw; it < NITEMS; it += ngw) {
            int rI = it;
            if (rI < I_QKV0) { transpose_item<true, false>(args.in[1], DM, NQKV0, Wqkv0, scr, rI, lane, nullptr, nullptr, nullptr, nullptr); continue; } rI -= I_QKV0;
            if (rI < I_WO0) { transpose_item<false, false>(args.in[2], DM, DM, Wo0, scr, rI, lane, nullptr, nullptr, nullptr, nullptr); continue; } rI -= I_WO0;
            if (rI < I_QKV1) { transpose_item<true, true>(args.in[3], DM, NQKV1, Wqkv1, scr, rI, lane, args.in[9], args.in[10], C1 + C_QKV1, C2 + C_QKV1); continue; } rI -= I_QKV1;
            if (rI < I_WO1) { transpose_item<false, false>(args.in[4], D1, DM, Wo1, scr, rI, lane, nullptr, nullptr, nullptr, nullptr); continue; } rI -= I_WO1;
            if (rI < 2 * I_IN) { const int l = rI / I_IN; transpose_item<false, true>(args.in[5] + (size_t)l * DM * FF, DM, FF, (bf16_t*)(ws + (l ? WS_WIN1 : WS_WIN0)), scr, rI - l * I_IN, lane, args.in[7] + l * DM, args.in[8] + l * DM, C1 + (l ? C_WIN1 : C_WIN0), C2 + (l ? C_WIN1 : C_WIN0)); continue; } rI -= 2 * I_IN;
            { const int l = rI / I_OUT; transpose_item<false, false>(args.in[6] + (size_t)l * DM * FF, FF, DM, (bf16_t*)(ws + (l ? WS_WOUT1 : WS_WOUT0)), scr, rI - l * I_OUT, lane, nullptr, nullptr, nullptr, nullptr); }
        }
        for (int idx = blockIdx.x * NTHR + tid; idx < SEQ * 32; idx += G * NTHR) {
            const int t = idx >> 5, e = idx & 31;
            const float inv = 1.0f / powf(10000.0f, (float)(2 * e) / 64.0f);
            const float ang = (float)t * inv;
            const double a = (double)ang, kk = rint(a * 0.15915494309189535), rd = fma(-kk, 6.283185307179586, a);
            const float rf = (float)rd;
            cosT[idx] = cosf(rf); sinT[idx] = sinf(rf);
        }
        for (int row = gw; row < MTOK; row += ngw) {
            const float* xr = x + (size_t)row * DM + 8 * lane;
            const f32x4 a0 = __builtin_nontemporal_load((const f32x4*)xr), a1 = __builtin_nontemporal_load((const f32x4*)(xr + 4)), b0 = __builtin_nontemporal_load((const f32x4*)(xr + 512)), b1 = __builtin_nontemporal_load((const f32x4*)(xr + 516));
            bf16_t* orow = HB + (size_t)row * DM + 8 * lane;
            u32x4 w; w.x = pk2(a0[0], a0[1]); w.y = pk2(a0[2], a0[3]); w.z = pk2(a1[0], a1[1]); w.w = pk2(a1[2], a1[3]); *(u32x4*)orow = w;
            w.x = pk2(b0[0], b0[1]); w.y = pk2(b0[2], b0[3]); w.z = pk2(b1[0], b1[1]); w.w = pk2(b1[2], b1[3]); *(u32x4*)(orow + 512) = w;
        }
    }
    __syncthreads();
    if (args.pad1 != 0) GRID_SYNC_CG();
    GRID_SYNC();

    bf16_t* Q0 = (bf16_t*)(ws + WS_Q); bf16_t* K0 = (bf16_t*)(ws + WS_K); bf16_t* VT0 = (bf16_t*)(ws + WS_VT); bf16_t* PO = (bf16_t*)(ws + WS_PO); float* PL = (float*)(ws + WS_PL);
    if (PHM & 2u) {
        pg8::Gemm g{HB, Wqkv0, MTOK, NQKV0, DM}; pg8::StaticOrder S; S.init(MTOK, NQKV0, G, (int)blockIdx.x);
        EpiQKV<0> E{Q0, K0, VT0, KM, cosT, sinT, nullptr, nullptr, nullptr};
        for (int repg = 0; repg < DUPG * DUPQ0; ++repg) pg8::gemm_phase<EpiQKV<0>, pg8::StaticOrder, G_ALIGN, G_SP2>(lds, g, S, E);
    }
    GRID_SYNC();
    if (PHM & 4u) {
        LAS unsigned* lcnt = (LAS unsigned*)(lds + LDS_MISC); LAS unsigned* lbase = lcnt + 32;
        const int r = lane & 31, hh = lane >> 5;
        for (int unit = blockIdx.x; unit < BATCH * 32 * 16; unit += G) {
            const int h = unit & 15, qb = (unit >> 4) & 31, b = unit >> 9;
            if (tid < 32) lcnt[tid] = 0u;
            __syncthreads();
            const int tq = qb * 256 + wave * 32 + r, token = b * 8192 + tq;
            bf16x8 qf[4];
#pragma unroll
            for (int ks = 0; ks < 4; ++ks) qf[ks] = *(const bf16x8*)(Q0 + (size_t)token * DM + h * 64 + ks * 16 + hh * 8);
            f32x16 gt;
#pragma unroll
            for (int i = 0; i < 16; ++i) gt[i] = 0.f;
            const float* kmr = KM + ((size_t)((b * 16 + h) * 32 + r)) * 64 + hh * 8;
#pragma unroll
            for (int ks = 0; ks < 4; ++ks) { const f32x4 k0 = *(const f32x4*)(kmr + ks * 16), k1 = *(const f32x4*)(kmr + ks * 16 + 4);
                u32x4 kw; kw.x = pk2(k0[0], k0[1]); kw.y = pk2(k0[2], k0[3]); kw.z = pk2(k1[0], k1[1]); kw.w = pk2(k1[2], k1[3]);
                gt = MFMA32(__builtin_bit_cast(bf16x8, kw), qf[ks], gt); }
            float v0 = -3.0e38f, v1 = -3.0e38f, v2 = -3.0e38f;
#define TOP_INS(val) do { float t_ = (val); const float a_ = fmaxf(v0, t_); t_ = fminf(v0, t_); v0 = a_; const float b_ = fmaxf(v1, t_); t_ = fminf(v1, t_); v1 = b_; v2 = fmaxf(v2, t_); } while (0)
#pragma unroll
            for (int i = 0; i < 16; ++i) { const int j = crow(i, hh); const float gv_ = j < qb ? gt[i] : -3.0e38f; TOP_INS(__uint_as_float((__float_as_uint(gv_) & ~31u) | (unsigned)j)); }
            { const float pv0 = __shfl_xor(v0, 32), pv1 = __shfl_xor(v1, 32), pv2 = __shfl_xor(v2, 32); TOP_INS(pv0); TOP_INS(pv1); TOP_INS(pv2); }
#undef TOP_INS
            const int i0 = (int)(__float_as_uint(v0) & 31u), i1 = (int)(__float_as_uint(v1) & 31u), i2 = (int)(__float_as_uint(v2) & 31u);
            const int nvalid = qb < 3 ? qb : 3;
            unsigned lp0 = 0, lp1 = 0, lp2 = 0;
            if (hh == 0) {
                if (0 < nvalid) lp0 = __hip_atomic_fetch_add(lcnt + i0, 1u, __ATOMIC_RELAXED, __HIP_MEMORY_SCOPE_WORKGROUP); else PL[((size_t)0 * MTOK + token) * 16 + h] = -INFINITY;
                if (1 < nvalid) lp1 = __hip_atomic_fetch_add(lcnt + i1, 1u, __ATOMIC_RELAXED, __HIP_MEMORY_SCOPE_WORKGROUP); else PL[((size_t)1 * MTOK + token) * 16 + h] = -INFINITY;
                if (2 < nvalid) lp2 = __hip_atomic_fetch_add(lcnt + i2, 1u, __ATOMIC_RELAXED, __HIP_MEMORY_SCOPE_WORKGROUP); else PL[((size_t)2 * MTOK + token) * 16 + h] = -INFINITY;
            }
            __syncthreads();
            if (tid < 32) { const unsigned c = lcnt[tid]; lbase[tid] = c ? __hip_atomic_fetch_add(gcnt + (b * 16 + h) * 32 + tid, c, __ATOMIC_RELAXED, __HIP_MEMORY_SCOPE_AGENT) : 0u; }
            __syncthreads();
            if (hh == 0) {
                unsigned* lst = LIST + (size_t)(b * 16 + h) * LIST_CAP;
                if (0 < nvalid) lst[256 * (31 * i0 - (i0 * (i0 - 1)) / 2) + lbase[i0] + lp0] = (unsigned)tq | (0u << 13);
                if (1 < nvalid) lst[256 * (31 * i1 - (i1 * (i1 - 1)) / 2) + lbase[i1] + lp1] = (unsigned)tq | (1u << 13);
                if (2 < nvalid) lst[256 * (31 * i2 - (i2 * (i2 - 1)) / 2) + lbase[i2] + lp2] = (unsigned)tq | (2u << 13);
            }
        }
    }
    __syncthreads();
    GRID_SYNC();
#ifndef DUP3
#define DUP3 1
#endif
#ifndef DUP10
#define DUP10 1
#endif
    for (int rep3 = 0; rep3 < DUP3; ++rep3) {
        const LAS unsigned char* Kl = lds; const LAS unsigned char* Vl = lds + 256 * KPB; constexpr int VPB = (256 + 8) * 2;
        const int r = lane & 31, hh = lane >> 5;
        bf16_t* dump = (bf16_t*)(ws + WS_DUMP) + (size_t)((blockIdx.x & 255) * NWAVES + wave) * 2048;
        u32x4 kreg[4], vreg[4];
#define P3_LOADKV(b_, h_, j_) do { _Pragma("unroll") for (int i = 0; i < 4; ++i) { const int c = tid + NTHR * i; \
            kreg[i] = *(const u32x4*)(K0 + (size_t)((b_) * 8192 + (j_) * 256 + (c >> 3)) * DM + (h_) * 64 + (c & 7) * 8); \
            vreg[i] = *(const u32x4*)(VT0 + ((size_t)((b_) * 16 + (h_)) * 64 + (c >> 5)) * 8192 + (j_) * 256 + (c & 31) * 8); } } while (0)
        LAS int* sh_n = (LAS int*)(lds + LDS_MISC + 512); LAS int* sh_order = sh_n + 32; LAS int* sh_myj = sh_order + 32; LAS int* sh_cnt = sh_myj + 32;
      for (int v = blockIdx.x; v < 256; v += G) {
        const int bh = (v & 7) * 8 + (v >> 5), q4 = (v >> 3) & 3, b = bh >> 4, h = bh & 15;
        __syncthreads();
        if (tid < 32) sh_n[tid] = 256 + (int)gcnt[bh * 32 + tid] + 128;
        __syncthreads();
        if (tid < 32) { const int nj = sh_n[tid]; int rank = 0;
            for (int i = 0; i < 32; ++i) { const int ni = sh_n[i]; rank += (ni > nj || (ni == nj && i < tid)) ? 1 : 0; }
            sh_order[rank] = tid; }
        __syncthreads();
        if (tid == 0) { int l0 = 0, l1 = 0, l2 = 0, l3 = 0, cnt = 0;
            for (int k = 0; k < 32; ++k) { const int jx = sh_order[k], w = sh_n[jx];
                int bin = 0, lm = l0; if (l1 < lm) { lm = l1; bin = 1; } if (l2 < lm) { lm = l2; bin = 2; } if (l3 < lm) { lm = l3; bin = 3; }
                l0 += bin == 0 ? w : 0; l1 += bin == 1 ? w : 0; l2 += bin == 2 ? w : 0; l3 += bin == 3 ? w : 0;
                if (bin == q4) { sh_myj[cnt] = jx; ++cnt; } }
            sh_cnt[0] = cnt; }
        __syncthreads();
        const int nit = sh_cnt[0];
        const bf16_t* Qbh = Q0 + (size_t)b * 8192 * DM + h * 64 + hh * 8;
        bf16x8 qf[4];
        if (nit > 0) { const int j0 = sh_myj[0]; P3_LOADKV(b, h, j0);
#pragma unroll
            for (int ks = 0; ks < 4; ++ks) qf[ks] = *(const bf16x8*)(Qbh + (size_t)(j0 * 256 + wave * 32 + r) * DM + ks * 16); }
#define RAW_BARRIER() do { asm volatile("s_waitcnt lgkmcnt(0)" ::: "memory"); __builtin_amdgcn_s_barrier(); asm volatile("" ::: "memory"); } while (0)
        for (int it = 0; it < nit; ++it) {
            const int j = sh_myj[it], jn = (it + 1 < nit) ? sh_myj[it + 1] : -1;
            RAW_BARRIER();
#pragma unroll
            for (int i = 0; i < 4; ++i) { const int c = tid + NTHR * i;
                *(LAS u32x4*)(lds + (c >> 3) * KPB + (c & 7) * 16) = kreg[i];
                *(LAS u32x4*)(lds + 256 * KPB + (c >> 5) * VPB + (c & 31) * 16) = vreg[i]; }
            RAW_BARRIER();
            if (jn >= 0) P3_LOADKV(b, h, jn);
#ifdef P3_PROBE_OWNONLY
            const int n = (rep3 + 1 < DUP3) ? 256 : 256 + (int)gcnt[bh * 32 + j], ngroups = (n + 31) >> 5;
#else
            const int n = 256 + (int)gcnt[bh * 32 + j], ngroups = (n + 31) >> 5;
#endif
            const unsigned* lst = LIST + (size_t)bh * LIST_CAP + 256 * (31 * j - (j * (j - 1)) / 2);
            int g = wave;
            int tq = j * 256 + g * 32 + r, slot = 3; bool valid = true;
            const int tqN = (jn >= 0 ? jn : j) * 256 + wave * 32 + r;
            unsigned en = 0u; bool vn = false;
            if (g + 8 < ngroups) { const int row = (g + 8) * 32 + r; vn = row < n; en = lst[vn ? row - 256 : 0]; }
            for (; g < ngroups; g += NWAVES) {
                bf16x8 q1[4]; int tq1 = tqN, slot1 = 3; unsigned en2 = 0u; bool vn2 = false;
                if (g + 8 < ngroups) { tq1 = (int)(en & 8191u); slot1 = (int)(en >> 13); }
#pragma unroll
                for (int ks = 0; ks < 4; ++ks) q1[ks] = *(const bf16x8*)(Qbh + (size_t)tq1 * DM + ks * 16);
                if (g + 16 < ngroups) { const int row = (g + 16) * 32 + r; vn2 = row < n; en2 = lst[vn2 ? row - 256 : 0]; }
                f32x16 o[2]; float lse2;
                attn_rows<8, 1, 2>(Kl, Vl, VPB, qf, r, hh, g < 8 ? g : 99, 0, o, lse2);
                {
                    LAS unsigned char* stg = lds + 73728 + wave * STG_WAVE;
                    stage_o8(stg, o, r, hh);
                    const int myinfo = tq | (slot << 13) | (valid ? (1 << 15) : 0);
                    {
                        const int R = lane >> 1, half = lane & 1;
                        const u32x4 v0 = *(const LAS u32x4*)(stg + R * STG8_PITCH + half * 32), v1 = *(const LAS u32x4*)(stg + R * STG8_PITCH + half * 32 + 16);
                        const int info = __shfl(myinfo, R), tqR = info & 8191, slotR = (info >> 13) & 3;
                        unsigned char* dstp = (slotR == 3 ? (unsigned char*)PO3 : (unsigned char*)PO + (size_t)slotR * MTOK * DM) + ((size_t)b * 8192 + tqR) * DM + h * 64 + half * 32;
                        if (!(info & (1 << 15))) dstp = (unsigned char*)dump + lane * 32;
                        __builtin_nontemporal_store(v0, (u32x4*)dstp); __builtin_nontemporal_store(v1, (u32x4*)(dstp + 16));
                    }
                    { float* plp = PL + ((size_t)slot * MTOK + (size_t)b * 8192 + tq) * 16 + h; if (!valid) plp = (float*)(dump + 1024) + lane; *plp = lse2; }
                }
#pragma unroll
                for (int ks = 0; ks < 4; ++ks) qf[ks] = q1[ks];
                tq = tq1; slot = slot1; valid = vn; en = en2; vn = vn2;
            }
        }
      }
#undef P3_LOADKV
#undef RAW_BARRIER
    }
    __syncthreads();
    GRID_SYNC();
    if (PHM & 16u) {
        const int head = lane >> 2, part = lane & 3;
        for (int token = gw; token < MTOK; token += ngw) {
            float ls[4], mxl = -INFINITY;
#pragma unroll
            for (int s = 0; s < 4; ++s) { ls[s] = PL[((size_t)s * MTOK + token) * 16 + head]; mxl = fmaxf(mxl, ls[s]); }
            float accv[16], den = 0.f;
#pragma unroll
            for (int i = 0; i < 16; ++i) accv[i] = 0.f;
#pragma unroll
            for (int s = 0; s < 4; ++s) {
                const float w = __builtin_amdgcn_exp2f(ls[s] - mxl);
                if (w > 0.f) {
                    den += w;
                    const unsigned char* src = (s == 3 ? (const unsigned char*)PO3 : (const unsigned char*)PO + (size_t)s * MTOK * DM) + (size_t)token * DM + head * 64 + part * 16;
                    const u32x4 a = __builtin_nontemporal_load((const u32x4*)src);
                    const float ws_ = w * (1.0f / PO8_SCALE);
#pragma unroll
                    for (int k = 0; k < 4; ++k) { const f32x2_t lo = __builtin_amdgcn_cvt_pk_f32_fp8((int)a[k], false), hi = __builtin_amdgcn_cvt_pk_f32_fp8((int)a[k], true);
                        accv[4 * k] += ws_ * lo.x; accv[4 * k + 1] += ws_ * lo.y; accv[4 * k + 2] += ws_ * hi.x; accv[4 * k + 3] += ws_ * hi.y; }
                }
            }
            const float inv = 1.0f / den;
            bf16_t* dst = Q0 + (size_t)token * DM + head * 64 + part * 16;
            u32x4 w0, w1;
            w0.x = pk2(accv[0] * inv, accv[1] * inv); w0.y = pk2(accv[2] * inv, accv[3] * inv); w0.z = pk2(accv[4] * inv, accv[5] * inv); w0.w = pk2(accv[6] * inv, accv[7] * inv);
            w1.x = pk2(accv[8] * inv, accv[9] * inv); w1.y = pk2(accv[10] * inv, accv[11] * inv); w1.z = pk2(accv[12] * inv, accv[13] * inv); w1.w = pk2(accv[14] * inv, accv[15] * inv);
            __builtin_nontemporal_store(w0, (u32x4*)dst); __builtin_nontemporal_store(w1, (u32x4*)(dst + 8));
        }
    }
    GRID_SYNC();
    if (PHM & 32u) {
        pg8::Gemm g{Q0, Wo0, MTOK, DM, DM}; pg8::StaticOrder S; S.init(MTOK, DM, G, (int)blockIdx.x);
        EpiResid<0> E{HB, Zb, nullptr, ST, nullptr, nullptr};
        for (int repg = 0; repg < DUPG; ++repg) pg8::gemm_phase<EpiResid<0>, pg8::StaticOrder, G_ALIGN, G_SP2>(lds, g, S, E);
    }
    GRID_SYNC();
    if (PHM & 64u) {
        pg8::Gemm g{Zb, (const bf16_t*)(ws + WS_WIN0), MTOK, FF, DM}; pg8::StaticOrder S; S.init(MTOK, FF, G, (int)blockIdx.x);
        EpiSqRelu E{Hm, FF, ST, C1 + C_WIN0, C2 + C_WIN0};
        for (int repg = 0; repg < DUPG * DUPU; ++repg) pg8::gemm_phase<EpiSqRelu, pg8::StaticOrder, G_ALIGN, G_SP2>(lds, g, S, E);
    }
    GRID_SYNC();
    {
        pg8::Gemm g{Hm, (const bf16_t*)(ws + WS_WOUT0), MTOK, DM, FF}; pg8::StaticOrder S; S.init(MTOK, DM, G, (int)blockIdx.x);
        EpiResid<1> E{nullptr, Zb, ST, ST + 2 * MTOK, args.in[7], args.in[8]};
        for (int repg = 0; repg < DUPG; ++repg) pg8::gemm_phase<EpiResid<1>, pg8::StaticOrder, G_ALIGN, G_SP2>(lds, g, S, E);
    }
    GRID_SYNC();

    bf16_t* Q1 = (bf16_t*)(ws + WS_Q1); bf16_t* K1 = (bf16_t*)(ws + WS_K1); bf16_t* VT1 = (bf16_t*)(ws + WS_VT1); bf16_t* PO1 = (bf16_t*)(ws + WS_PO1); float* PL1 = (float*)(ws + WS_PL1);
    if (PHM & 128u) {
        pg8::Gemm g{Zb, Wqkv1, MTOK, NQKV1, DM}; pg8::StaticOrder S; S.init(MTOK, NQKV1, G, (int)blockIdx.x);
        EpiQKV<1> E{Q1, K1, VT1, nullptr, cosT, sinT, ST + 2 * MTOK, C1 + C_QKV1, C2 + C_QKV1};
        for (int repg = 0; repg < DUPG * DUPQ1; ++repg) pg8::gemm_phase<EpiQKV<1>, pg8::StaticOrder, G_ALIGN, G_SP2>(lds, g, S, E);
    }
    GRID_SYNC();
    for (int rep10 = 0; rep10 < DUP10; ++rep10) {
        constexpr int VPB = (384 + 8) * 2; const int r = lane & 31, hh = lane >> 5;
        u32x4 kreg[6], vreg[6];
#define P10_DECODE(unit_, pp_, head_, b_, dsh_, gb_, hp_) const int pp_ = (unit_) & 31, head_ = ((unit_) >> 5) % 12, b_ = (unit_) / (32 * 12), dsh_ = 2 * (head_ >> 2), gb_ = 2 * pp_, hp_ = ((gb_ & ((64 >> dsh_) - 1)) != 0) ? 1 : 0
#define P10_LOAD(b_, head_, gb_, hp_) do { _Pragma("unroll") for (int i = 0; i < 6; ++i) { const int c = tid + NTHR * i; \
            { const int f = c >> 3, part = c & 7; kreg[i] = (u32x4){0u, 0u, 0u, 0u}; \
              if ((hp_) || f >= 128) kreg[i] = *(const u32x4*)(K1 + ((size_t)(b_) * 8192 + ((gb_) - 1) * 128 + f) * D1 + (head_) * 64 + part * 8); } \
            { const int d = c / 48, part = c - d * 48; vreg[i] = (u32x4){0u, 0u, 0u, 0u}; \
              if ((hp_) || part >= 16) vreg[i] = *(const u32x4*)(VT1 + ((size_t)((b_) * 12 + (head_)) * 64 + d) * 8192 + ((gb_) - 1) * 128 + part * 8); } } } while (0)
#define RAW_BARRIER() do { asm volatile("s_waitcnt lgkmcnt(0)" ::: "memory"); __builtin_amdgcn_s_barrier(); asm volatile("" ::: "memory"); } while (0)
        if ((int)blockIdx.x < BATCH * 12 * 32) { P10_DECODE((int)blockIdx.x, pp0, head0, b0, dsh0, gb0, hp0); P10_LOAD(b0, head0, gb0, hp0); }
        for (int unit = blockIdx.x; unit < BATCH * 12 * 32; unit += G) {
            P10_DECODE(unit, pp, head, b, dsh, gb, hasprev);
            bf16x8 qc[4];
#pragma unroll
            for (int ks = 0; ks < 4; ++ks) qc[ks] = *(const bf16x8*)(Q1 + ((size_t)b * 8192 + gb * 128 + wave * 32 + r) * D1 + head * 64 + ks * 16 + hh * 8);
            RAW_BARRIER();
#pragma unroll
            for (int i = 0; i < 6; ++i) { const int c = tid + NTHR * i;
                *(LAS u32x4*)(lds + (c >> 3) * KPB + (c & 7) * 16) = kreg[i];
                { const int d = c / 48, part = c - d * 48; *(LAS u32x4*)(lds + 384 * KPB + d * VPB + part * 16) = vreg[i]; } }
            RAW_BARRIER();
            if (unit + G < BATCH * 12 * 32) { P10_DECODE(unit + G, ppn, headn, bn, dshn, gbn, hpn); P10_LOAD(bn, headn, gbn, hpn); }
            const int rr = gb * 128 + wave * 32 + r;
            f32x16 o[2]; float lse2;
            attn_rows<5, 2, 2>(lds + wave * 32 * KPB, lds + 384 * KPB + wave * 64, VPB, qc, r, hh, wave, hasprev, o, lse2);
            const int t = ((rr & ((8192 >> dsh) - 1)) << dsh) | (rr >> (13 - dsh));
            const size_t token = (size_t)b * 8192 + t;
            {
                LAS unsigned char* stg = lds + 384 * KPB + 64 * VPB + wave * STG_WAVE;
                stage_o(stg, o, r, hh);
#pragma unroll
                for (int i = 0; i < 4; ++i) {
                    const int R = i * 8 + (lane >> 3), chunk = lane & 7;
                    const u32x4 vrow = *(const LAS u32x4*)(stg + R * STG_PITCH + chunk * 16);
                    const int tR = __shfl(t, R);
                    __builtin_nontemporal_store(vrow, (u32x4*)(PO1 + ((size_t)b * 8192 + tR) * D1 + head * 64 + chunk * 8));
                }
            }
            PL1[token * 12 + head] = lse2;
        }
#undef P10_DECODE
#undef P10_LOAD
#undef RAW_BARRIER
    }
    __syncthreads();
    GRID_SYNC();
    {
        const int head = lane >> 2, part = lane & 3, hs = head & 3, gsel = head >> 2;
        for (int token = gw; token < MTOK; token += ngw) {
            if (lane < 48) {
                const float l0 = PL1[(size_t)token * 12 + hs], l1 = PL1[(size_t)token * 12 + 4 + hs], l2 = PL1[(size_t)token * 12 + 8 + hs];
                const float mxl = fmaxf(l0, fmaxf(l1, l2));
                const float w0 = __builtin_amdgcn_exp2f(l0 - mxl), w1 = __builtin_amdgcn_exp2f(l1 - mxl), w2 = __builtin_amdgcn_exp2f(l2 - mxl);
                const float al = (gsel == 0 ? w0 : (gsel == 1 ? w1 : w2)) / (w0 + w1 + w2);
                bf16_t* p = PO1 + (size_t)token * D1 + head * 64 + part * 16;
                u32x4 a = *(const u32x4*)p, c = *(const u32x4*)(p + 8);
                a.x = pk2(al * bf_lo(a.x), al * bf_hi(a.x)); a.y = pk2(al * bf_lo(a.y), al * bf_hi(a.y)); a.z = pk2(al * bf_lo(a.z), al * bf_hi(a.z)); a.w = pk2(al * bf_lo(a.w), al * bf_hi(a.w));
                c.x = pk2(al * bf_lo(c.x), al * bf_hi(c.x)); c.y = pk2(al * bf_lo(c.y), al * bf_hi(c.y)); c.z = pk2(al * bf_lo(c.z), al * bf_hi(c.z)); c.w = pk2(al * bf_lo(c.w), al * bf_hi(c.w));
                *(u32x4*)p = a; *(u32x4*)(p + 8) = c;
            }
        }
    }
    GRID_SYNC();
    {
        pg8::Gemm g{PO1, Wo1, MTOK, DM, D1}; pg8::StaticOrder S; S.init(MTOK, DM, G, (int)blockIdx.x);
        EpiResid<1> E{nullptr, Zb, ST + 2 * MTOK, ST + 4 * MTOK, args.in[9], args.in[10]};
        for (int repg = 0; repg < DUPG; ++repg) pg8::gemm_phase<EpiResid<1>, pg8::StaticOrder, G_ALIGN, G_SP2>(lds, g, S, E);
    }
    GRID_SYNC();
    {
        pg8::Gemm g{Zb, (const bf16_t*)(ws + WS_WIN1), MTOK, FF, DM}; pg8::StaticOrder S; S.init(MTOK, FF, G, (int)blockIdx.x);
        EpiSqRelu E{Hm, FF, ST + 4 * MTOK, C1 + C_WIN1, C2 + C_WIN1};
        for (int repg = 0; repg < DUPG * DUPU; ++repg) pg8::gemm_phase<EpiSqRelu, pg8::StaticOrder, G_ALIGN, G_SP2>(lds, g, S, E);
    }
    GRID_SYNC();
    {
        pg8::Gemm g{Hm, (const bf16_t*)(ws + WS_WOUT1), MTOK, DM, FF}; pg8::StaticOrder S; S.init(MTOK, DM, G, (int)blockIdx.x);
        EpiResid<1> E{nullptr, Zb, ST + 4 * MTOK, ST + 6 * MTOK, args.in[7] + DM, args.in[8] + DM};
        for (int repg = 0; repg < DUPG; ++repg) pg8::gemm_phase<EpiResid<1>, pg8::StaticOrder, G_ALIGN, G_SP2>(lds, g, S, E);
    }
    GRID_SYNC();
    ln_phase<true>(Zb, args.in[9] + DM, args.in[10] + DM, nullptr, args.out, gw, ngw, lane);
}

extern "C" void kernel_launch(void* const* d_in, const int* in_sizes, int n_in, void* d_out, int out_size, void* d_ws, size_t ws_size, hipStream_t stream) {
    static int grid_blocks = 0;
    if (grid_blocks == 0) {
        if (n_in != 11 || out_size != MTOK * DM || ws_size < WS_END) { fprintf(stderr, "kernel_launch: unexpected shapes (n_in %d, out %d, ws %zu)\n", n_in, out_size, ws_size); grid_blocks = -1; return; }
        int dev = 0, cus = 0, per_cu = 0;
        hipGetDevice(&dev);
        hipDeviceGetAttribute(&cus, hipDeviceAttributeMultiprocessorCount, dev);
        if (hipFuncSetAttribute((const void*)hybrid_fwd, hipFuncAttributeMaxDynamicSharedMemorySize, LDS_BYTES) != hipSuccess) { fprintf(stderr, "kernel_launch: hipFuncSetAttribute failed\n"); }
        if (hipOccupancyMaxActiveBlocksPerMultiprocessor(&per_cu, (const void*)hybrid_fwd, NTHR, LDS_BYTES) != hipSuccess || per_cu < 1) { fprintf(stderr, "kernel_launch: occupancy query says %d blocks per CU\n", per_cu); per_cu = 1; (void)hipGetLastError(); }
        if (per_cu > 1) per_cu = 1;
        grid_blocks = cus * per_cu;
    }
    if (grid_blocks < 0) return;
    (void)hipMemsetAsync((char*)d_ws + WS_CTL, 0, CTL_BYTES, stream);
    Args a{};
    for (int i = 0; i < 11; ++i) a.in[i] = (const float*)d_in[i];
    a.out = (float*)d_out; a.ws = (unsigned char*)d_ws;
    void* kargs[] = {&a};
    hipError_t e = hipLaunchCooperativeKernel((const void*)hybrid_fwd, dim3(grid_blocks), dim3(NTHR), kargs, LDS_BYTES, stream);
    if (e != hipSuccess) fprintf(stderr, "kernel_launch: cooperative launch failed: %s (grid %d)\n", hipGetErrorString(e), grid_blocks);
}
```

```cpp
#include <hip/hip_runtime.h>
#include <hip/hip_cooperative_groups.h>
#include <cstdio>
#include <cstdint>
namespace cg = cooperative_groups;
namespace pg8 {
#define PG8_LAS __attribute__((address_space(3)))
typedef unsigned short bf16_t;
typedef short bf16x8 __attribute__((ext_vector_type(8)));
typedef float f32x4 __attribute__((ext_vector_type(4)));
typedef unsigned u32x4 __attribute__((ext_vector_type(4)));
constexpr int BM = 256, BK = 64, HALF = 128, HTB = HALF * BK * 2  , STAGE_BYTES = 8 * HTB, NXCD = 8, WGM = 4;

__host__ __device__ __forceinline__ int lds_byte(int r, int c) { const int st = (r >> 4) * 2 + (c >> 5), rr = r & 15, cc = c & 31, ob = rr * 64 + cc * 2; return st * 1024 + (ob ^ (((ob >> 9) & 1) << 5)); }
__host__ __device__ __forceinline__ void stage_rc(int b, int& R, int& C) { const int st = b / 1024, sb = b % 1024, swz = sb ^ (((sb >> 9) & 1) << 5); R = (st >> 1) * 16 + swz / 64; C = (st & 1) * 32 + (swz % 64) / 2; }
__host__ __device__ __forceinline__ int perm32(int rho) { const int n = rho >> 4, i = rho & 15; return 8 * (i >> 2) + 4 * n + (i & 3); }

struct Unit { int pm, pn; };
struct Gemm { const bf16_t* A; const bf16_t* Bt; int M, N, K; };

struct StaticOrder {
    int nM, nN, nwg, G, c;
    __host__ __device__ void init(int M, int N, int G_, int c_) { nM = M / BM; nN = N / BM; nwg = nM * nN; G = G_; c = c_; }
    __host__ __device__ bool next(int i, Unit& u) const {
        const long L = (long)i * G + c; if (L >= nwg) return false;
        int wgid = (int)L; { const int q = nwg / NXCD, r = nwg % NXCD, xcd = wgid % NXCD, off = wgid / NXCD; wgid = (xcd < r ? xcd * (q + 1) : r * (q + 1) + (xcd - r) * q) + off; }
        const int nig = WGM * nN, gid = wgid / nig, fm = gid * WGM, gsz = (nM - fm) < WGM ? (nM - fm) : WGM;
        u.pm = fm + ((wgid % nig) % gsz); u.pn = (wgid % nig) / gsz; return true;
    }
    __device__ __forceinline__ void a_ready(const Unit&) const {}
    __device__ __forceinline__ void done(const Unit&) const {}
};


__device__ __forceinline__ unsigned cvt_pk_bf16(float lo, float hi) { unsigned r; asm volatile("v_cvt_pk_bf16_f32 %0, %1, %2" : "=v"(r) : "v"(lo), "v"(hi)); return r; }
typedef float f32x2 __attribute__((ext_vector_type(2)));

template <class Epi, class Sched, bool ALIGN_EPI = false, bool SP2 = false>
__device__ __forceinline__ void gemm_phase(PG8_LAS unsigned char* lds, const Gemm g, const Sched& S, const Epi& E) {
    int tid_ = threadIdx.x; asm volatile("" : "+v"(tid_));
    const int tid = tid_, wid = __builtin_amdgcn_readfirstlane(tid >> 6), lane = tid & 63, wr = wid >> 2, wc = wid & 3, fr = lane & 15, fq = lane >> 4;
    const int K = g.K, nt = K / BK;
    unsigned voffA[2], voffB[2];
#pragma unroll
    for (int i = 0; i < 2; ++i) { int R, C; stage_rc(tid * 16 + i * 8192, R, C); const int Rb = Epi::PERM ? ((R & ~31) + perm32(R & 31)) : R;
        voffA[i] = (unsigned)(R * K + C) * 2u; voffB[i] = (unsigned)(Rb * K + C) * 2u; }
    const size_t kstep = (size_t)(BK * 2);
    const size_t hstep = (size_t)HALF * K * 2;
    const size_t tstep = 2 * hstep;
    const unsigned ldsw = (unsigned)wid * 1024u;
    const int aoff = lds_byte(wr * 64 + fr, fq * 8), boff = lds_byte(wc * 32 + fr, fq * 8);
#define PG8_SA(b, h) (((b) * 2 + (h)) * HTB)
#define PG8_SB(b, h) ((4 + (b) * 2 + (h)) * HTB)
#define PG8_STAGE(bufoff, gbase, voff) do { _Pragma("unroll") for (int _i = 0; _i < 2; ++_i) \
        __builtin_amdgcn_global_load_lds((const unsigned*)((const char*)(gbase) + (voff)[_i]), (PG8_LAS unsigned*)(lds + (bufoff) + ldsw + _i * 8192), 16, 0, 0); } while (0)
#define PG8_LDA(dst, b, h) do { _Pragma("unroll") for (int m = 0; m < 4; ++m) _Pragma("unroll") for (int k = 0; k < 2; ++k) dst[m][k] = *(const PG8_LAS bf16x8*)(lds + PG8_SA(b, h) + aoff + m * 2048 + k * 1024); } while (0)
#define PG8_LDB(dst, b, h) do { _Pragma("unroll") for (int n = 0; n < 2; ++n) _Pragma("unroll") for (int k = 0; k < 2; ++k) dst[n][k] = *(const PG8_LAS bf16x8*)(lds + PG8_SB(b, h) + boff + n * 2048 + k * 1024); } while (0)
#define PG8_MMA(ai, bj, At, Bt) do { __builtin_amdgcn_s_setprio(1); _Pragma("unroll") for (int m = 0; m < 4; ++m) _Pragma("unroll") for (int n = 0; n < 2; ++n) _Pragma("unroll") for (int k = 0; k < 2; ++k) \
        acc[ai][bj][m][n] = __builtin_amdgcn_mfma_f32_16x16x32_bf16(Bt[n][k], At[m][k], acc[ai][bj][m][n], 0, 0, 0); __builtin_amdgcn_s_setprio(0); } while (0)
#define PG8_WAIT_V(n) asm volatile("s_waitcnt vmcnt(" #n ")" ::: "memory")
#define PG8_WAIT_L(n) asm volatile("s_waitcnt lgkmcnt(" #n ")" ::: "memory")
#define PG8_BAR __builtin_amdgcn_s_barrier()
#define PG8_SCHED __builtin_amdgcn_sched_barrier(0)
    Unit cur, nxt; int ui = 0;
    if (!S.next(0, cur)) return;
    f32x4 acc[2][2][4][2];
#pragma unroll
    for (int a = 0; a < 2; ++a)
#pragma unroll
        for (int b = 0; b < 2; ++b)
#pragma unroll
            for (int m = 0; m < 4; ++m)
#pragma unroll
                for (int n = 0; n < 2; ++n) acc[a][b][m][n] = (f32x4){0.f, 0.f, 0.f, 0.f};
    bf16x8 At[4][2], B0[2][2], B1[2][2];
    const char* cA = (const char*)g.A + (size_t)cur.pm * tstep; const char* cB = (const char*)g.Bt + (size_t)cur.pn * tstep;
    S.a_ready(cur);
    if constexpr (SP2) {
        PG8_STAGE(PG8_SB(0, 0), cB, voffB); PG8_STAGE(PG8_SB(0, 1), cB + hstep, voffB); PG8_STAGE(PG8_SA(0, 0), cA, voffA); PG8_STAGE(PG8_SA(0, 1), cA + hstep, voffA);
        if (wr == 1) PG8_BAR;
        PG8_WAIT_V(2); PG8_BAR;
        PG8_STAGE(PG8_SB(1, 0), cB + kstep, voffB); PG8_STAGE(PG8_SA(1, 0), cA + kstep, voffA); PG8_STAGE(PG8_SB(1, 1), cB + hstep + kstep, voffB);
        PG8_WAIT_V(6); PG8_BAR;
    } else {
        PG8_STAGE(PG8_SB(0, 0), cB, voffB); PG8_STAGE(PG8_SA(0, 0), cA, voffA); PG8_STAGE(PG8_SB(0, 1), cB + hstep, voffB); PG8_STAGE(PG8_SA(0, 1), cA + hstep, voffA);
        if (wr == 1) PG8_BAR;
        PG8_WAIT_V(4); PG8_BAR;
        PG8_STAGE(PG8_SB(1, 0), cB + kstep, voffB); PG8_STAGE(PG8_SA(1, 0), cA + kstep, voffA); PG8_STAGE(PG8_SB(1, 1), cB + hstep + kstep, voffB);
        PG8_WAIT_V(6); PG8_BAR;
    }
    for (;;) {
        const bool has_next = S.next(ui + 1, nxt);
        const char* nA = has_next ? (const char*)g.A + (size_t)nxt.pm * tstep : cA; const char* nB = has_next ? (const char*)g.Bt + (size_t)nxt.pn * tstep : cB;
        for (int t = 0; t < nt; t += 2) {
            const bool last = (t == nt - 2);
            const char* a1 = cA + (size_t)(t + 1) * kstep;
            const char* a2 = last ? nA : cA + (size_t)(t + 2) * kstep; const char* b2 = last ? nB : cB + (size_t)(t + 2) * kstep;
            const char* a3 = a2 + kstep; const char* b3 = b2 + kstep;
            if (last && has_next) S.a_ready(nxt);
            if constexpr (SP2) {
            PG8_LDB(B0, 0, 0); PG8_LDB(B1, 0, 1); PG8_SCHED; PG8_LDA(At, 0, 0); PG8_STAGE(PG8_SA(1, 1), a1 + hstep, voffA);
            PG8_WAIT_V(8); PG8_WAIT_L(0); PG8_BAR; PG8_MMA(0, 0, At, B0); PG8_MMA(0, 1, At, B1); PG8_BAR; PG8_SCHED;
            PG8_LDA(At, 0, 1); PG8_STAGE(PG8_SB(0, 0), b2, voffB); PG8_STAGE(PG8_SB(0, 1), b2 + hstep, voffB); PG8_STAGE(PG8_SA(0, 0), a2, voffA);
            PG8_WAIT_V(8); PG8_WAIT_L(0); PG8_BAR; PG8_MMA(1, 0, At, B0); PG8_MMA(1, 1, At, B1); PG8_BAR; PG8_SCHED;
            PG8_LDB(B0, 1, 0); PG8_LDB(B1, 1, 1); PG8_SCHED; PG8_LDA(At, 1, 0); PG8_STAGE(PG8_SA(0, 1), a2 + hstep, voffA);
            PG8_WAIT_V(8); PG8_WAIT_L(0); PG8_BAR; PG8_MMA(0, 0, At, B0); PG8_MMA(0, 1, At, B1); PG8_BAR; PG8_SCHED;
            PG8_LDA(At, 1, 1); PG8_STAGE(PG8_SB(1, 0), b3, voffB); PG8_STAGE(PG8_SB(1, 1), b3 + hstep, voffB); PG8_STAGE(PG8_SA(1, 0), a3, voffA);
            PG8_WAIT_V(8); PG8_WAIT_L(0); PG8_BAR; PG8_MMA(1, 0, At, B0); PG8_MMA(1, 1, At, B1); PG8_BAR; PG8_SCHED;
            } else {
            PG8_LDB(B0, 0, 0); PG8_SCHED; PG8_LDA(At, 0, 0); PG8_STAGE(PG8_SA(1, 1), a1 + hstep, voffA);
            PG8_WAIT_L(8); PG8_BAR; PG8_WAIT_L(0); PG8_MMA(0, 0, At, B0); PG8_BAR; PG8_SCHED;
            PG8_LDB(B1, 0, 1); PG8_STAGE(PG8_SB(0, 0), b2, voffB);
            PG8_BAR; PG8_WAIT_L(0); PG8_MMA(0, 1, At, B1); PG8_BAR;
            PG8_LDA(At, 0, 1); PG8_STAGE(PG8_SA(0, 0), a2, voffA);
            PG8_BAR; PG8_WAIT_L(0); PG8_MMA(1, 0, At, B0); PG8_BAR; PG8_SCHED;
            PG8_STAGE(PG8_SB(0, 1), b2 + hstep, voffB);
            PG8_WAIT_V(6); PG8_BAR; PG8_MMA(1, 1, At, B1); PG8_BAR;
            PG8_LDB(B0, 1, 0); PG8_SCHED; PG8_LDA(At, 1, 0); PG8_STAGE(PG8_SA(0, 1), a2 + hstep, voffA);
            PG8_WAIT_L(8); PG8_BAR; PG8_WAIT_L(0); PG8_MMA(0, 0, At, B0); PG8_BAR; PG8_SCHED;
            PG8_LDB(B1, 1, 1); PG8_STAGE(PG8_SB(1, 0), b3, voffB);
            PG8_BAR; PG8_WAIT_L(0); PG8_MMA(0, 1, At, B1); PG8_BAR;
            PG8_LDA(At, 1, 1); PG8_STAGE(PG8_SA(1, 0), a3, voffA);
            PG8_BAR; PG8_WAIT_L(0); PG8_MMA(1, 0, At, B0); PG8_BAR; PG8_SCHED;
            PG8_STAGE(PG8_SB(1, 1), b3 + hstep, voffB);
            PG8_WAIT_V(6); PG8_BAR; PG8_MMA(1, 1, At, B1); PG8_BAR;
            }
        }
        if constexpr (ALIGN_EPI) { if (wr == 0) PG8_BAR; }
        if constexpr (!Epi::AFTER_DRAIN) { E(acc, cur, wr, wc, fr, fq); S.done(cur); }
        if (!has_next) break;
#pragma unroll
        for (int a = 0; a < 2; ++a)
#pragma unroll
            for (int b = 0; b < 2; ++b)
#pragma unroll
                for (int m = 0; m < 4; ++m)
#pragma unroll
                    for (int n = 0; n < 2; ++n) acc[a][b][m][n] = (f32x4){0.f, 0.f, 0.f, 0.f};
        cur = nxt; cA = nA; cB = nB; ++ui;
        if constexpr (ALIGN_EPI) { if (wr == 1) PG8_BAR; }
    }
    PG8_WAIT_V(0);
    if constexpr (!ALIGN_EPI) { if (wr == 0) PG8_BAR; }
    PG8_BAR;
    if constexpr (Epi::AFTER_DRAIN) { E.fused(acc, cur, wr, wc, fr, fq, lds, wid, lane); S.done(cur); }
#undef PG8_SA
#undef PG8_SB
#undef PG8_STAGE
#undef PG8_LDA
#undef PG8_LDB
#undef PG8_MMA
#undef PG8_WAIT_V
#undef PG8_WAIT_L
#undef PG8_BAR
#undef PG8_SCHED
}
}

#define LAS __attribute__((address_space(3)))
using pg8::bf16_t; using pg8::bf16x8; using pg8::f32x4; using pg8::u32x4; using pg8::Unit;
typedef float f32x16 __attribute__((ext_vector_type(16)));
typedef float f32x2_t __attribute__((ext_vector_type(2)));
typedef __bf16 bf16x2_t __attribute__((ext_vector_type(2)));
typedef unsigned u32x2 __attribute__((ext_vector_type(2)));
#define MFMA32(a, b, c) __builtin_amdgcn_mfma_f32_32x32x16_bf16((a), (b), (c), 0, 0, 0)

constexpr int BATCH = 4, SEQ = 8192, DM = 1024, MTOK = BATCH * SEQ, FF = 4096, NQKV0 = 3072, NQKV1 = 2304, D1 = 768;
constexpr float ALPHA = 1.41421356237309505f, LN_EPS = 1e-5f, QSCALE = 0.125f * 1.4426950408889634f;
constexpr int NWAVES = 8, NTHR = 512;
constexpr int LIST_CAP = 126976;

constexpr size_t MiB = 1u << 20;
constexpr size_t WS_CTL = 0, CTL_BYTES = 2 * MiB;
constexpr size_t WS_KM = 128 * 1024, WS_BAR = 16 * 1024;
constexpr size_t WS_COS = 505 * MiB, WS_SIN = 506 * MiB;
constexpr size_t WS_C12 = 640 * 1024, WS_ST = 1 * MiB;
constexpr int NC12 = 4096 + 4096 + 2304, C_WIN0 = 0, C_WIN1 = 4096, C_QKV1 = 8192;
constexpr size_t WS_WQKV0 = 3 * MiB, WS_WO0 = 9 * MiB, WS_WQKV1 = 11 * MiB, WS_WO1 = 15 * MiB + 512 * 1024, WS_WIN0 = 17 * MiB, WS_WOUT0 = 25 * MiB, WS_WIN1 = 33 * MiB, WS_WOUT1 = 41 * MiB;
constexpr size_t WS_HB = 49 * MiB;
constexpr size_t WS_Q = 113 * MiB, WS_K = 177 * MiB, WS_VT = 241 * MiB, WS_PO = 305 * MiB, WS_PL = 497 * MiB;
constexpr size_t WS_H = 113 * MiB, WS_Z = 369 * MiB, WS_HB2 = 433 * MiB;
constexpr size_t WS_Q1 = 113 * MiB, WS_K1 = 161 * MiB, WS_VT1 = 209 * MiB, WS_PO1 = 257 * MiB, WS_PL1 = 305 * MiB;
constexpr size_t WS_DUMP = 401 * MiB, WS_END = 507 * MiB;
constexpr size_t OUT_PO3 = 0, OUT_LIST = 64 * MiB;

#ifndef DUPU
#define DUPU 1
#endif
#ifndef DUPQ0
#define DUPQ0 1
#endif
#ifndef DUPQ1
#define DUPQ1 1
#endif
#ifndef DUPG
#define DUPG 1
#endif
#ifndef G_ALIGN
#define G_ALIGN true
#endif
#ifndef G_SP2
#define G_SP2 true
#endif
#ifndef PHM
#define PHM 0xFFFFFFFFu
#endif
constexpr int RING_BYTES = 131072, LDS_BYTES = 147456, LDS_MISC = LDS_BYTES - 1024;

__device__ __forceinline__ unsigned pk2(float lo, float hi) { f32x2_t v = {lo, hi}; bf16x2_t b = __builtin_convertvector(v, bf16x2_t); return __builtin_bit_cast(unsigned, b); }
__device__ __forceinline__ float bf_lo(unsigned u) { return __uint_as_float(u << 16); }
__device__ __forceinline__ float bf_hi(unsigned u) { return __uint_as_float(u & 0xffff0000u); }
__device__ __forceinline__ int crow(int i, int hh) { return (i & 3) + 8 * (i >> 2) + 4 * hh; }
__device__ __forceinline__ float wave_sum(float v) {
#pragma unroll
    for (int o = 1; o < 64; o <<= 1) v += __shfl_xor(v, o);
    return v;
}
#define LDS_WAIT() asm volatile("s_waitcnt lgkmcnt(0)" ::: "memory")
__device__ __forceinline__ int qkv_phys(int c) { return (c & ~255) + ((c & 32) ? 128 : 0) + (((c >> 6) & 3) << 5) + (c & 31); }
__device__ __forceinline__ int swz16(int r) { return (r & ~12) | ((r & 4) << 1) | ((r & 8) >> 1); }

#define ROW_STATS(st_, row_, mu_, rs_) do { const f32x2_t sv_ = *(const f32x2_t*)((st_) + (size_t)(row_) * 2); (mu_) = sv_.x * (1.0f / DM); (rs_) = 1.0f / sqrtf(sv_.y * (1.0f / DM) - (mu_) * (mu_) + LN_EPS); } while (0)
template <int LAYER> struct EpiQKV {
    static constexpr bool PERM = true, AFTER_DRAIN = false;
    bf16_t* Q; bf16_t* Kb; bf16_t* VT; float* KM; const float* cs; const float* sn; const float* st; const float* c1; const float* c2;
    __device__ __forceinline__ void operator()(const f32x4 (&acc)[2][2][4][2], const Unit& u, int wr, int wc, int fr, int fq) const {
        constexpr int NT = LAYER == 0 ? 4 : 3, PITCH = NT * 256, NH = NT * 4;
        const int which = u.pn / NT, hg = u.pn - which * NT, head = hg * 4 + wc, e0 = 8 * fq;
        const int dsh = LAYER == 0 ? 0 : 2 * hg;
        const int rowb = u.pm * 256 + wr * 64 + fr;
        f32x4 c1v[2][2], c2v[2][2]; f32x2_t svc = {0.f, 0.f}, svn = {0.f, 0.f};
        if (LAYER == 1) {
#pragma unroll
            for (int bj = 0; bj < 2; ++bj)
#pragma unroll
                for (int n = 0; n < 2; ++n) { const int cc = u.pn * 256 + bj * 128 + wc * 32 + e0 + 4 * n; c1v[bj][n] = *(const f32x4*)(c1 + cc); c2v[bj][n] = *(const f32x4*)(c2 + cc); }
            svc = *(const f32x2_t*)(st + (size_t)rowb * 2);
        }
#define QKV_AFF(a_, bj_, n_) (LAYER == 1 ? ((a_) - mu * c1v[bj_][n_]) * rstd + c2v[bj_][n_] : (a_))
        if (which < 2) {
            bf16_t* dst = which == 0 ? Q : Kb; const float sc = which == 0 ? QSCALE : 1.f;
            f32x4 ks[2][2];
#pragma unroll
            for (int a = 0; a < 2; ++a)
#pragma unroll
                for (int b = 0; b < 2; ++b) ks[a][b] = (f32x4){0.f, 0.f, 0.f, 0.f};
            f32x4 tc[4], tn[4];
            { const int t = rowb & 8191; tc[0] = *(const f32x4*)(cs + t * 32 + e0); tc[1] = *(const f32x4*)(cs + t * 32 + e0 + 4); tc[2] = *(const f32x4*)(sn + t * 32 + e0); tc[3] = *(const f32x4*)(sn + t * 32 + e0 + 4); }
#pragma unroll
            for (int q = 0; q < 8; ++q) {
                const int ai = q >> 2, m = q & 3;
                const int row = rowb + ai * 128 + m * 16, b = row >> 13, t = row & 8191;
                if (q + 1 < 8) { const int t2 = (rowb + ((q + 1) >> 2) * 128 + ((q + 1) & 3) * 16) & 8191;
                    tn[0] = *(const f32x4*)(cs + t2 * 32 + e0); tn[1] = *(const f32x4*)(cs + t2 * 32 + e0 + 4); tn[2] = *(const f32x4*)(sn + t2 * 32 + e0); tn[3] = *(const f32x4*)(sn + t2 * 32 + e0 + 4);
                    if (LAYER == 1) svn = *(const f32x2_t*)(st + (size_t)(rowb + ((q + 1) >> 2) * 128 + ((q + 1) & 3) * 16) * 2); }
                const int rr = ((t & ((1 << dsh) - 1)) << (13 - dsh)) | (t >> dsh);
                const f32x4 c0 = tc[0], c1_ = tc[1], s0 = tc[2], s1 = tc[3];
                const float mu = LAYER == 1 ? svc.x * (1.0f / DM) : 0.f, rstd = LAYER == 1 ? 1.0f / sqrtf(svc.y * (1.0f / DM) - mu * mu + LN_EPS) : 1.f;
                const f32x4 x1a = QKV_AFF(acc[ai][0][m][0], 0, 0), x1b = QKV_AFF(acc[ai][0][m][1], 0, 1), x2a = QKV_AFF(acc[ai][1][m][0], 1, 0), x2b = QKV_AFF(acc[ai][1][m][1], 1, 1);
                const f32x4 o1a = (x1a * c0 - x2a * s0) * sc, o1b = (x1b * c1_ - x2b * s1) * sc, o2a = (x2a * c0 + x1a * s0) * sc, o2b = (x2b * c1_ + x1b * s1) * sc;
                bf16_t* p = dst + (size_t)(b * 8192 + rr) * PITCH + head * 64 + e0;
                u32x4 w; w.x = pk2(o1a[0], o1a[1]); w.y = pk2(o1a[2], o1a[3]); w.z = pk2(o1b[0], o1b[1]); w.w = pk2(o1b[2], o1b[3]);
                __builtin_nontemporal_store(w, (u32x4*)p);
                w.x = pk2(o2a[0], o2a[1]); w.y = pk2(o2a[2], o2a[3]); w.z = pk2(o2b[0], o2b[1]); w.w = pk2(o2b[2], o2b[3]);
                __builtin_nontemporal_store(w, (u32x4*)(p + 32));
                if (LAYER == 0 && which == 1) { ks[0][0] += o1a; ks[0][1] += o1b; ks[1][0] += o2a; ks[1][1] += o2b; }
                asm volatile("" ::: "memory");
#pragma unroll
                for (int k = 0; k < 4; ++k) tc[k] = tn[k];
                svc = svn;
            }
            if (LAYER == 0 && which == 1) {
                const int b = u.pm >> 5, blk = u.pm & 31;
                float* kmp = KM + ((size_t)((b * 16 + head) * 32 + blk)) * 64; float kmv = 0.f;
#pragma unroll
                for (int a = 0; a < 2; ++a)
#pragma unroll
                    for (int n = 0; n < 2; ++n)
#pragma unroll
                        for (int i = 0; i < 4; ++i) {
                            float v = ks[a][n][i];
                            v += __shfl_xor(v, 1); v += __shfl_xor(v, 2); v += __shfl_xor(v, 4); v += __shfl_xor(v, 8);
                            if (fr == a * 8 + n * 4 + i) kmv = v;
                        }
                __hip_atomic_fetch_add(kmp + (fr >> 3) * 32 + e0 + (fr & 7), kmv * (1.0f / 256.0f), __ATOMIC_RELAXED, __HIP_MEMORY_SCOPE_AGENT);
            }
        } else {
#pragma unroll
            for (int q = 0; q < 8; ++q) {
                const int ai = q >> 2, m = q & 3;
                const int row = rowb + ai * 128 + m * 16, b = row >> 13, t = row & 8191;
                const int rr = ((t & ((1 << dsh) - 1)) << (13 - dsh)) | (t >> dsh);
                bf16_t* p = VT + ((size_t)(b * NH + head) * 64 + e0) * 8192 + swz16(rr);
                if (LAYER == 1 && q + 1 < 8) svn = *(const f32x2_t*)(st + (size_t)(rowb + ((q + 1) >> 2) * 128 + ((q + 1) & 3) * 16) * 2);
                const float mu = LAYER == 1 ? svc.x * (1.0f / DM) : 0.f, rstd = LAYER == 1 ? 1.0f / sqrtf(svc.y * (1.0f / DM) - mu * mu + LN_EPS) : 1.f;
#pragma unroll
                for (int bj = 0; bj < 2; ++bj)
#pragma unroll
                    for (int n = 0; n < 2; ++n) { const f32x4 yv = QKV_AFF(acc[ai][bj][m][n], bj, n);
#pragma unroll
                        for (int i = 0; i < 4; ++i) p[(size_t)(bj * 32 + 4 * n + i) * 8192] = (bf16_t)(pk2(yv[i], 0.f) & 0xffffu); }
                svc = svn;
            }
        }
#undef QKV_AFF
    }
};
struct EpiSqRelu {
    static constexpr bool PERM = true, AFTER_DRAIN = false;
    bf16_t* O; int ldc; const float* st; const float* c1; const float* c2;
    __device__ __forceinline__ void operator()(const f32x4 (&acc)[2][2][4][2], const Unit& u, int wr, int wc, int fr, int fq) const {
        const int row0 = u.pm * 256 + wr * 64 + fr, col0 = u.pn * 256 + wc * 32 + 8 * fq;
        f32x4 c1v[2][2], c2v[2][2]; float mus[8], rss[8];
#pragma unroll
        for (int bj = 0; bj < 2; ++bj)
#pragma unroll
            for (int n = 0; n < 2; ++n) { c1v[bj][n] = *(const f32x4*)(c1 + col0 + bj * 128 + 4 * n); c2v[bj][n] = *(const f32x4*)(c2 + col0 + bj * 128 + 4 * n); }
#pragma unroll
        for (int q = 0; q < 8; ++q) ROW_STATS(st, row0 + (q >> 2) * 128 + (q & 3) * 16, mus[q], rss[q]);
#pragma unroll
        for (int ai = 0; ai < 2; ++ai)
#pragma unroll
            for (int m = 0; m < 4; ++m) { const int row = row0 + ai * 128 + m * 16; bf16_t* rowp = O + (size_t)row * ldc + col0;
                const float mu = mus[ai * 4 + m], rstd = rss[ai * 4 + m];
#pragma unroll
                for (int bj = 0; bj < 2; ++bj) { f32x4 v0 = (acc[ai][bj][m][0] - mu * c1v[bj][0]) * rstd + c2v[bj][0], v1 = (acc[ai][bj][m][1] - mu * c1v[bj][1]) * rstd + c2v[bj][1];
#pragma unroll
                    for (int i = 0; i < 4; ++i) { const float a = fmaxf(v0[i], 0.f), b = fmaxf(v1[i], 0.f); v0[i] = a * a; v1[i] = b * b; }
                    u32x4 w; w.x = pk2(v0[0], v0[1]); w.y = pk2(v0[2], v0[3]); w.z = pk2(v1[0], v1[1]); w.w = pk2(v1[2], v1[3]);
                    __builtin_nontemporal_store(w, (u32x4*)(rowp + bj * 128)); } }
    }
};
template <int MODE> struct EpiResid {
    static constexpr bool PERM = true, AFTER_DRAIN = false;
    const bf16_t* R; bf16_t* Z; const float* stp; float* stc; const float* g; const float* b;
    __device__ __forceinline__ void operator()(const f32x4 (&acc)[2][2][4][2], const Unit& u, int wr, int wc, int fr, int fq) const {
        const int row0 = u.pm * 256 + wr * 64 + fr, col0 = u.pn * 256 + wc * 32 + 8 * fq;
        const bf16_t* src = MODE == 1 ? (const bf16_t*)Z : R;
        f32x4 gv[2][2], bv[2][2]; f32x2_t svc = {0.f, 0.f}, svn = {0.f, 0.f};
        u32x4 rc[2], rn[2]; float sq[8];
        rc[0] = *(const u32x4*)(src + (size_t)row0 * DM + col0); rc[1] = *(const u32x4*)(src + (size_t)row0 * DM + col0 + 128);
        if (MODE == 1) {
#pragma unroll
            for (int bj = 0; bj < 2; ++bj)
#pragma unroll
                for (int n = 0; n < 2; ++n) { gv[bj][n] = *(const f32x4*)(g + col0 + bj * 128 + 4 * n); bv[bj][n] = *(const f32x4*)(b + col0 + bj * 128 + 4 * n); }
            svc = *(const f32x2_t*)(stp + (size_t)row0 * 2);
        }
#pragma unroll
        for (int q = 0; q < 8; ++q) {
            const int ai = q >> 2, m = q & 3, row = row0 + ai * 128 + m * 16; const size_t off = (size_t)row * DM + col0;
            if (q + 1 < 8) { const int row2 = row0 + ((q + 1) >> 2) * 128 + ((q + 1) & 3) * 16; const size_t off2 = (size_t)row2 * DM + col0; rn[0] = *(const u32x4*)(src + off2); rn[1] = *(const u32x4*)(src + off2 + 128);
                if (MODE == 1) svn = *(const f32x2_t*)(stp + (size_t)row2 * 2); }
            const float mu = MODE == 1 ? svc.x * (1.0f / DM) : 0.f, rstd = MODE == 1 ? 1.0f / sqrtf(svc.y * (1.0f / DM) - mu * mu + LN_EPS) : 1.f;
            float s1 = 0.f, s2 = 0.f;
#pragma unroll
            for (int bj = 0; bj < 2; ++bj) { const u32x4 rv = rc[bj];
                f32x4 h0 = (f32x4){bf_lo(rv.x), bf_hi(rv.x), bf_lo(rv.y), bf_hi(rv.y)}, h1 = (f32x4){bf_lo(rv.z), bf_hi(rv.z), bf_lo(rv.w), bf_hi(rv.w)};
                if (MODE == 1) { h0 = (h0 - mu) * rstd * gv[bj][0] + bv[bj][0]; h1 = (h1 - mu) * rstd * gv[bj][1] + bv[bj][1]; }
                const f32x4 z0 = ALPHA * h0 + acc[ai][bj][m][0], z1 = ALPHA * h1 + acc[ai][bj][m][1];
                u32x4 w; w.x = pk2(z0[0], z0[1]); w.y = pk2(z0[2], z0[3]); w.z = pk2(z1[0], z1[1]); w.w = pk2(z1[2], z1[3]);
                *(u32x4*)(Z + off + bj * 128) = w;
                const float r0 = bf_lo(w.x), r1 = bf_hi(w.x), r2 = bf_lo(w.y), r3 = bf_hi(w.y), r4 = bf_lo(w.z), r5 = bf_hi(w.z), r6 = bf_lo(w.w), r7 = bf_hi(w.w);
                s1 += ((r0 + r1) + (r2 + r3)) + ((r4 + r5) + (r6 + r7));
                s2 += ((r0 * r0 + r1 * r1) + (r2 * r2 + r3 * r3)) + ((r4 * r4 + r5 * r5) + (r6 * r6 + r7 * r7)); }
            s1 += __shfl_xor(s1, 16); s1 += __shfl_xor(s1, 32); s2 += __shfl_xor(s2, 16); s2 += __shfl_xor(s2, 32);
            sq[q] = (fq & 1) ? s2 : s1;
            asm volatile("" ::: "memory");
            rc[0] = rn[0]; rc[1] = rn[1]; svc = svn;
        }
#pragma unroll
        for (int p = 0; p < 4; ++p) {
            const int qa = 2 * p, qb = 2 * p + 1;
            const float val = (fq < 2) ? sq[qa] : sq[qb];
            const int rowp = row0 + ((fq < 2) ? ((qa >> 2) * 128 + (qa & 3) * 16) : ((qb >> 2) * 128 + (qb & 3) * 16));
            __hip_atomic_fetch_add(stc + (size_t)rowp * 2 + (fq & 1), val, __ATOMIC_RELAXED, __HIP_MEMORY_SCOPE_AGENT);
        }
    }
};

template <bool PERMQ, bool SCALED> __device__ __forceinline__ void transpose_item(const float* W, int K, int N, bf16_t* WT, LAS float* scr, int item, int lane, const float* gk, const float* bk, float* c1, float* c2) {
    const int nblk = N / 32, kb = item / nblk, nb = item % nblk, k0 = 64 * kb, n0 = 32 * nb;
    float p1 = 0.f, p2 = 0.f;
#pragma unroll 8
    for (int i = 0; i < 32; ++i) { const int kk = 2 * i + (lane >> 5); float v = W[(size_t)(k0 + kk) * N + n0 + (lane & 31)];
        if (SCALED) { p2 += v * bk[k0 + kk]; v *= gk[k0 + kk]; p1 += bf_lo(pk2(v, 0.f)); }
        scr[kk * 33 + (lane & 31)] = v; }
    LDS_WAIT();
    if (SCALED) { p1 += __shfl_xor(p1, 32); p2 += __shfl_xor(p2, 32);
        if (lane < 32) { const int oc = PERMQ ? qkv_phys(n0 + lane) : (n0 + lane); __hip_atomic_fetch_add(c1 + oc, p1, __ATOMIC_RELAXED, __HIP_MEMORY_SCOPE_AGENT); __hip_atomic_fetch_add(c2 + oc, p2, __ATOMIC_RELAXED, __HIP_MEMORY_SCOPE_AGENT); } }
    const int c = lane & 7;
#pragma unroll
    for (int j = 0; j < 4; ++j) { const int n = (lane >> 3) + 8 * j; const LAS float* sp = scr + (8 * c) * 33 + n;
        u32x4 o; o.x = pk2(sp[0 * 33], sp[1 * 33]); o.y = pk2(sp[2 * 33], sp[3 * 33]); o.z = pk2(sp[4 * 33], sp[5 * 33]); o.w = pk2(sp[6 * 33], sp[7 * 33]);
        const int orow = PERMQ ? qkv_phys(n0 + n) : (n0 + n);
        *(u32x4*)(WT + (size_t)orow * K + k0 + 8 * c) = o; }
    LDS_WAIT();
}

template <bool F32OUT> __device__ __forceinline__ void ln_phase(const bf16_t* Z, const float* g, const float* bt, bf16_t* ob, float* of, int gw, int ngw, int lane) {
    f32x4 gv[4], bv[4];
#pragma unroll
    for (int q = 0; q < 2; ++q) { gv[2 * q] = *(const f32x4*)(g + 512 * q + 8 * lane); gv[2 * q + 1] = *(const f32x4*)(g + 512 * q + 8 * lane + 4);
                                  bv[2 * q] = *(const f32x4*)(bt + 512 * q + 8 * lane); bv[2 * q + 1] = *(const f32x4*)(bt + 512 * q + 8 * lane + 4); }
    for (int row = gw; row < MTOK; row += ngw) {
        const bf16_t* zr = Z + (size_t)row * DM + 8 * lane;
        const u32x4 a = *(const u32x4*)zr, b = *(const u32x4*)(zr + 512);
        float v[16] = {bf_lo(a.x), bf_hi(a.x), bf_lo(a.y), bf_hi(a.y), bf_lo(a.z), bf_hi(a.z), bf_lo(a.w), bf_hi(a.w),
                       bf_lo(b.x), bf_hi(b.x), bf_lo(b.y), bf_hi(b.y), bf_lo(b.z), bf_hi(b.z), bf_lo(b.w), bf_hi(b.w)};
        float s = 0.f;
#pragma unroll
        for (int i = 0; i < 16; ++i) s += v[i];
        const float mean = wave_sum(s) * (1.0f / DM);
        float q = 0.f;
#pragma unroll
        for (int i = 0; i < 16; ++i) { v[i] -= mean; q += v[i] * v[i]; }
        const float rstd = 1.0f / sqrtf(wave_sum(q) * (1.0f / DM) + LN_EPS);
#pragma unroll
        for (int i = 0; i < 16; ++i) v[i] = v[i] * rstd * gv[i >> 2][i & 3] + bv[i >> 2][i & 3];
        if (F32OUT) {
            float* orow = of + (size_t)row * DM + 8 * lane;
            __builtin_nontemporal_store((f32x4){v[0], v[1], v[2], v[3]}, (f32x4*)orow); __builtin_nontemporal_store((f32x4){v[4], v[5], v[6], v[7]}, (f32x4*)(orow + 4));
            __builtin_nontemporal_store((f32x4){v[8], v[9], v[10], v[11]}, (f32x4*)(orow + 512)); __builtin_nontemporal_store((f32x4){v[12], v[13], v[14], v[15]}, (f32x4*)(orow + 516));
        } else {
            bf16_t* orow = ob + (size_t)row * DM + 8 * lane;
            u32x4 w; w.x = pk2(v[0], v[1]); w.y = pk2(v[2], v[3]); w.z = pk2(v[4], v[5]); w.w = pk2(v[6], v[7]); *(u32x4*)orow = w;
            w.x = pk2(v[8], v[9]); w.y = pk2(v[10], v[11]); w.z = pk2(v[12], v[13]); w.w = pk2(v[14], v[15]); *(u32x4*)(orow + 512) = w;
        }
    }
}

constexpr int KPB = 144;
template <int NKT, int MODE, int GT>
__device__ __forceinline__ void attn_rows(const LAS unsigned char* Kl, const LAS unsigned char* Vl, const int vpb, const bf16x8 (&qf)[4], const int r, const int hh, const int p0, const int p1,
                                          f32x16 (&o)[2], float& lse2) {
    constexpr int NG = (NKT + GT - 1) / GT;
    float mrun = -INFINITY, lrun = 0.f;
#pragma unroll
    for (int i = 0; i < 16; ++i) { o[0][i] = 0.f; o[1][i] = 0.f; }
#pragma unroll
    for (int grp = 0; grp < NG; ++grp) {
        constexpr int dummy = 0; (void)dummy;
        const int kt0 = grp * GT;
        const int nt = (NKT - kt0) < GT ? (NKT - kt0) : GT;
        const bool gact = MODE == 0 ? true : (MODE == 1 ? (kt0 <= p0) : (p1 != 0 || (p0 + kt0 + nt - 1 >= 4)));
        if (gact) {
            bf16x8 kf[GT][4];
#pragma unroll
            for (int q = 0; q < GT; ++q)
#pragma unroll
                for (int ks = 0; ks < 4; ++ks) if (q < nt) kf[q][ks] = *(const LAS bf16x8*)(Kl + ((kt0 + q) * 32 + r) * KPB + ks * 32 + hh * 16);
            f32x16 s[GT];
#pragma unroll
            for (int q = 0; q < GT; ++q)
#pragma unroll
                for (int i = 0; i < 16; ++i) s[q][i] = 0.f;
#pragma unroll
            for (int ks = 0; ks < 4; ++ks)
#pragma unroll
                for (int q = 0; q < GT; ++q) if (q < nt) s[q] = MFMA32(kf[q][ks], qf[ks], s[q]);
            bf16x8 vf[GT][2][2];
#pragma unroll
            for (int q = 0; q < GT; ++q)
#pragma unroll
                for (int s2 = 0; s2 < 2; ++s2)
#pragma unroll
                    for (int dt = 0; dt < 2; ++dt) if (q < nt) vf[q][s2][dt] = *(const LAS bf16x8*)(Vl + (dt * 32 + r) * vpb + ((kt0 + q) * 32 + s2 * 16 + hh * 8) * 2);
            if (MODE == 1) { if (p0 < 8) {
#pragma unroll
                for (int q = 0; q < GT; ++q) if (q < nt) { const int lim = (p0 - (kt0 + q)) * 32 + r;
#pragma unroll
                    for (int i = 0; i < 16; ++i) if (crow(i, hh) > lim) s[q][i] = -INFINITY; } } }
            if (MODE == 2) {
#pragma unroll
                for (int q = 0; q < GT; ++q) if (q < nt) { const int kt = kt0 + q;
                    if (kt == 0) {
#pragma unroll
                        for (int i = 0; i < 16; ++i) if (crow(i, hh) < r) s[q][i] = -INFINITY; }
                    if (kt == NKT - 1) {
#pragma unroll
                        for (int i = 0; i < 16; ++i) if (crow(i, hh) > r) s[q][i] = -INFINITY; } }
                if (p1 == 0) {
#pragma unroll
                    for (int q = 0; q < GT; ++q) if (q < nt) { if (p0 + kt0 + q < 4) {
#pragma unroll
                        for (int i = 0; i < 16; ++i) s[q][i] = -INFINITY; } } }
            }
            float mx = -INFINITY;
#pragma unroll
            for (int q = 0; q < GT; ++q) if (q < nt) {
#pragma unroll
                for (int i = 0; i < 16; ++i) mx = fmaxf(mx, s[q][i]); }
            mx = fmaxf(mx, __shfl_xor(mx, 32));
            const float mnew = fmaxf(mrun, mx);
            const float sc = __builtin_amdgcn_exp2f(mrun - mnew);
            mrun = mnew; lrun *= sc;
            if (grp > 0) {
#pragma unroll
                for (int i = 0; i < 16; ++i) { o[0][i] *= sc; o[1][i] *= sc; }
            }
#pragma unroll
            for (int q = 0; q < GT; ++q) if (q < nt) {
#pragma unroll
                for (int i = 0; i < 16; ++i) { const float p = __builtin_amdgcn_exp2f(s[q][i] - mnew); s[q][i] = p; lrun += p; }
#pragma unroll
                for (int s2 = 0; s2 < 2; ++s2) {
                    u32x4 pw; pw.x = pk2(s[q][8 * s2], s[q][8 * s2 + 1]); pw.y = pk2(s[q][8 * s2 + 2], s[q][8 * s2 + 3]); pw.z = pk2(s[q][8 * s2 + 4], s[q][8 * s2 + 5]); pw.w = pk2(s[q][8 * s2 + 6], s[q][8 * s2 + 7]);
                    const bf16x8 pf = __builtin_bit_cast(bf16x8, pw);
#pragma unroll
                    for (int dt = 0; dt < 2; ++dt) o[dt] = MFMA32(vf[q][s2][dt], pf, o[dt]);
                }
            }
        }
    }
    const float l = lrun + __shfl_xor(lrun, 32);
    const float inv = 1.0f / l;
#pragma unroll
    for (int i = 0; i < 16; ++i) { o[0][i] *= inv; o[1][i] *= inv; }
    lse2 = mrun + __builtin_amdgcn_logf(l);
}
__device__ __forceinline__ void store_o(bf16_t* dst, const f32x16 (&o)[2], int hh) {
#pragma unroll
    for (int dt = 0; dt < 2; ++dt)
#pragma unroll
        for (int g4 = 0; g4 < 4; ++g4) { u32x2 w; w.x = pk2(o[dt][4 * g4], o[dt][4 * g4 + 1]); w.y = pk2(o[dt][4 * g4 + 2], o[dt][4 * g4 + 3]); *(u32x2*)(dst + dt * 32 + 8 * g4 + 4 * hh) = w; }
}

constexpr int STG_PITCH = 144, STG_WAVE = 32 * STG_PITCH;
__device__ __forceinline__ void stage_o(LAS unsigned char* stg, const f32x16 (&o)[2], int r, int hh) {
#pragma unroll
    for (int dt = 0; dt < 2; ++dt)
#pragma unroll
        for (int g4 = 0; g4 < 4; ++g4) { u32x2 w; w.x = pk2(o[dt][4 * g4], o[dt][4 * g4 + 1]); w.y = pk2(o[dt][4 * g4 + 2], o[dt][4 * g4 + 3]); *(LAS u32x2*)(stg + r * STG_PITCH + dt * 64 + g4 * 16 + hh * 8) = w; }
    LDS_WAIT();
}
constexpr int STG8_PITCH = 80; constexpr float PO8_SCALE = 16.0f;
__device__ __forceinline__ void stage_o8(LAS unsigned char* stg, const f32x16 (&o)[2], int r, int hh) {
#pragma unroll
    for (int dt = 0; dt < 2; ++dt)
#pragma unroll
        for (int g4 = 0; g4 < 4; ++g4) {
            int w = __builtin_amdgcn_cvt_pk_fp8_f32(o[dt][4 * g4] * PO8_SCALE, o[dt][4 * g4 + 1] * PO8_SCALE, 0, false);
            w = __builtin_amdgcn_cvt_pk_fp8_f32(o[dt][4 * g4 + 2] * PO8_SCALE, o[dt][4 * g4 + 3] * PO8_SCALE, w, true);
            *(LAS int*)(stg + r * STG8_PITCH + dt * 32 + g4 * 8 + hh * 4) = w; }
    LDS_WAIT();
}
#define XB_TMO      128
#define XB_XCNT(j)  (256  + 64 * (j))
#define XB_XSUB(j)  (1280 + 64 * (j))
#define XB_XGEN(j)  (2304 + 64 * (j))
#define XB_TOP      3328
#define XB_TOPGEN   3392
#define XCD_BAR_WORDS 3456
#define XB_SPIN_CAP (1u << 18)

__device__ __forceinline__ unsigned xb_ld(unsigned* p)              { return __hip_atomic_load(p, __ATOMIC_RELAXED, __HIP_MEMORY_SCOPE_AGENT); }
__device__ __forceinline__ unsigned xb_add(unsigned* p, unsigned v) { return __hip_atomic_fetch_add(p, v, __ATOMIC_RELAXED, __HIP_MEMORY_SCOPE_AGENT); }
__device__ __forceinline__ unsigned xb_xcc_id() { return (unsigned)__builtin_amdgcn_s_getreg((3 << 11) | 20) & 0xFu; }
#define XB_SPIN(cond, bar) do { unsigned _sp = 0; while (cond) { __builtin_amdgcn_s_sleep(1); \
    if ((++_sp & 255u) == 0u) { if (xb_ld(&(bar)[XB_TMO])) break; if (_sp > XB_SPIN_CAP) { atomicAdd(&(bar)[XB_TMO], 1u); break; } } } } while (0)

struct XcdBarrier {
    unsigned* bar; unsigned x;
    volatile LAS unsigned* st;
};

__device__ __forceinline__ XcdBarrier xcd_barrier_post(unsigned* bar, volatile LAS unsigned* st) {
    XcdBarrier b; b.bar = bar; b.x = xb_xcc_id(); b.st = st;
    if (threadIdx.x == 0) (void)xb_add(&bar[XB_XCNT(b.x)], 1u);
    return b;
}
__device__ __forceinline__ void xcd_barrier_complete(unsigned* bar, unsigned x, unsigned& nloc, unsigned& nx) {
    const unsigned G = gridDim.x * gridDim.y * gridDim.z;
    unsigned sum, cnt, mine, sp = 0u;
    for (;;) {
        sum = 0u; cnt = 0u; mine = 0u;
#pragma unroll
        for (unsigned j = 0; j < 16; ++j) { const unsigned c = xb_ld(&bar[XB_XCNT(j)]); sum += c; cnt += (c > 0u) ? 1u : 0u; mine = (j == x) ? c : mine; }
        if (sum == G) break;
        __builtin_amdgcn_s_sleep(1);
        if ((++sp & 255u) == 0u) { if (xb_ld(&bar[XB_TMO])) break; if (sp > XB_SPIN_CAP) { atomicAdd(&bar[XB_TMO], 1u); break; } }
    }
    nloc = mine > 0u ? mine : 1u; nx = cnt > 0u ? cnt : 1u;
}

__device__ __forceinline__ void xcd_barrier(const XcdBarrier& b) {
    asm volatile("s_waitcnt vmcnt(0)" ::: "memory");
    __syncthreads();
    if (threadIdx.x == 0) {
        unsigned* bar = b.bar;
        __builtin_amdgcn_s_waitcnt(0);
        unsigned nloc = b.st[0], nx = b.st[1];
        if (nloc == 0u) { xcd_barrier_complete(bar, b.x, nloc, nx); b.st[0] = nloc; b.st[1] = nx; }
        const unsigned old = xb_add(&bar[XB_XSUB(b.x)], 1u);
        const unsigned gen = old / nloc;
        if (old + 1u == (gen + 1u) * nloc) {
            __builtin_amdgcn_fence(__ATOMIC_RELEASE, "agent");
            asm volatile("s_waitcnt vmcnt(0)" ::: "memory");
            const unsigned og = xb_add(&bar[XB_TOP], 1u);
            const unsigned tg = og / nx;
            if (og + 1u == (tg + 1u) * nx) xb_add(&bar[XB_TOPGEN], 1u);
            else XB_SPIN(xb_ld(&bar[XB_TOPGEN]) == tg, bar);
            __builtin_amdgcn_fence(__ATOMIC_ACQUIRE, "agent");
            xb_add(&bar[XB_XGEN(b.x)], 1u);
            asm volatile("s_waitcnt vmcnt(0)" ::: "memory");
        } else {
            XB_SPIN(xb_ld(&bar[XB_XGEN(b.x)]) == gen, bar);
            __builtin_amdgcn_fence(__ATOMIC_ACQUIRE, "agent");
            asm volatile("s_waitcnt vmcnt(0)" ::: "memory");
        }
    }
    __syncthreads();
}

struct Args { const float* in[11]; float* out; unsigned char* ws; int pad0, pad1; };

__global__ void __launch_bounds__(NTHR) hybrid_fwd(Args args) {
    extern __shared__ __attribute__((aligned(16))) unsigned char lds_raw[];
    LAS unsigned char* lds = (LAS unsigned char*)lds_raw;
    cg::grid_group grid = cg::this_grid();
    int tid = threadIdx.x, lane = tid & 63, wave = __builtin_amdgcn_readfirstlane(tid >> 6);
    const int G = gridDim.x, ngw = G * NWAVES; int gw = blockIdx.x * NWAVES + wave;
#define GRID_SYNC_CG() do { grid.sync(); asm volatile("" : "+v"(tid), "+v"(lane)); } while (0)
#define GRID_SYNC() do { xcd_barrier(xbar); asm volatile("" : "+v"(tid), "+v"(lane)); } while (0)
    if (tid < 2) ((LAS unsigned*)(lds + LDS_MISC + 256))[tid] = 0u;
    __syncthreads();
    const XcdBarrier xbar = xcd_barrier_post((unsigned*)(args.ws + WS_BAR), (volatile LAS unsigned*)(lds + LDS_MISC + 256));
    unsigned char* ws = args.ws;
    const float* x = args.in[0];
    bf16_t* Wqkv0 = (bf16_t*)(ws + WS_WQKV0); bf16_t* Wo0 = (bf16_t*)(ws + WS_WO0); bf16_t* Wqkv1 = (bf16_t*)(ws + WS_WQKV1); bf16_t* Wo1 = (bf16_t*)(ws + WS_WO1);
    float* cosT = (float*)(ws + WS_COS); float* sinT = (float*)(ws + WS_SIN);
    bf16_t* HB = (bf16_t*)(ws + WS_HB); bf16_t* Zb = (bf16_t*)(ws + WS_Z); bf16_t* Hm = (bf16_t*)(ws + WS_H);
    float* C1 = (float*)(ws + WS_C12); float* C2 = C1 + NC12; float* ST = (float*)(ws + WS_ST);
    unsigned* gcnt = (unsigned*)(ws + WS_CTL); float* KM = (float*)(ws + WS_KM);
    unsigned* LIST = (unsigned*)((unsigned char*)args.out + OUT_LIST); bf16_t* PO3 = (bf16_t*)((unsigned char*)args.out + OUT_PO3);

    if (PHM & 1u) {
        LAS float* scr = (LAS float*)(lds + wave * 16384);
        constexpr int I_QKV0 = (DM / 64) * (NQKV0 / 32), I_WO0 = (DM / 64) * (DM / 32), I_QKV1 = (DM / 64) * (NQKV1 / 32), I_WO1 = (D1 / 64) * (DM / 32), I_IN = (DM / 64) * (FF / 32), I_OUT = (FF / 64) * (DM / 32);
        constexpr int NITEMS = I_QKV0 + I_WO0 + I_QKV1 + I_WO1 + 2 * I_IN + 2 * I_OUT;
        for (int it = gw; it < NITEMS; it += ngw) {
            int rI = it;
            if (rI < I_QKV0) { transpose_item<true, false>(args.in[1], DM, NQKV0, Wqkv0, scr, rI, lane, nullptr, nullptr, nullptr, nullptr); continue; } rI -= I_QKV0;
            if (rI < I_WO0) { transpose_item<false, false>(args.in[2], DM, DM, Wo0, scr, rI, lane, nullptr, nullptr, nullptr, nullptr); continue; } rI -= I_WO0;
            if (rI < I_QKV1) { transpose_item<true, true>(args.in[3], DM, NQKV1, Wqkv1, scr, rI, lane, args.in[9], args.in[10], C1 + C_QKV1, C2 + C_QKV1); continue; } rI -= I_QKV1;
            if (rI < I_WO1) { transpose_item<false, false>(args.in[4], D1, DM, Wo1, scr, rI, lane, nullptr, nullptr, nullptr, nullptr); continue; } rI -= I_WO1;
            if (rI < 2 * I_IN) { const int l = rI / I_IN; transpose_item<false, true>(args.in[5] + (size_t)l * DM * FF, DM, FF, (bf16_t*)(ws + (l ? WS_WIN1 : WS_WIN0)), scr, rI - l * I_IN, lane, args.in[7] + l * DM, args.in[8] + l * DM, C1 + (l ? C_WIN1 : C_WIN0), C2 + (l ? C_WIN1 : C_WIN0)); continue; } rI -= 2 * I_IN;
            { const int l = rI / I_OUT; transpose_item<false, false>(args.in[6] + (size_t)l * DM * FF, FF, DM, (bf16_t*)(ws + (l ? WS_WOUT1 : WS_WOUT0)), scr, rI - l * I_OUT, lane, nullptr, nullptr, nullptr, nullptr); }
        }
        for (int idx = blockIdx.x * NTHR + tid; idx < SEQ * 32; idx += G * NTHR) {
            const int t = idx >> 5, e = idx & 31;
            const float inv = 1.0f / powf(10000.0f, (float)(2 * e) / 64.0f);
            const float ang = (float)t * inv;
            const double a = (double)ang, kk = rint(a * 0.15915494309189535), rd = fma(-kk, 6.283185307179586, a);
            const float rf = (float)rd;
            cosT[idx] = cosf(rf); sinT[idx] = sinf(rf);
        }
        for (int row = gw; row < MTOK; row += ngw) {
            const float* xr = x + (size_t)row * DM + 8 * lane;
            const f32x4 a0 = __builtin_nontemporal_load((const f32x4*)xr), a1 = __builtin_nontemporal_load((const f32x4*)(xr + 4)), b0 = __builtin_nontemporal_load((const f32x4*)(xr + 512)), b1 = __builtin_nontemporal_load((const f32x4*)(xr + 516));
            bf16_t* orow = HB + (size_t)row * DM + 8 * lane;
            u32x4 w; w.x = pk2(a0[0], a0[1]); w.y = pk2(a0[2], a0[3]); w.z = pk2(a1[0], a1[1]); w.w = pk2(a1[2], a1[3]); *(u32x4*)orow = w;
            w.x = pk2(b0[0], b0[1]); w.y = pk2(b0[2], b0[3]); w.z = pk2(b1[0], b1[1]); w.w = pk2(b1[2], b1[3]); *(u32x4*)(orow + 512) = w;
        }
    }
    __syncthreads();
    if (args.pad1 != 0) GRID_SYNC_CG();
    GRID_SYNC();

    bf16_t* Q0 = (bf16_t*)(ws + WS_Q); bf16_t* K0 = (bf16_t*)(ws + WS_K); bf16_t* VT0 = (bf16_t*)(ws + WS_VT); bf16_t* PO = (bf16_t*)(ws + WS_PO); float* PL = (float*)(ws + WS_PL);
    if (PHM & 2u) {
        pg8::Gemm g{HB, Wqkv0, MTOK, NQKV0, DM}; pg8::StaticOrder S; S.init(MTOK, NQKV0, G, (int)blockIdx.x);
        EpiQKV<0> E{Q0, K0, VT0, KM, cosT, sinT, nullptr, nullptr, nullptr};
        for (int repg = 0; repg < DUPG * DUPQ0; ++repg) pg8::gemm_phase<EpiQKV<0>, pg8::StaticOrder, G_ALIGN, G_SP2>(lds, g, S, E);
    }
    GRID_SYNC();
    if (PHM & 4u) {
        LAS unsigned* lcnt = (LAS unsigned*)(lds + LDS_MISC); LAS unsigned* lbase = lcnt + 32;
        const int r = lane & 31, hh = lane >> 5;
        for (int unit = blockIdx.x; unit < BATCH * 32 * 16; unit += G) {
            const int h = unit & 15, qb = (unit >> 4) & 31, b = unit >> 9;
            if (tid < 32) lcnt[tid] = 0u;
            __syncthreads();
            const int tq = qb * 256 + wave * 32 + r, token = b * 8192 + tq;
            bf16x8 qf[4];
#pragma unroll
            for (int ks = 0; ks < 4; ++ks) qf[ks] = *(const bf16x8*)(Q0 + (size_t)token * DM + h * 64 + ks * 16 + hh * 8);
            f32x16 gt;
#pragma unroll
            for (int i = 0; i < 16; ++i) gt[i] = 0.f;
            const float* kmr = KM + ((size_t)((b * 16 + h) * 32 + r)) * 64 + hh * 8;
#pragma unroll
            for (int ks = 0; ks < 4; ++ks) { const f32x4 k0 = *(const f32x4*)(kmr + ks * 16), k1 = *(const f32x4*)(kmr + ks * 16 + 4);
                u32x4 kw; kw.x = pk2(k0[0], k0[1]); kw.y = pk2(k0[2], k0[3]); kw.z = pk2(k1[0], k1[1]); kw.w = pk2(k1[2], k1[3]);
                gt = MFMA32(__builtin_bit_cast(bf16x8, kw), qf[ks], gt); }
            float v0 = -3.0e38f, v1 = -3.0e38f, v2 = -3.0e38f;
#define TOP_INS(val) do { float t_ = (val); const float a_ = fmaxf(v0, t_); t_ = fminf(v0, t_); v0 = a_; const float b_ = fmaxf(v1, t_); t_ = fminf(v1, t_); v1 = b_; v2 = fmaxf(v2, t_); } while (0)
#pragma unroll
            for (int i = 0; i < 16; ++i) { const int j = crow(i, hh); const float gv_ = j < qb ? gt[i] : -3.0e38f; TOP_INS(__uint_as_float((__float_as_uint(gv_) & ~31u) | (unsigned)j)); }
            { const float pv0 = __shfl_xor(v0, 32), pv1 = __shfl_xor(v1, 32), pv2 = __shfl_xor(v2, 32); TOP_INS(pv0); TOP_INS(pv1); TOP_INS(pv2); }
#undef TOP_INS
            const int i0 = (int)(__float_as_uint(v0) & 31u), i1 = (int)(__float_as_uint(v1) & 31u), i2 = (int)(__float_as_uint(v2) & 31u);
            const int nvalid = qb < 3 ? qb : 3;
            unsigned lp0 = 0, lp1 = 0, lp2 = 0;
            if (hh == 0) {
                if (0 < nvalid) lp0 = __hip_atomic_fetch_add(lcnt + i0, 1u, __ATOMIC_RELAXED, __HIP_MEMORY_SCOPE_WORKGROUP); else PL[((size_t)0 * MTOK + token) * 16 + h] = -INFINITY;
                if (1 < nvalid) lp1 = __hip_atomic_fetch_add(lcnt + i1, 1u, __ATOMIC_RELAXED, __HIP_MEMORY_SCOPE_WORKGROUP); else PL[((size_t)1 * MTOK + token) * 16 + h] = -INFINITY;
                if (2 < nvalid) lp2 = __hip_atomic_fetch_add(lcnt + i2, 1u, __ATOMIC_RELAXED, __HIP_MEMORY_SCOPE_WORKGROUP); else PL[((size_t)2 * MTOK + token) * 16 + h] = -INFINITY;
            }
            __syncthreads();
            if (tid < 32) { const unsigned c = lcnt[tid]; lbase[tid] = c ? __hip_atomic_fetch_add(gcnt + (b * 16 + h) * 32 + tid, c, __ATOMIC_RELAXED, __HIP_MEMORY_SCOPE_AGENT) : 0u; }
            __syncthreads();
            if (hh == 0) {
                unsigned* lst = LIST + (size_t)(b * 16 + h) * LIST_CAP;
                if (0 < nvalid) lst[256 * (31 * i0 - (i0 * (i0 - 1)) / 2) + lbase[i0] + lp0] = (unsigned)tq | (0u << 13);
                if (1 < nvalid) lst[256 * (31 * i1 - (i1 * (i1 - 1)) / 2) + lbase[i1] + lp1] = (unsigned)tq | (1u << 13);
                if (2 < nvalid) lst[256 * (31 * i2 - (i2 * (i2 - 1)) / 2) + lbase[i2] + lp2] = (unsigned)tq | (2u << 13);
            }
        }
    }
    __syncthreads();
    GRID_SYNC();
#ifndef DUP3
#define DUP3 1
#endif
#ifndef DUP10
#define DUP10 1
#endif
    for (int rep3 = 0; rep3 < DUP3; ++rep3) {
        const LAS unsigned char* Kl = lds; const LAS unsigned char* Vl = lds + 256 * KPB; constexpr int VPB = (256 + 8) * 2;
        const int r = lane & 31, hh = lane >> 5;
        bf16_t* dump = (bf16_t*)(ws + WS_DUMP) + (size_t)((blockIdx.x & 255) * NWAVES + wave) * 2048;
        u32x4 kreg[4], vreg[4];
#define P3_LOADKV(b_, h_, j_) do { _Pragma("unroll") for (int i = 0; i < 4; ++i) { const int c = tid + NTHR * i; \
            kreg[i] = *(const u32x4*)(K0 + (size_t)((b_) * 8192 + (j_) * 256 + (c >> 3)) * DM + (h_) * 64 + (c & 7) * 8); \
            vreg[i] = *(const u32x4*)(VT0 + ((size_t)((b_) * 16 + (h_)) * 64 + (c >> 5)) * 8192 + (j_) * 256 + (c & 31) * 8); } } while (0)
        LAS int* sh_n = (LAS int*)(lds + LDS_MISC + 512); LAS int* sh_order = sh_n + 32; LAS int* sh_myj = sh_order + 32; LAS int* sh_cnt = sh_myj + 32;
      for (int v = blockIdx.x; v < 256; v += G) {
        const int bh = (v & 7) * 8 + (v >> 5), q4 = (v >> 3) & 3, b = bh >> 4, h = bh & 15;
        __syncthreads();
        if (tid < 32) sh_n[tid] = 256 + (int)gcnt[bh * 32 + tid] + 128;
        __syncthreads();
        if (tid < 32) { const int nj = sh_n[tid]; int rank = 0;
            for (int i = 0; i < 32; ++i) { const int ni = sh_n[i]; rank += (ni > nj || (ni == nj && i < tid)) ? 1 : 0; }
            sh_order[rank] = tid; }
        __syncthreads();
        if (tid == 0) { int l0 = 0, l1 = 0, l2 = 0, l3 = 0, cnt = 0;
            for (int k = 0; k < 32; ++k) { const int jx = sh_order[k], w = sh_n[jx];
                int bin = 0, lm = l0; if (l1 < lm) { lm = l1; bin = 1; } if (l2 < lm) { lm = l2; bin = 2; } if (l3 < lm) { lm = l3; bin = 3; }
                l0 += bin == 0 ? w : 0; l1 += bin == 1 ? w : 0; l2 += bin == 2 ? w : 0; l3 += bin == 3 ? w : 0;
                if (bin == q4) { sh_myj[cnt] = jx; ++cnt; } }
            sh_cnt[0] = cnt; }
        __syncthreads();
        const int nit = sh_cnt[0];
        const bf16_t* Qbh = Q0 + (size_t)b * 8192 * DM + h * 64 + hh * 8;
        bf16x8 qf[4];
        if (nit > 0) { const int j0 = sh_myj[0]; P3_LOADKV(b, h, j0);
#pragma unroll
            for (int ks = 0; ks < 4; ++ks) qf[ks] = *(const bf16x8*)(Qbh + (size_t)(j0 * 256 + wave * 32 + r) * DM + ks * 16); }
#define RAW_BARRIER() do { asm volatile("s_waitcnt lgkmcnt(0)" ::: "memory"); __builtin_amdgcn_s_barrier(); asm volatile("" ::: "memory"); } while (0)
        for (int it = 0; it < nit; ++it) {
            const int j = sh_myj[it], jn = (it + 1 < nit) ? sh_myj[it + 1] : -1;
            RAW_BARRIER();
#pragma unroll
            for (int i = 0; i < 4; ++i) { const int c = tid + NTHR * i;
                *(LAS u32x4*)(lds + (c >> 3) * KPB + (c & 7) * 16) = kreg[i];
                *(LAS u32x4*)(lds + 256 * KPB + (c >> 5) * VPB + (c & 31) * 16) = vreg[i]; }
            RAW_BARRIER();
            if (jn >= 0) P3_LOADKV(b, h, jn);
#ifdef P3_PROBE_OWNONLY
            const int n = (rep3 + 1 < DUP3) ? 256 : 256 + (int)gcnt[bh * 32 + j], ngroups = (n + 31) >> 5;
#else
            const int n = 256 + (int)gcnt[bh * 32 + j], ngroups = (n + 31) >> 5;
#endif
            const unsigned* lst = LIST + (size_t)bh * LIST_CAP + 256 * (31 * j - (j * (j - 1)) / 2);
            int g = wave;
            int tq = j * 256 + g * 32 + r, slot = 3; bool valid = true;
            const int tqN = (jn >= 0 ? jn : j) * 256 + wave * 32 + r;
            unsigned en = 0u; bool vn = false;
            if (g + 8 < ngroups) { const int row = (g + 8) * 32 + r; vn = row < n; en = lst[vn ? row - 256 : 0]; }
            for (; g < ngroups; g += NWAVES) {
                bf16x8 q1[4]; int tq1 = tqN, slot1 = 3; unsigned en2 = 0u; bool vn2 = false;
                if (g + 8 < ngroups) { tq1 = (int)(en & 8191u); slot1 = (int)(en >> 13); }
#pragma unroll
                for (int ks = 0; ks < 4; ++ks) q1[ks] = *(const bf16x8*)(Qbh + (size_t)tq1 * DM + ks * 16);
                if (g + 16 < ngroups) { const int row = (g + 16) * 32 + r; vn2 = row < n; en2 = lst[vn2 ? row - 256 : 0]; }
                f32x16 o[2]; float lse2;
                attn_rows<8, 1, 2>(Kl, Vl, VPB, qf, r, hh, g < 8 ? g : 99, 0, o, lse2);
                {
                    LAS unsigned char* stg = lds + 73728 + wave * STG_WAVE;
                    stage_o8(stg, o, r, hh);
                    const int myinfo = tq | (slot << 13) | (valid ? (1 << 15) : 0);
                    {
                        const int R = lane >> 1, half = lane & 1;
                        const u32x4 v0 = *(const LAS u32x4*)(stg + R * STG8_PITCH + half * 32), v1 = *(const LAS u32x4*)(stg + R * STG8_PITCH + half * 32 + 16);
                        const int info = __shfl(myinfo, R), tqR = info & 8191, slotR = (info >> 13) & 3;
                        unsigned char* dstp = (slotR == 3 ? (unsigned char*)PO3 : (unsigned char*)PO + (size_t)slotR * MTOK * DM) + ((size_t)b * 8192 + tqR) * DM + h * 64 + half * 32;
                        if (!(info & (1 << 15))) dstp = (unsigned char*)dump + lane * 32;
                        __builtin_nontemporal_store(v0, (u32x4*)dstp); __builtin_nontemporal_store(v1, (u32x4*)(dstp + 16));
                    }
                    { float* plp = PL + ((size_t)slot * MTOK + (size_t)b * 8192 + tq) * 16 + h; if (!valid) plp = (float*)(dump + 1024) + lane; *plp = lse2; }
                }
#pragma unroll
                for (int ks = 0; ks < 4; ++ks) qf[ks] = q1[ks];
                tq = tq1; slot = slot1; valid = vn; en = en2; vn = vn2;
            }
        }
      }
#undef P3_LOADKV
#undef RAW_BARRIER
    }
    __syncthreads();
    GRID_SYNC();
    if (PHM & 16u) {
        const int head = lane >> 2, part = lane & 3;
        for (int token = gw; token < MTOK; token += ngw) {
            float ls[4], mxl = -INFINITY;
#pragma unroll
            for (int s = 0; s < 4; ++s) { ls[s] = PL[((size_t)s * MTOK + token) * 16 + head]; mxl = fmaxf(mxl, ls[s]); }
            float accv[16], den = 0.f;
#pragma unroll
            for (int i = 0; i < 16; ++i) accv[i] = 0.f;
#pragma unroll
            for (int s = 0; s < 4; ++s) {
                const float w = __builtin_amdgcn_exp2f(ls[s] - mxl);
                if (w > 0.f) {
                    den += w;
                    const unsigned char* src = (s == 3 ? (const unsigned char*)PO3 : (const unsigned char*)PO + (size_t)s * MTOK * DM) + (size_t)token * DM + head * 64 + part * 16;
                    const u32x4 a = *(const u32x4*)src;
                    const float ws_ = w * (1.0f / PO8_SCALE);
#pragma unroll
                    for (int k = 0; k < 4; ++k) { const f32x2_t lo = __builtin_amdgcn_cvt_pk_f32_fp8((int)a[k], false), hi = __builtin_amdgcn_cvt_pk_f32_fp8((int)a[k], true);
                        accv[4 * k] += ws_ * lo.x; accv[4 * k + 1] += ws_ * lo.y; accv[4 * k + 2] += ws_ * hi.x; accv[4 * k + 3] += ws_ * hi.y; }
                }
            }
            const float inv = 1.0f / den;
            bf16_t* dst = Q0 + (size_t)token * DM + head * 64 + part * 16;
            u32x4 w0, w1;
            w0.x = pk2(accv[0] * inv, accv[1] * inv); w0.y = pk2(accv[2] * inv, accv[3] * inv); w0.z = pk2(accv[4] * inv, accv[5] * inv); w0.w = pk2(accv[6] * inv, accv[7] * inv);
            w1.x = pk2(accv[8] * inv, accv[9] * inv); w1.y = pk2(accv[10] * inv, accv[11] * inv); w1.z = pk2(accv[12] * inv, accv[13] * inv); w1.w = pk2(accv[14] * inv, accv[15] * inv);
            *(u32x4*)dst = w0; *(u32x4*)(dst + 8) = w1;
        }
    }
    GRID_SYNC();
    if (PHM & 32u) {
        pg8::Gemm g{Q0, Wo0, MTOK, DM, DM}; pg8::StaticOrder S; S.init(MTOK, DM, G, (int)blockIdx.x);
        EpiResid<0> E{HB, Zb, nullptr, ST, nullptr, nullptr};
        for (int repg = 0; repg < DUPG; ++repg) pg8::gemm_phase<EpiResid<0>, pg8::StaticOrder, G_ALIGN, G_SP2>(lds, g, S, E);
    }
    GRID_SYNC();
    if (PHM & 64u) {
        pg8::Gemm g{Zb, (const bf16_t*)(ws + WS_WIN0), MTOK, FF, DM}; pg8::StaticOrder S; S.init(MTOK, FF, G, (int)blockIdx.x);
        EpiSqRelu E{Hm, FF, ST, C1 + C_WIN0, C2 + C_WIN0};
        for (int repg = 0; repg < DUPG * DUPU; ++repg) pg8::gemm_phase<EpiSqRelu, pg8::StaticOrder, G_ALIGN, G_SP2>(lds, g, S, E);
    }
    GRID_SYNC();
    {
        pg8::Gemm g{Hm, (const bf16_t*)(ws + WS_WOUT0), MTOK, DM, FF}; pg8::StaticOrder S; S.init(MTOK, DM, G, (int)blockIdx.x);
        EpiResid<1> E{nullptr, Zb, ST, ST + 2 * MTOK, args.in[7], args.in[8]};
        for (int repg = 0; repg < DUPG; ++repg) pg8::gemm_phase<EpiResid<1>, pg8::StaticOrder, G_ALIGN, G_SP2>(lds, g, S, E);
    }
    GRID_SYNC();

    bf16_t* Q1 = (bf16_t*)(ws + WS_Q1); bf16_t* K1 = (bf16_t*)(ws + WS_K1); bf16_t* VT1 = (bf16_t*)(ws + WS_VT1); bf16_t* PO1 = (bf16_t*)(ws + WS_PO1); float* PL1 = (float*)(ws + WS_PL1);
    if (PHM & 128u) {
        pg8::Gemm g{Zb, Wqkv1, MTOK, NQKV1, DM}; pg8::StaticOrder S; S.init(MTOK, NQKV1, G, (int)blockIdx.x);
        EpiQKV<1> E{Q1, K1, VT1, nullptr, cosT, sinT, ST + 2 * MTOK, C1 + C_QKV1, C2 + C_QKV1};
        for (int repg = 0; repg < DUPG * DUPQ1; ++repg) pg8::gemm_phase<EpiQKV<1>, pg8::StaticOrder, G_ALIGN, G_SP2>(lds, g, S, E);
    }
    GRID_SYNC();
    for (int rep10 = 0; rep10 < DUP10; ++rep10) {
        constexpr int VPB = (384 + 8) * 2; const int r = lane & 31, hh = lane >> 5;
        u32x4 kreg[6], vreg[6];
#define P10_DECODE(unit_, pp_, head_, b_, dsh_, gb_, hp_) const int pp_ = (unit_) & 31, head_ = ((unit_) >> 5) % 12, b_ = (unit_) / (32 * 12), dsh_ = 2 * (head_ >> 2), gb_ = 2 * pp_, hp_ = ((gb_ & ((64 >> dsh_) - 1)) != 0) ? 1 : 0
#define P10_LOAD(b_, head_, gb_, hp_) do { _Pragma("unroll") for (int i = 0; i < 6; ++i) { const int c = tid + NTHR * i; \
            { const int f = c >> 3, part = c & 7; kreg[i] = (u32x4){0u, 0u, 0u, 0u}; \
              if ((hp_) || f >= 128) kreg[i] = *(const u32x4*)(K1 + ((size_t)(b_) * 8192 + ((gb_) - 1) * 128 + f) * D1 + (head_) * 64 + part * 8); } \
            { const int d = c / 48, part = c - d * 48; vreg[i] = (u32x4){0u, 0u, 0u, 0u}; \
              if ((hp_) || part >= 16) vreg[i] = *(const u32x4*)(VT1 + ((size_t)((b_) * 12 + (head_)) * 64 + d) * 8192 + ((gb_) - 1) * 128 + part * 8); } } } while (0)
#define RAW_BARRIER() do { asm volatile("s_waitcnt lgkmcnt(0)" ::: "memory"); __builtin_amdgcn_s_barrier(); asm volatile("" ::: "memory"); } while (0)
        if ((int)blockIdx.x < BATCH * 12 * 32) { P10_DECODE((int)blockIdx.x, pp0, head0, b0, dsh0, gb0, hp0); P10_LOAD(b0, head0, gb0, hp0); }
        for (int unit = blockIdx.x; unit < BATCH * 12 * 32; unit += G) {
            P10_DECODE(unit, pp, head, b, dsh, gb, hasprev);
            bf16x8 qc[4];
#pragma unroll
            for (int ks = 0; ks < 4; ++ks) qc[ks] = *(const bf16x8*)(Q1 + ((size_t)b * 8192 + gb * 128 + wave * 32 + r) * D1 + head * 64 + ks * 16 + hh * 8);
            RAW_BARRIER();
#pragma unroll
            for (int i = 0; i < 6; ++i) { const int c = tid + NTHR * i;
                *(LAS u32x4*)(lds + (c >> 3) * KPB + (c & 7) * 16) = kreg[i];
                { const int d = c / 48, part = c - d * 48; *(LAS u32x4*)(lds + 384 * KPB + d * VPB + part * 16) = vreg[i]; } }
            RAW_BARRIER();
            if (unit + G < BATCH * 12 * 32) { P10_DECODE(unit + G, ppn, headn, bn, dshn, gbn, hpn); P10_LOAD(bn, headn, gbn, hpn); }
            const int rr = gb * 128 + wave * 32 + r;
            f32x16 o[2]; float lse2;
            attn_rows<5, 2, 2>(lds + wave * 32 * KPB, lds + 384 * KPB + wave * 64, VPB, qc, r, hh, wave, hasprev, o, lse2);
            const int t = ((rr & ((8192 >> dsh) - 1)) << dsh) | (rr >> (13 - dsh));
            const size_t token = (size_t)b * 8192 + t;
            {
                LAS unsigned char* stg = lds + 384 * KPB + 64 * VPB + wave * STG_WAVE;
                stage_o(stg, o, r, hh);
#pragma unroll
                for (int i = 0; i < 4; ++i) {
                    const int R = i * 8 + (lane >> 3), chunk = lane & 7;
                    const u32x4 vrow = *(const LAS u32x4*)(stg + R * STG_PITCH + chunk * 16);
                    const int tR = __shfl(t, R);
                    *(u32x4*)(PO1 + ((size_t)b * 8192 + tR) * D1 + head * 64 + chunk * 8) = vrow;
                }
            }
            PL1[token * 12 + head] = lse2;
        }
#undef P10_DECODE
#undef P10_LOAD
#undef RAW_BARRIER
    }
    __syncthreads();
    GRID_SYNC();
    {
        const int head = lane >> 2, part = lane & 3, hs = head & 3, gsel = head >> 2;
        for (int token = gw; token < MTOK; token += ngw) {
            if (lane < 48) {
                const float l0 = PL1[(size_t)token * 12 + hs], l1 = PL1[(size_t)token * 12 + 4 + hs], l2 = PL1[(size_t)token * 12 + 8 + hs];
                const float mxl = fmaxf(l0, fmaxf(l1, l2));
                const float w0 = __builtin_amdgcn_exp2f(l0 - mxl), w1 = __builtin_amdgcn_exp2f(l1 - mxl), w2 = __builtin_amdgcn_exp2f(l2 - mxl);
                const float al = (gsel == 0 ? w0 : (gsel == 1 ? w1 : w2)) / (w0 + w1 + w2);
                bf16_t* p = PO1 + (size_t)token * D1 + head * 64 + part * 16;
                u32x4 a = *(const u32x4*)p, c = *(const u32x4*)(p + 8);
                a.x = pk2(al * bf_lo(a.x), al * bf_hi(a.x)); a.y = pk2(al * bf_lo(a.y), al * bf_hi(a.y)); a.z = pk2(al * bf_lo(a.z), al * bf_hi(a.z)); a.w = pk2(al * bf_lo(a.w), al * bf_hi(a.w));
                c.x = pk2(al * bf_lo(c.x), al * bf_hi(c.x)); c.y = pk2(al * bf_lo(c.y), al * bf_hi(c.y)); c.z = pk2(al * bf_lo(c.z), al * bf_hi(c.z)); c.w = pk2(al * bf_lo(c.w), al * bf_hi(c.w));
                *(u32x4*)p = a; *(u32x4*)(p + 8) = c;
            }
        }
    }
    GRID_SYNC();
    {
        pg8::Gemm g{PO1, Wo1, MTOK, DM, D1}; pg8::StaticOrder S; S.init(MTOK, DM, G, (int)blockIdx.x);
        EpiResid<1> E{nullptr, Zb, ST + 2 * MTOK, ST + 4 * MTOK, args.in[9], args.in[10]};
        for (int repg = 0; repg < DUPG; ++repg) pg8::gemm_phase<EpiResid<1>, pg8::StaticOrder, G_ALIGN, G_SP2>(lds, g, S, E);
    }
    GRID_SYNC();
    {
        pg8::Gemm g{Zb, (const bf16_t*)(ws + WS_WIN1), MTOK, FF, DM}; pg8::StaticOrder S; S.init(MTOK, FF, G, (int)blockIdx.x);
        EpiSqRelu E{Hm, FF, ST + 4 * MTOK, C1 + C_WIN1, C2 + C_WIN1};
        for (int repg = 0; repg < DUPG * DUPU; ++repg) pg8::gemm_phase<EpiSqRelu, pg8::StaticOrder, G_ALIGN, G_SP2>(lds, g, S, E);
    }
    GRID_SYNC();
    {
        pg8::Gemm g{Hm, (const bf16_t*)(ws + WS_WOUT1), MTOK, DM, FF}; pg8::StaticOrder S; S.init(MTOK, DM, G, (int)blockIdx.x);
        EpiResid<1> E{nullptr, Zb, ST + 4 * MTOK, ST + 6 * MTOK, args.in[7] + DM, args.in[8] + DM};
        for (int repg = 0; repg < DUPG; ++repg) pg8::gemm_phase<EpiResid<1>, pg8::StaticOrder, G_ALIGN, G_SP2>(lds, g, S, E);
    }
    GRID_SYNC();
    ln_phase<true>(Zb, args.in[9] + DM, args.in[10] + DM, nullptr, args.out, gw, ngw, lane);
}

extern "C" void kernel_launch(void* const* d_in, const int* in_sizes, int n_in, void* d_out, int out_size, void* d_ws, size_t ws_size, hipStream_t stream) {
    static int grid_blocks = 0;
    if (grid_blocks == 0) {
        if (n_in != 11 || out_size != MTOK * DM || ws_size < WS_END) { fprintf(stderr, "kernel_launch: unexpected shapes (n_in %d, out %d, ws %zu)\n", n_in, out_size, ws_size); grid_blocks = -1; return; }
        int dev = 0, cus = 0, per_cu = 0;
        hipGetDevice(&dev);
        hipDeviceGetAttribute(&cus, hipDeviceAttributeMultiprocessorCount, dev);
        if (hipFuncSetAttribute((const void*)hybrid_fwd, hipFuncAttributeMaxDynamicSharedMemorySize, LDS_BYTES) != hipSuccess) { fprintf(stderr, "kernel_launch: hipFuncSetAttribute failed\n"); }
        if (hipOccupancyMaxActiveBlocksPerMultiprocessor(&per_cu, (const void*)hybrid_fwd, NTHR, LDS_BYTES) != hipSuccess || per_cu < 1) { fprintf(stderr, "kernel_launch: occupancy query says %d blocks per CU\n", per_cu); per_cu = 1; (void)hipGetLastError(); }
        if (per_cu > 1) per_cu = 1;
        grid_blocks = cus * per_cu;
    }
    if (grid_blocks < 0) return;
    (void)hipMemsetAsync((char*)d_ws + WS_CTL, 0, CTL_BYTES, stream);
    Args a{};
    for (int i = 0; i < 11; ++i) a.in[i] = (const float*)d_in[i];
    a.out = (float*)d_out; a.ws = (unsigned char*)d_ws;
    void* kargs[] = {&a};
    hipError_t e = hipLaunchCooperativeKernel((const void*)hybrid_fwd, dim3(grid_blocks), dim3(NTHR), kargs, LDS_BYTES, stream);
    if (e != hipSuccess) fprintf(stderr, "kernel_launch: cooperative launch failed: %s (grid %d)\n", hipGetErrorString(e), grid_blocks);
}
```

```cpp
#include <hip/hip_runtime.h>
#include <hip/hip_cooperative_groups.h>
#include <cstdio>
#include <cstdint>
namespace cg = cooperative_groups;
namespace pg8 {
#define PG8_LAS __attribute__((address_space(3)))
typedef unsigned short bf16_t;
typedef short bf16x8 __attribute__((ext_vector_type(8)));
typedef float f32x4 __attribute__((ext_vector_type(4)));
typedef unsigned u32x4 __attribute__((ext_vector_type(4)));
constexpr int BM = 256, BK = 64, HALF = 128, HTB = HALF * BK * 2  , STAGE_BYTES = 8 * HTB, NXCD = 8, WGM = 4;

__host__ __device__ __forceinline__ int lds_byte(int r, int c) { const int st = (r >> 4) * 2 + (c >> 5), rr = r & 15, cc = c & 31, ob = rr * 64 + cc * 2; return st * 1024 + (ob ^ (((ob >> 9) & 1) << 5)); }
__host__ __device__ __forceinline__ void stage_rc(int b, int& R, int& C) { const int st = b / 1024, sb = b % 1024, swz = sb ^ (((sb >> 9) & 1) << 5); R = (st >> 1) * 16 + swz / 64; C = (st & 1) * 32 + (swz % 64) / 2; }
__host__ __device__ __forceinline__ int perm32(int rho) { const int n = rho >> 4, i = rho & 15; return 8 * (i >> 2) + 4 * n + (i & 3); }

struct Unit { int pm, pn; };
struct Gemm { const bf16_t* A; const bf16_t* Bt; int M, N, K; };

struct StaticOrder {
    int nM, nN, nwg, G, c;
    __host__ __device__ void init(int M, int N, int G_, int c_) { nM = M / BM; nN = N / BM; nwg = nM * nN; G = G_; c = c_; }
    __host__ __device__ bool next(int i, Unit& u) const {
        const long L = (long)i * G + c; if (L >= nwg) return false;
        int wgid = (int)L; { const int q = nwg / NXCD, r = nwg % NXCD, xcd = wgid % NXCD, off = wgid / NXCD; wgid = (xcd < r ? xcd * (q + 1) : r * (q + 1) + (xcd - r) * q) + off; }
        const int nig = WGM * nN, gid = wgid / nig, fm = gid * WGM, gsz = (nM - fm) < WGM ? (nM - fm) : WGM;
        u.pm = fm + ((wgid % nig) % gsz); u.pn = (wgid % nig) / gsz; return true;
    }
    __device__ __forceinline__ void a_ready(const Unit&) const {}
    __device__ __forceinline__ void done(const Unit&) const {}
};


__device__ __forceinline__ unsigned cvt_pk_bf16(float lo, float hi) { unsigned r; asm volatile("v_cvt_pk_bf16_f32 %0, %1, %2" : "=v"(r) : "v"(lo), "v"(hi)); return r; }
typedef float f32x2 __attribute__((ext_vector_type(2)));

template <class Epi, class Sched, bool ALIGN_EPI = false, bool SP2 = false>
__device__ __forceinline__ void gemm_phase(PG8_LAS unsigned char* lds, const Gemm g, const Sched& S, const Epi& E) {
    int tid_ = threadIdx.x; asm volatile("" : "+v"(tid_));
    const int tid = tid_, wid = __builtin_amdgcn_readfirstlane(tid >> 6), lane = tid & 63, wr = wid >> 2, wc = wid & 3, fr = lane & 15, fq = lane >> 4;
    const int K = g.K, nt = K / BK;
    unsigned voffA[2], voffB[2];
#pragma unroll
    for (int i = 0; i < 2; ++i) { int R, C; stage_rc(tid * 16 + i * 8192, R, C); const int Rb = Epi::PERM ? ((R & ~31) + perm32(R & 31)) : R;
        voffA[i] = (unsigned)(R * K + C) * 2u; voffB[i] = (unsigned)(Rb * K + C) * 2u; }
    const size_t kstep = (size_t)(BK * 2);
    const size_t hstep = (size_t)HALF * K * 2;
    const size_t tstep = 2 * hstep;
    const unsigned ldsw = (unsigned)wid * 1024u;
    const int aoff = lds_byte(wr * 64 + fr, fq * 8), boff = lds_byte(wc * 32 + fr, fq * 8);
#define PG8_SA(b, h) (((b) * 2 + (h)) * HTB)
#define PG8_SB(b, h) ((4 + (b) * 2 + (h)) * HTB)
#define PG8_STAGE(bufoff, gbase, voff) do { _Pragma("unroll") for (int _i = 0; _i < 2; ++_i) \
        __builtin_amdgcn_global_load_lds((const unsigned*)((const char*)(gbase) + (voff)[_i]), (PG8_LAS unsigned*)(lds + (bufoff) + ldsw + _i * 8192), 16, 0, 0); } while (0)
#define PG8_LDA(dst, b, h) do { _Pragma("unroll") for (int m = 0; m < 4; ++m) _Pragma("unroll") for (int k = 0; k < 2; ++k) dst[m][k] = *(const PG8_LAS bf16x8*)(lds + PG8_SA(b, h) + aoff + m * 2048 + k * 1024); } while (0)
#define PG8_LDB(dst, b, h) do { _Pragma("unroll") for (int n = 0; n < 2; ++n) _Pragma("unroll") for (int k = 0; k < 2; ++k) dst[n][k] = *(const PG8_LAS bf16x8*)(lds + PG8_SB(b, h) + boff + n * 2048 + k * 1024); } while (0)
#define PG8_MMA(ai, bj, At, Bt) do { __builtin_amdgcn_s_setprio(1); _Pragma("unroll") for (int m = 0; m < 4; ++m) _Pragma("unroll") for (int n = 0; n < 2; ++n) _Pragma("unroll") for (int k = 0; k < 2; ++k) \
        acc[ai][bj][m][n] = __builtin_amdgcn_mfma_f32_16x16x32_bf16(Bt[n][k], At[m][k], acc[ai][bj][m][n], 0, 0, 0); __builtin_amdgcn_s_setprio(0); } while (0)
#define PG8_WAIT_V(n) asm volatile("s_waitcnt vmcnt(" #n ")" ::: "memory")
#define PG8_WAIT_L(n) asm volatile("s_waitcnt lgkmcnt(" #n ")" ::: "memory")
#define PG8_BAR __builtin_amdgcn_s_barrier()
#define PG8_SCHED __builtin_amdgcn_sched_barrier(0)
    Unit cur, nxt; int ui = 0;
    if (!S.next(0, cur)) return;
    f32x4 acc[2][2][4][2];
#pragma unroll
    for (int a = 0; a < 2; ++a)
#pragma unroll
        for (int b = 0; b < 2; ++b)
#pragma unroll
            for (int m = 0; m < 4; ++m)
#pragma unroll
                for (int n = 0; n < 2; ++n) acc[a][b][m][n] = (f32x4){0.f, 0.f, 0.f, 0.f};
    bf16x8 At[4][2], B0[2][2], B1[2][2];
    const char* cA = (const char*)g.A + (size_t)cur.pm * tstep; const char* cB = (const char*)g.Bt + (size_t)cur.pn * tstep;
    S.a_ready(cur);
    if constexpr (SP2) {
        PG8_STAGE(PG8_SB(0, 0), cB, voffB); PG8_STAGE(PG8_SB(0, 1), cB + hstep, voffB); PG8_STAGE(PG8_SA(0, 0), cA, voffA); PG8_STAGE(PG8_SA(0, 1), cA + hstep, voffA);
        if (wr == 1) PG8_BAR;
        PG8_WAIT_V(2); PG8_BAR;
        PG8_STAGE(PG8_SB(1, 0), cB + kstep, voffB); PG8_STAGE(PG8_SA(1, 0), cA + kstep, voffA); PG8_STAGE(PG8_SB(1, 1), cB + hstep + kstep, voffB);
        PG8_WAIT_V(6); PG8_BAR;
    } else {
        PG8_STAGE(PG8_SB(0, 0), cB, voffB); PG8_STAGE(PG8_SA(0, 0), cA, voffA); PG8_STAGE(PG8_SB(0, 1), cB + hstep, voffB); PG8_STAGE(PG8_SA(0, 1), cA + hstep, voffA);
        if (wr == 1) PG8_BAR;
        PG8_WAIT_V(4); PG8_BAR;
        PG8_STAGE(PG8_SB(1, 0), cB + kstep, voffB); PG8_STAGE(PG8_SA(1, 0), cA + kstep, voffA); PG8_STAGE(PG8_SB(1, 1), cB + hstep + kstep, voffB);
        PG8_WAIT_V(6); PG8_BAR;
    }
    for (;;) {
        const bool has_next = S.next(ui + 1, nxt);
        const char* nA = has_next ? (const char*)g.A + (size_t)nxt.pm * tstep : cA; const char* nB = has_next ? (const char*)g.Bt + (size_t)nxt.pn * tstep : cB;
        for (int t = 0; t < nt; t += 2) {
            const bool last = (t == nt - 2);
            const char* a1 = cA + (size_t)(t + 1) * kstep;
            const char* a2 = last ? nA : cA + (size_t)(t + 2) * kstep; const char* b2 = last ? nB : cB + (size_t)(t + 2) * kstep;
            const char* a3 = a2 + kstep; const char* b3 = b2 + kstep;
            if (last && has_next) S.a_ready(nxt);
            if constexpr (SP2) {
            PG8_LDB(B0, 0, 0); PG8_LDB(B1, 0, 1); PG8_SCHED; PG8_LDA(At, 0, 0); PG8_STAGE(PG8_SA(1, 1), a1 + hstep, voffA);
            PG8_WAIT_V(8); PG8_WAIT_L(0); PG8_BAR; PG8_MMA(0, 0, At, B0); PG8_MMA(0, 1, At, B1); PG8_BAR; PG8_SCHED;
            PG8_LDA(At, 0, 1); PG8_STAGE(PG8_SB(0, 0), b2, voffB); PG8_STAGE(PG8_SB(0, 1), b2 + hstep, voffB); PG8_STAGE(PG8_SA(0, 0), a2, voffA);
            PG8_WAIT_V(8); PG8_WAIT_L(0); PG8_BAR; PG8_MMA(1, 0, At, B0); PG8_MMA(1, 1, At, B1); PG8_BAR; PG8_SCHED;
            PG8_LDB(B0, 1, 0); PG8_LDB(B1, 1, 1); PG8_SCHED; PG8_LDA(At, 1, 0); PG8_STAGE(PG8_SA(0, 1), a2 + hstep, voffA);
            PG8_WAIT_V(8); PG8_WAIT_L(0); PG8_BAR; PG8_MMA(0, 0, At, B0); PG8_MMA(0, 1, At, B1); PG8_BAR; PG8_SCHED;
            PG8_LDA(At, 1, 1); PG8_STAGE(PG8_SB(1, 0), b3, voffB); PG8_STAGE(PG8_SB(1, 1), b3 + hstep, voffB); PG8_STAGE(PG8_SA(1, 0), a3, voffA);
            PG8_WAIT_V(8); PG8_WAIT_L(0); PG8_BAR; PG8_MMA(1, 0, At, B0); PG8_MMA(1, 1, At, B1); PG8_BAR; PG8_SCHED;
            } else {
            PG8_LDB(B0, 0, 0); PG8_SCHED; PG8_LDA(At, 0, 0); PG8_STAGE(PG8_SA(1, 1), a1 + hstep, voffA);
            PG8_WAIT_L(8); PG8_BAR; PG8_WAIT_L(0); PG8_MMA(0, 0, At, B0); PG8_BAR; PG8_SCHED;
            PG8_LDB(B1, 0, 1); PG8_STAGE(PG8_SB(0, 0), b2, voffB);
            PG8_BAR; PG8_WAIT_L(0); PG8_MMA(0, 1, At, B1); PG8_BAR;
            PG8_LDA(At, 0, 1); PG8_STAGE(PG8_SA(0, 0), a2, voffA);
            PG8_BAR; PG8_WAIT_L(0); PG8_MMA(1, 0, At, B0); PG8_BAR; PG8_SCHED;
            PG8_STAGE(PG8_SB(0, 1), b2 + hstep, voffB);
            PG8_WAIT_V(6); PG8_BAR; PG8_MMA(1, 1, At, B1); PG8_BAR;
            PG8_LDB(B0, 1, 0); PG8_SCHED; PG8_LDA(At, 1, 0); PG8_STAGE(PG8_SA(0, 1), a2 + hstep, voffA);
            PG8_WAIT_L(8); PG8_BAR; PG8_WAIT_L(0); PG8_MMA(0, 0, At, B0); PG8_BAR; PG8_SCHED;
            PG8_LDB(B1, 1, 1); PG8_STAGE(PG8_SB(1, 0), b3, voffB);
            PG8_BAR; PG8_WAIT_L(0); PG8_MMA(0, 1, At, B1); PG8_BAR;
            PG8_LDA(At, 1, 1); PG8_STAGE(PG8_SA(1, 0), a3, voffA);
            PG8_BAR; PG8_WAIT_L(0); PG8_MMA(1, 0, At, B0); PG8_BAR; PG8_SCHED;
            PG8_STAGE(PG8_SB(1, 1), b3 + hstep, voffB);
            PG8_WAIT_V(6); PG8_BAR; PG8_MMA(1, 1, At, B1); PG8_BAR;
            }
        }
        if constexpr (ALIGN_EPI) { if (wr == 0) PG8_BAR; }
        if constexpr (!Epi::AFTER_DRAIN) { E(acc, cur, wr, wc, fr, fq); S.done(cur); }
        if (!has_next) break;
#pragma unroll
        for (int a = 0; a < 2; ++a)
#pragma unroll
            for (int b = 0; b < 2; ++b)
#pragma unroll
                for (int m = 0; m < 4; ++m)
#pragma unroll
                    for (int n = 0; n < 2; ++n) acc[a][b][m][n] = (f32x4){0.f, 0.f, 0.f, 0.f};
        cur = nxt; cA = nA; cB = nB; ++ui;
        if constexpr (ALIGN_EPI) { if (wr == 1) PG8_BAR; }
    }
    PG8_WAIT_V(0);
    if constexpr (!ALIGN_EPI) { if (wr == 0) PG8_BAR; }
    PG8_BAR;
    if constexpr (Epi::AFTER_DRAIN) { E.fused(acc, cur, wr, wc, fr, fq, lds, wid, lane); S.done(cur); }
#undef PG8_SA
#undef PG8_SB
#undef PG8_STAGE
#undef PG8_LDA
#undef PG8_LDB
#undef PG8_MMA
#undef PG8_WAIT_V
#undef PG8_WAIT_L
#undef PG8_BAR
#undef PG8_SCHED
}
}

#define LAS __attribute__((address_space(3)))
using pg8::bf16_t; using pg8::bf16x8; using pg8::f32x4; using pg8::u32x4; using pg8::Unit;
typedef float f32x16 __attribute__((ext_vector_type(16)));
typedef float f32x2_t __attribute__((ext_vector_type(2)));
typedef __bf16 bf16x2_t __attribute__((ext_vector_type(2)));
typedef unsigned u32x2 __attribute__((ext_vector_type(2)));
#define MFMA32(a, b, c) __builtin_amdgcn_mfma_f32_32x32x16_bf16((a), (b), (c), 0, 0, 0)

constexpr int BATCH = 4, SEQ = 8192, DM = 1024, MTOK = BATCH * SEQ, FF = 4096, NQKV0 = 3072, NQKV1 = 2304, D1 = 768;
constexpr float ALPHA = 1.41421356237309505f, LN_EPS = 1e-5f, QSCALE = 0.125f * 1.4426950408889634f;
constexpr int NWAVES = 8, NTHR = 512;
constexpr int LIST_CAP = 126976;

constexpr size_t MiB = 1u << 20;
constexpr size_t WS_CTL = 0, CTL_BYTES = 2 * MiB;
constexpr size_t WS_KM = 128 * 1024, WS_BAR = 16 * 1024;
constexpr size_t WS_COS = 505 * MiB, WS_SIN = 506 * MiB;
constexpr size_t WS_C12 = 640 * 1024, WS_ST = 1 * MiB;
constexpr int NC12 = 4096 + 4096 + 2304, C_WIN0 = 0, C_WIN1 = 4096, C_QKV1 = 8192;
constexpr size_t WS_WQKV0 = 3 * MiB, WS_WO0 = 9 * MiB, WS_WQKV1 = 11 * MiB, WS_WO1 = 15 * MiB + 512 * 1024, WS_WIN0 = 17 * MiB, WS_WOUT0 = 25 * MiB, WS_WIN1 = 33 * MiB, WS_WOUT1 = 41 * MiB;
constexpr size_t WS_HB = 49 * MiB;
constexpr size_t WS_Q = 113 * MiB, WS_K = 177 * MiB, WS_VT = 241 * MiB, WS_PO = 305 * MiB, WS_PL = 497 * MiB;
constexpr size_t WS_H = 113 * MiB, WS_Z = 369 * MiB, WS_HB2 = 433 * MiB;
constexpr size_t WS_Q1 = 113 * MiB, WS_K1 = 161 * MiB, WS_VT1 = 209 * MiB, WS_PO1 = 257 * MiB, WS_PL1 = 305 * MiB;
constexpr size_t WS_DUMP = 401 * MiB, WS_END = 507 * MiB;
constexpr size_t OUT_PO3 = 0, OUT_LIST = 64 * MiB;

#ifndef DUPU
#define DUPU 1
#endif
#ifndef DUPQ0
#define DUPQ0 1
#endif
#ifndef DUPQ1
#define DUPQ1 1
#endif
#ifndef DUPG
#define DUPG 1
#endif
#ifndef G_ALIGN
#define G_ALIGN true
#endif
#ifndef G_SP2
#define G_SP2 true
#endif
#ifndef PHM
#define PHM 0xFFFFFFFFu
#endif
constexpr int RING_BYTES = 131072, LDS_BYTES = 147456, LDS_MISC = LDS_BYTES - 1024;

__device__ __forceinline__ unsigned pk2(float lo, float hi) { f32x2_t v = {lo, hi}; bf16x2_t b = __builtin_convertvector(v, bf16x2_t); return __builtin_bit_cast(unsigned, b); }
__device__ __forceinline__ float bf_lo(unsigned u) { return __uint_as_float(u << 16); }
__device__ __forceinline__ float bf_hi(unsigned u) { return __uint_as_float(u & 0xffff0000u); }
__device__ __forceinline__ int crow(int i, int hh) { return (i & 3) + 8 * (i >> 2) + 4 * hh; }
__device__ __forceinline__ float wave_sum(float v) {
#pragma unroll
    for (int o = 1; o < 64; o <<= 1) v += __shfl_xor(v, o);
    return v;
}
#define LDS_WAIT() asm volatile("s_waitcnt lgkmcnt(0)" ::: "memory")
__device__ __forceinline__ int qkv_phys(int c) { return (c & ~255) + ((c & 32) ? 128 : 0) + (((c >> 6) & 3) << 5) + (c & 31); }
__device__ __forceinline__ int swz16(int r) { return (r & ~12) | ((r & 4) << 1) | ((r & 8) >> 1); }

#define ROW_STATS(st_, row_, mu_, rs_) do { const f32x2_t sv_ = *(const f32x2_t*)((st_) + (size_t)(row_) * 2); (mu_) = sv_.x * (1.0f / DM); (rs_) = 1.0f / sqrtf(sv_.y * (1.0f / DM) - (mu_) * (mu_) + LN_EPS); } while (0)
template <int LAYER> struct EpiQKV {
    static constexpr bool PERM = true, AFTER_DRAIN = false;
    bf16_t* Q; bf16_t* Kb; bf16_t* VT; float* KM; const float* cs; const float* sn; const float* st; const float* c1; const float* c2;
    __device__ __forceinline__ void operator()(const f32x4 (&acc)[2][2][4][2], const Unit& u, int wr, int wc, int fr, int fq) const {
        constexpr int NT = LAYER == 0 ? 4 : 3, PITCH = NT * 256, NH = NT * 4;
        const int which = u.pn / NT, hg = u.pn - which * NT, head = hg * 4 + wc, e0 = 8 * fq;
        const int dsh = LAYER == 0 ? 0 : 2 * hg;
        const int rowb = u.pm * 256 + wr * 64 + fr;
        f32x4 c1v[2][2], c2v[2][2]; f32x2_t svc = {0.f, 0.f}, svn = {0.f, 0.f};
        if (LAYER == 1) {
#pragma unroll
            for (int bj = 0; bj < 2; ++bj)
#pragma unroll
                for (int n = 0; n < 2; ++n) { const int cc = u.pn * 256 + bj * 128 + wc * 32 + e0 + 4 * n; c1v[bj][n] = *(const f32x4*)(c1 + cc); c2v[bj][n] = *(const f32x4*)(c2 + cc); }
            svc = *(const f32x2_t*)(st + (size_t)rowb * 2);
        }
#define QKV_AFF(a_, bj_, n_) (LAYER == 1 ? ((a_) - mu * c1v[bj_][n_]) * rstd + c2v[bj_][n_] : (a_))
        if (which < 2) {
            bf16_t* dst = which == 0 ? Q : Kb; const float sc = which == 0 ? QSCALE : 1.f;
            f32x4 ks[2][2];
#pragma unroll
            for (int a = 0; a < 2; ++a)
#pragma unroll
                for (int b = 0; b < 2; ++b) ks[a][b] = (f32x4){0.f, 0.f, 0.f, 0.f};
            f32x4 tc[4], tn[4];
            { const int t = rowb & 8191; tc[0] = *(const f32x4*)(cs + t * 32 + e0); tc[1] = *(const f32x4*)(cs + t * 32 + e0 + 4); tc[2] = *(const f32x4*)(sn + t * 32 + e0); tc[3] = *(const f32x4*)(sn + t * 32 + e0 + 4); }
#pragma unroll
            for (int q = 0; q < 8; ++q) {
                const int ai = q >> 2, m = q & 3;
                const int row = rowb + ai * 128 + m * 16, b = row >> 13, t = row & 8191;
                if (q + 1 < 8) { const int t2 = (rowb + ((q + 1) >> 2) * 128 + ((q + 1) & 3) * 16) & 8191;
                    tn[0] = *(const f32x4*)(cs + t2 * 32 + e0); tn[1] = *(const f32x4*)(cs + t2 * 32 + e0 + 4); tn[2] = *(const f32x4*)(sn + t2 * 32 + e0); tn[3] = *(const f32x4*)(sn + t2 * 32 + e0 + 4);
                    if (LAYER == 1) svn = *(const f32x2_t*)(st + (size_t)(rowb + ((q + 1) >> 2) * 128 + ((q + 1) & 3) * 16) * 2); }
                const int rr = ((t & ((1 << dsh) - 1)) << (13 - dsh)) | (t >> dsh);
                const f32x4 c0 = tc[0], c1_ = tc[1], s0 = tc[2], s1 = tc[3];
                const float mu = LAYER == 1 ? svc.x * (1.0f / DM) : 0.f, rstd = LAYER == 1 ? 1.0f / sqrtf(svc.y * (1.0f / DM) - mu * mu + LN_EPS) : 1.f;
                const f32x4 x1a = QKV_AFF(acc[ai][0][m][0], 0, 0), x1b = QKV_AFF(acc[ai][0][m][1], 0, 1), x2a = QKV_AFF(acc[ai][1][m][0], 1, 0), x2b = QKV_AFF(acc[ai][1][m][1], 1, 1);
                const f32x4 o1a = (x1a * c0 - x2a * s0) * sc, o1b = (x1b * c1_ - x2b * s1) * sc, o2a = (x2a * c0 + x1a * s0) * sc, o2b = (x2b * c1_ + x1b * s1) * sc;
                bf16_t* p = dst + (size_t)(b * 8192 + rr) * PITCH + head * 64 + e0;
                u32x4 w; w.x = pk2(o1a[0], o1a[1]); w.y = pk2(o1a[2], o1a[3]); w.z = pk2(o1b[0], o1b[1]); w.w = pk2(o1b[2], o1b[3]);
                __builtin_nontemporal_store(w, (u32x4*)p);
                w.x = pk2(o2a[0], o2a[1]); w.y = pk2(o2a[2], o2a[3]); w.z = pk2(o2b[0], o2b[1]); w.w = pk2(o2b[2], o2b[3]);
                __builtin_nontemporal_store(w, (u32x4*)(p + 32));
                if (LAYER == 0 && which == 1) { ks[0][0] += o1a; ks[0][1] += o1b; ks[1][0] += o2a; ks[1][1] += o2b; }
                asm volatile("" ::: "memory");
#pragma unroll
                for (int k = 0; k < 4; ++k) tc[k] = tn[k];
                svc = svn;
            }
            if (LAYER == 0 && which == 1) {
                const int b = u.pm >> 5, blk = u.pm & 31;
                float* kmp = KM + ((size_t)((b * 16 + head) * 32 + blk)) * 64; float kmv = 0.f;
#pragma unroll
                for (int a = 0; a < 2; ++a)
#pragma unroll
                    for (int n = 0; n < 2; ++n)
#pragma unroll
                        for (int i = 0; i < 4; ++i) {
                            float v = ks[a][n][i];
                            v += __shfl_xor(v, 1); v += __shfl_xor(v, 2); v += __shfl_xor(v, 4); v += __shfl_xor(v, 8);
                            if (fr == a * 8 + n * 4 + i) kmv = v;
                        }
                __hip_atomic_fetch_add(kmp + (fr >> 3) * 32 + e0 + (fr & 7), kmv * (1.0f / 256.0f), __ATOMIC_RELAXED, __HIP_MEMORY_SCOPE_AGENT);
            }
        } else {
#pragma unroll
            for (int q = 0; q < 8; ++q) {
                const int ai = q >> 2, m = q & 3;
                const int row = rowb + ai * 128 + m * 16, b = row >> 13, t = row & 8191;
                const int rr = ((t & ((1 << dsh) - 1)) << (13 - dsh)) | (t >> dsh);
                bf16_t* p = VT + ((size_t)(b * NH + head) * 64 + e0) * 8192 + swz16(rr);
                if (LAYER == 1 && q + 1 < 8) svn = *(const f32x2_t*)(st + (size_t)(rowb + ((q + 1) >> 2) * 128 + ((q + 1) & 3) * 16) * 2);
                const float mu = LAYER == 1 ? svc.x * (1.0f / DM) : 0.f, rstd = LAYER == 1 ? 1.0f / sqrtf(svc.y * (1.0f / DM) - mu * mu + LN_EPS) : 1.f;
#pragma unroll
                for (int bj = 0; bj < 2; ++bj)
#pragma unroll
                    for (int n = 0; n < 2; ++n) { const f32x4 yv = QKV_AFF(acc[ai][bj][m][n], bj, n);
#pragma unroll
                        for (int i = 0; i < 4; ++i) p[(size_t)(bj * 32 + 4 * n + i) * 8192] = (bf16_t)(pk2(yv[i], 0.f) & 0xffffu); }
                svc = svn;
            }
        }
#undef QKV_AFF
    }
};
struct EpiSqRelu {
    static constexpr bool PERM = true, AFTER_DRAIN = false;
    bf16_t* O; int ldc; const float* st; const float* c1; const float* c2;
    __device__ __forceinline__ void operator()(const f32x4 (&acc)[2][2][4][2], const Unit& u, int wr, int wc, int fr, int fq) const {
        const int row0 = u.pm * 256 + wr * 64 + fr, col0 = u.pn * 256 + wc * 32 + 8 * fq;
        f32x4 c1v[2][2], c2v[2][2]; float mus[8], rss[8];
#pragma unroll
        for (int bj = 0; bj < 2; ++bj)
#pragma unroll
            for (int n = 0; n < 2; ++n) { c1v[bj][n] = *(const f32x4*)(c1 + col0 + bj * 128 + 4 * n); c2v[bj][n] = *(const f32x4*)(c2 + col0 + bj * 128 + 4 * n); }
#pragma unroll
        for (int q = 0; q < 8; ++q) ROW_STATS(st, row0 + (q >> 2) * 128 + (q & 3) * 16, mus[q], rss[q]);
#pragma unroll
        for (int ai = 0; ai < 2; ++ai)
#pragma unroll
            for (int m = 0; m < 4; ++m) { const int row = row0 + ai * 128 + m * 16; bf16_t* rowp = O + (size_t)row * ldc + col0;
                const float mu = mus[ai * 4 + m], rstd = rss[ai * 4 + m];
#pragma unroll
                for (int bj = 0; bj < 2; ++bj) { f32x4 v0 = (acc[ai][bj][m][0] - mu * c1v[bj][0]) * rstd + c2v[bj][0], v1 = (acc[ai][bj][m][1] - mu * c1v[bj][1]) * rstd + c2v[bj][1];
#pragma unroll
                    for (int i = 0; i < 4; ++i) { const float a = fmaxf(v0[i], 0.f), b = fmaxf(v1[i], 0.f); v0[i] = a * a; v1[i] = b * b; }
                    u32x4 w; w.x = pk2(v0[0], v0[1]); w.y = pk2(v0[2], v0[3]); w.z = pk2(v1[0], v1[1]); w.w = pk2(v1[2], v1[3]);
                    __builtin_nontemporal_store(w, (u32x4*)(rowp + bj * 128)); } }
    }
};
template <int MODE> struct EpiResid {
    static constexpr bool PERM = true, AFTER_DRAIN = false;
    const bf16_t* R; bf16_t* Z; const float* stp; float* stc; const float* g; const float* b;
    __device__ __forceinline__ void operator()(const f32x4 (&acc)[2][2][4][2], const Unit& u, int wr, int wc, int fr, int fq) const {
        const int row0 = u.pm * 256 + wr * 64 + fr, col0 = u.pn * 256 + wc * 32 + 8 * fq;
        const bf16_t* src = MODE == 1 ? (const bf16_t*)Z : R;
        f32x4 gv[2][2], bv[2][2]; f32x2_t svc = {0.f, 0.f}, svn = {0.f, 0.f};
        u32x4 rc[2], rn[2]; float sq[8];
        rc[0] = *(const u32x4*)(src + (size_t)row0 * DM + col0); rc[1] = *(const u32x4*)(src + (size_t)row0 * DM + col0 + 128);
        if (MODE == 1) {
#pragma unroll
            for (int bj = 0; bj < 2; ++bj)
#pragma unroll
                for (int n = 0; n < 2; ++n) { gv[bj][n] = *(const f32x4*)(g + col0 + bj * 128 + 4 * n); bv[bj][n] = *(const f32x4*)(b + col0 + bj * 128 + 4 * n); }
            svc = *(const f32x2_t*)(stp + (size_t)row0 * 2);
        }
#pragma unroll
        for (int q = 0; q < 8; ++q) {
            const int ai = q >> 2, m = q & 3, row = row0 + ai * 128 + m * 16; const size_t off = (size_t)row * DM + col0;
            if (q + 1 < 8) { const int row2 = row0 + ((q + 1) >> 2) * 128 + ((q + 1) & 3) * 16; const size_t off2 = (size_t)row2 * DM + col0; rn[0] = *(const u32x4*)(src + off2); rn[1] = *(const u32x4*)(src + off2 + 128);
                if (MODE == 1) svn = *(const f32x2_t*)(stp + (size_t)row2 * 2); }
            const float mu = MODE == 1 ? svc.x * (1.0f / DM) : 0.f, rstd = MODE == 1 ? 1.0f / sqrtf(svc.y * (1.0f / DM) - mu * mu + LN_EPS) : 1.f;
            float s1 = 0.f, s2 = 0.f;
#pragma unroll
            for (int bj = 0; bj < 2; ++bj) { const u32x4 rv = rc[bj];
                f32x4 h0 = (f32x4){bf_lo(rv.x), bf_hi(rv.x), bf_lo(rv.y), bf_hi(rv.y)}, h1 = (f32x4){bf_lo(rv.z), bf_hi(rv.z), bf_lo(rv.w), bf_hi(rv.w)};
                if (MODE == 1) { h0 = (h0 - mu) * rstd * gv[bj][0] + bv[bj][0]; h1 = (h1 - mu) * rstd * gv[bj][1] + bv[bj][1]; }
                const f32x4 z0 = ALPHA * h0 + acc[ai][bj][m][0], z1 = ALPHA * h1 + acc[ai][bj][m][1];
                u32x4 w; w.x = pk2(z0[0], z0[1]); w.y = pk2(z0[2], z0[3]); w.z = pk2(z1[0], z1[1]); w.w = pk2(z1[2], z1[3]);
                *(u32x4*)(Z + off + bj * 128) = w;
                const float r0 = bf_lo(w.x), r1 = bf_hi(w.x), r2 = bf_lo(w.y), r3 = bf_hi(w.y), r4 = bf_lo(w.z), r5 = bf_hi(w.z), r6 = bf_lo(w.w), r7 = bf_hi(w.w);
                s1 += ((r0 + r1) + (r2 + r3)) + ((r4 + r5) + (r6 + r7));
                s2 += ((r0 * r0 + r1 * r1) + (r2 * r2 + r3 * r3)) + ((r4 * r4 + r5 * r5) + (r6 * r6 + r7 * r7)); }
            s1 += __shfl_xor(s1, 16); s1 += __shfl_xor(s1, 32); s2 += __shfl_xor(s2, 16); s2 += __shfl_xor(s2, 32);
            sq[q] = (fq & 1) ? s2 : s1;
            asm volatile("" ::: "memory");
            rc[0] = rn[0]; rc[1] = rn[1]; svc = svn;
        }
#pragma unroll
        for (int p = 0; p < 4; ++p) {
            const int qa = 2 * p, qb = 2 * p + 1;
            const float val = (fq < 2) ? sq[qa] : sq[qb];
            const int rowp = row0 + ((fq < 2) ? ((qa >> 2) * 128 + (qa & 3) * 16) : ((qb >> 2) * 128 + (qb & 3) * 16));
            __hip_atomic_fetch_add(stc + (size_t)rowp * 2 + (fq & 1), val, __ATOMIC_RELAXED, __HIP_MEMORY_SCOPE_AGENT);
        }
    }
};

template <bool PERMQ, bool SCALED> __device__ __forceinline__ void transpose_item(const float* W, int K, int N, bf16_t* WT, LAS float* scr, int item, int lane, const float* gk, const float* bk, float* c1, float* c2) {
    const int nblk = N / 32, kb = item / nblk, nb = item % nblk, k0 = 64 * kb, n0 = 32 * nb;
    float p1 = 0.f, p2 = 0.f;
#pragma unroll 8
    for (int i = 0; i < 32; ++i) { const int kk = 2 * i + (lane >> 5); float v = W[(size_t)(k0 + kk) * N + n0 + (lane & 31)];
        if (SCALED) { p2 += v * bk[k0 + kk]; v *= gk[k0 + kk]; p1 += bf_lo(pk2(v, 0.f)); }
        scr[kk * 33 + (lane & 31)] = v; }
    LDS_WAIT();
    if (SCALED) { p1 += __shfl_xor(p1, 32); p2 += __shfl_xor(p2, 32);
        if (lane < 32) { const int oc = PERMQ ? qkv_phys(n0 + lane) : (n0 + lane); __hip_atomic_fetch_add(c1 + oc, p1, __ATOMIC_RELAXED, __HIP_MEMORY_SCOPE_AGENT); __hip_atomic_fetch_add(c2 + oc, p2, __ATOMIC_RELAXED, __HIP_MEMORY_SCOPE_AGENT); } }
    const int c = lane & 7;
#pragma unroll
    for (int j = 0; j < 4; ++j) { const int n = (lane >> 3) + 8 * j; const LAS float* sp = scr + (8 * c) * 33 + n;
        u32x4 o; o.x = pk2(sp[0 * 33], sp[1 * 33]); o.y = pk2(sp[2 * 33], sp[3 * 33]); o.z = pk2(sp[4 * 33], sp[5 * 33]); o.w = pk2(sp[6 * 33], sp[7 * 33]);
        const int orow = PERMQ ? qkv_phys(n0 + n) : (n0 + n);
        *(u32x4*)(WT + (size_t)orow * K + k0 + 8 * c) = o; }
    LDS_WAIT();
}

template <bool F32OUT> __device__ __forceinline__ void ln_phase(const bf16_t* Z, const float* g, const float* bt, bf16_t* ob, float* of, int gw, int ngw, int lane) {
    f32x4 gv[4], bv[4];
#pragma unroll
    for (int q = 0; q < 2; ++q) { gv[2 * q] = *(const f32x4*)(g + 512 * q + 8 * lane); gv[2 * q + 1] = *(const f32x4*)(g + 512 * q + 8 * lane + 4);
                                  bv[2 * q] = *(const f32x4*)(bt + 512 * q + 8 * lane); bv[2 * q + 1] = *(const f32x4*)(bt + 512 * q + 8 * lane + 4); }
    for (int row = gw; row < MTOK; row += ngw) {
        const bf16_t* zr = Z + (size_t)row * DM + 8 * lane;
        const u32x4 a = *(const u32x4*)zr, b = *(const u32x4*)(zr + 512);
        float v[16] = {bf_lo(a.x), bf_hi(a.x), bf_lo(a.y), bf_hi(a.y), bf_lo(a.z), bf_hi(a.z), bf_lo(a.w), bf_hi(a.w),
                       bf_lo(b.x), bf_hi(b.x), bf_lo(b.y), bf_hi(b.y), bf_lo(b.z), bf_hi(b.z), bf_lo(b.w), bf_hi(b.w)};
        float s = 0.f;
#pragma unroll
        for (int i = 0; i < 16; ++i) s += v[i];
        const float mean = wave_sum(s) * (1.0f / DM);
        float q = 0.f;
#pragma unroll
        for (int i = 0; i < 16; ++i) { v[i] -= mean; q += v[i] * v[i]; }
        const float rstd = 1.0f / sqrtf(wave_sum(q) * (1.0f / DM) + LN_EPS);
#pragma unroll
        for (int i = 0; i < 16; ++i) v[i] = v[i] * rstd * gv[i >> 2][i & 3] + bv[i >> 2][i & 3];
        if (F32OUT) {
            float* orow = of + (size_t)row * DM + 8 * lane;
            __builtin_nontemporal_store((f32x4){v[0], v[1], v[2], v[3]}, (f32x4*)orow); __builtin_nontemporal_store((f32x4){v[4], v[5], v[6], v[7]}, (f32x4*)(orow + 4));
            __builtin_nontemporal_store((f32x4){v[8], v[9], v[10], v[11]}, (f32x4*)(orow + 512)); __builtin_nontemporal_store((f32x4){v[12], v[13], v[14], v[15]}, (f32x4*)(orow + 516));
        } else {
            bf16_t* orow = ob + (size_t)row * DM + 8 * lane;
            u32x4 w; w.x = pk2(v[0], v[1]); w.y = pk2(v[2], v[3]); w.z = pk2(v[4], v[5]); w.w = pk2(v[6], v[7]); *(u32x4*)orow = w;
            w.x = pk2(v[8], v[9]); w.y = pk2(v[10], v[11]); w.z = pk2(v[12], v[13]); w.w = pk2(v[14], v[15]); *(u32x4*)(orow + 512) = w;
        }
    }
}

constexpr int KPB = 144;
template <int NKT, int MODE, int GT>
__device__ __forceinline__ void attn_rows(const LAS unsigned char* Kl, const LAS unsigned char* Vl, const int vpb, const bf16x8 (&qf)[4], const int r, const int hh, const int p0, const int p1,
                                          f32x16 (&o)[2], float& lse2) {
    constexpr int NG = (NKT + GT - 1) / GT;
    float mrun = -INFINITY, lrun = 0.f;
#pragma unroll
    for (int i = 0; i < 16; ++i) { o[0][i] = 0.f; o[1][i] = 0.f; }
#pragma unroll
    for (int grp = 0; grp < NG; ++grp) {
        constexpr int dummy = 0; (void)dummy;
        const int kt0 = grp * GT;
        const int nt = (NKT - kt0) < GT ? (NKT - kt0) : GT;
        const bool gact = MODE == 0 ? true : (MODE == 1 ? (kt0 <= p0) : (p1 != 0 || (p0 + kt0 + nt - 1 >= 4)));
        if (gact) {
            bf16x8 kf[GT][4];
#pragma unroll
            for (int q = 0; q < GT; ++q)
#pragma unroll
                for (int ks = 0; ks < 4; ++ks) if (q < nt) kf[q][ks] = *(const LAS bf16x8*)(Kl + ((kt0 + q) * 32 + r) * KPB + ks * 32 + hh * 16);
            f32x16 s[GT];
#pragma unroll
            for (int q = 0; q < GT; ++q)
#pragma unroll
                for (int i = 0; i < 16; ++i) s[q][i] = 0.f;
#pragma unroll
            for (int ks = 0; ks < 4; ++ks)
#pragma unroll
                for (int q = 0; q < GT; ++q) if (q < nt) s[q] = MFMA32(kf[q][ks], qf[ks], s[q]);
            bf16x8 vf[GT][2][2];
#pragma unroll
            for (int q = 0; q < GT; ++q)
#pragma unroll
                for (int s2 = 0; s2 < 2; ++s2)
#pragma unroll
                    for (int dt = 0; dt < 2; ++dt) if (q < nt) vf[q][s2][dt] = *(const LAS bf16x8*)(Vl + (dt * 32 + r) * vpb + ((kt0 + q) * 32 + s2 * 16 + hh * 8) * 2);
            if (MODE == 1) { if (p0 < 8) {
#pragma unroll
                for (int q = 0; q < GT; ++q) if (q < nt) { const int lim = (p0 - (kt0 + q)) * 32 + r;
#pragma unroll
                    for (int i = 0; i < 16; ++i) if (crow(i, hh) > lim) s[q][i] = -INFINITY; } } }
            if (MODE == 2) {
#pragma unroll
                for (int q = 0; q < GT; ++q) if (q < nt) { const int kt = kt0 + q;
                    if (kt == 0) {
#pragma unroll
                        for (int i = 0; i < 16; ++i) if (crow(i, hh) < r) s[q][i] = -INFINITY; }
                    if (kt == NKT - 1) {
#pragma unroll
                        for (int i = 0; i < 16; ++i) if (crow(i, hh) > r) s[q][i] = -INFINITY; } }
                if (p1 == 0) {
#pragma unroll
                    for (int q = 0; q < GT; ++q) if (q < nt) { if (p0 + kt0 + q < 4) {
#pragma unroll
                        for (int i = 0; i < 16; ++i) s[q][i] = -INFINITY; } } }
            }
            float mx = -INFINITY;
#pragma unroll
            for (int q = 0; q < GT; ++q) if (q < nt) {
#pragma unroll
                for (int i = 0; i < 16; ++i) mx = fmaxf(mx, s[q][i]); }
            mx = fmaxf(mx, __shfl_xor(mx, 32));
            const float mnew = fmaxf(mrun, mx);
            const float sc = __builtin_amdgcn_exp2f(mrun - mnew);
            mrun = mnew; lrun *= sc;
            if (grp > 0) {
#pragma unroll
                for (int i = 0; i < 16; ++i) { o[0][i] *= sc; o[1][i] *= sc; }
            }
#pragma unroll
            for (int q = 0; q < GT; ++q) if (q < nt) {
#pragma unroll
                for (int i = 0; i < 16; ++i) { const float p = __builtin_amdgcn_exp2f(s[q][i] - mnew); s[q][i] = p; lrun += p; }
#pragma unroll
                for (int s2 = 0; s2 < 2; ++s2) {
                    u32x4 pw; pw.x = pk2(s[q][8 * s2], s[q][8 * s2 + 1]); pw.y = pk2(s[q][8 * s2 + 2], s[q][8 * s2 + 3]); pw.z = pk2(s[q][8 * s2 + 4], s[q][8 * s2 + 5]); pw.w = pk2(s[q][8 * s2 + 6], s[q][8 * s2 + 7]);
                    const bf16x8 pf = __builtin_bit_cast(bf16x8, pw);
#pragma unroll
                    for (int dt = 0; dt < 2; ++dt) o[dt] = MFMA32(vf[q][s2][dt], pf, o[dt]);
                }
            }
        }
    }
    const float l = lrun + __shfl_xor(lrun, 32);
    const float inv = 1.0f / l;
#pragma unroll
    for (int i = 0; i < 16; ++i) { o[0][i] *= inv; o[1][i] *= inv; }
    lse2 = mrun + __builtin_amdgcn_logf(l);
}
__device__ __forceinline__ void store_o(bf16_t* dst, const f32x16 (&o)[2], int hh) {
#pragma unroll
    for (int dt = 0; dt < 2; ++dt)
#pragma unroll
        for (int g4 = 0; g4 < 4; ++g4) { u32x2 w; w.x = pk2(o[dt][4 * g4], o[dt][4 * g4 + 1]); w.y = pk2(o[dt][4 * g4 + 2], o[dt][4 * g4 + 3]); *(u32x2*)(dst + dt * 32 + 8 * g4 + 4 * hh) = w; }
}

constexpr int STG_PITCH = 144, STG_WAVE = 32 * STG_PITCH;
__device__ __forceinline__ void stage_o(LAS unsigned char* stg, const f32x16 (&o)[2], int r, int hh) {
#pragma unroll
    for (int dt = 0; dt < 2; ++dt)
#pragma unroll
        for (int g4 = 0; g4 < 4; ++g4) { u32x2 w; w.x = pk2(o[dt][4 * g4], o[dt][4 * g4 + 1]); w.y = pk2(o[dt][4 * g4 + 2], o[dt][4 * g4 + 3]); *(LAS u32x2*)(stg + r * STG_PITCH + dt * 64 + g4 * 16 + hh * 8) = w; }
    LDS_WAIT();
}
constexpr int STG8_PITCH = 80; constexpr float PO8_SCALE = 16.0f;
__device__ __forceinline__ void stage_o8(LAS unsigned char* stg, const f32x16 (&o)[2], int r, int hh) {
#pragma unroll
    for (int dt = 0; dt < 2; ++dt)
#pragma unroll
        for (int g4 = 0; g4 < 4; ++g4) {
            int w = __builtin_amdgcn_cvt_pk_fp8_f32(o[dt][4 * g4] * PO8_SCALE, o[dt][4 * g4 + 1] * PO8_SCALE, 0, false);
            w = __builtin_amdgcn_cvt_pk_fp8_f32(o[dt][4 * g4 + 2] * PO8_SCALE, o[dt][4 * g4 + 3] * PO8_SCALE, w, true);
            *(LAS int*)(stg + r * STG8_PITCH + dt * 32 + g4 * 8 + hh * 4) = w; }
    LDS_WAIT();
}
#define XB_TMO      128
#define XB_XCNT(j)  (256  + 64 * (j))
#define XB_XSUB(j)  (1280 + 64 * (j))
#define XB_XGEN(j)  (2304 + 64 * (j))
#define XB_TOP      3328
#define XB_TOPGEN   3392
#define XCD_BAR_WORDS 3456
#define XB_SPIN_CAP (1u << 18)

__device__ __forceinline__ unsigned xb_ld(unsigned* p)              { return __hip_atomic_load(p, __ATOMIC_RELAXED, __HIP_MEMORY_SCOPE_AGENT); }
__device__ __forceinline__ unsigned xb_add(unsigned* p, unsigned v) { return __hip_atomic_fetch_add(p, v, __ATOMIC_RELAXED, __HIP_MEMORY_SCOPE_AGENT); }
__device__ __forceinline__ unsigned xb_xcc_id() { return (unsigned)__builtin_amdgcn_s_getreg((3 << 11) | 20) & 0xFu; }
#define XB_SPIN(cond, bar) do { unsigned _sp = 0; while (cond) { __builtin_amdgcn_s_sleep(1); \
    if ((++_sp & 255u) == 0u) { if (xb_ld(&(bar)[XB_TMO])) break; if (_sp > XB_SPIN_CAP) { atomicAdd(&(bar)[XB_TMO], 1u); break; } } } } while (0)

struct XcdBarrier {
    unsigned* bar; unsigned x;
    volatile LAS unsigned* st;
};

__device__ __forceinline__ XcdBarrier xcd_barrier_post(unsigned* bar, volatile LAS unsigned* st) {
    XcdBarrier b; b.bar = bar; b.x = xb_xcc_id(); b.st = st;
    if (threadIdx.x == 0) (void)xb_add(&bar[XB_XCNT(b.x)], 1u);
    return b;
}
__device__ __forceinline__ void xcd_barrier_complete(unsigned* bar, unsigned x, unsigned& nloc, unsigned& nx) {
    const unsigned G = gridDim.x * gridDim.y * gridDim.z;
    unsigned sum, cnt, mine, sp = 0u;
    for (;;) {
        sum = 0u; cnt = 0u; mine = 0u;
#pragma unroll
        for (unsigned j = 0; j < 16; ++j) { const unsigned c = xb_ld(&bar[XB_XCNT(j)]); sum += c; cnt += (c > 0u) ? 1u : 0u; mine = (j == x) ? c : mine; }
        if (sum == G) break;
        __builtin_amdgcn_s_sleep(1);
        if ((++sp & 255u) == 0u) { if (xb_ld(&bar[XB_TMO])) break; if (sp > XB_SPIN_CAP) { atomicAdd(&bar[XB_TMO], 1u); break; } }
    }
    nloc = mine > 0u ? mine : 1u; nx = cnt > 0u ? cnt : 1u;
}

__device__ __forceinline__ void xcd_barrier(const XcdBarrier& b) {
    asm volatile("s_waitcnt vmcnt(0)" ::: "memory");
    __syncthreads();
    if (threadIdx.x == 0) {
        unsigned* bar = b.bar;
        __builtin_amdgcn_s_waitcnt(0);
        unsigned nloc = b.st[0], nx = b.st[1];
        if (nloc == 0u) { xcd_barrier_complete(bar, b.x, nloc, nx); b.st[0] = nloc; b.st[1] = nx; }
        const unsigned old = xb_add(&bar[XB_XSUB(b.x)], 1u);
        const unsigned gen = old / nloc;
        if (old + 1u == (gen + 1u) * nloc) {
            __builtin_amdgcn_fence(__ATOMIC_RELEASE, "agent");
            asm volatile("s_waitcnt vmcnt(0)" ::: "memory");
            const unsigned og = xb_add(&bar[XB_TOP], 1u);
            const unsigned tg = og / nx;
            if (og + 1u == (tg + 1u) * nx) xb_add(&bar[XB_TOPGEN], 1u);
            else XB_SPIN(xb_ld(&bar[XB_TOPGEN]) == tg, bar);
            __builtin_amdgcn_fence(__ATOMIC_ACQUIRE, "agent");
            xb_add(&bar[XB_XGEN(b.x)], 1u);
            asm volatile("s_waitcnt vmcnt(0)" ::: "memory");
        } else {
            XB_SPIN(xb_ld(&bar[XB_XGEN(b.x)]) == gen, bar);
            __builtin_amdgcn_fence(__ATOMIC_ACQUIRE, "agent");
            asm volatile("s_waitcnt vmcnt(0)" ::: "memory");
        }
    }
    __syncthreads();
}

struct Args { const float* in[11]; float* out; unsigned char* ws; int pad0, pad1; };

__global__ void __launch_bounds__(NTHR) hybrid_fwd(Args args) {
    extern __shared__ __attribute__((aligned(16))) unsigned char lds_raw[];
    LAS unsigned char* lds = (LAS unsigned char*)lds_raw;
    cg::grid_group grid = cg::this_grid();
    int tid = threadIdx.x, lane = tid & 63, wave = __builtin_amdgcn_readfirstlane(tid >> 6);
    const int G = gridDim.x, ngw = G * NWAVES; int gw = blockIdx.x * NWAVES + wave;
#define GRID_SYNC_CG() do { grid.sync(); asm volatile("" : "+v"(tid), "+v"(lane)); } while (0)
#define GRID_SYNC() do { xcd_barrier(xbar); asm volatile("" : "+v"(tid), "+v"(lane)); } while (0)
    if (tid < 2) ((LAS unsigned*)(lds + LDS_MISC + 256))[tid] = 0u;
    __syncthreads();
    const XcdBarrier xbar = xcd_barrier_post((unsigned*)(args.ws + WS_BAR), (volatile LAS unsigned*)(lds + LDS_MISC + 256));
    unsigned char* ws = args.ws;
    const float* x = args.in[0];
    bf16_t* Wqkv0 = (bf16_t*)(ws + WS_WQKV0); bf16_t* Wo0 = (bf16_t*)(ws + WS_WO0); bf16_t* Wqkv1 = (bf16_t*)(ws + WS_WQKV1); bf16_t* Wo1 = (bf16_t*)(ws + WS_WO1);
    float* cosT = (float*)(ws + WS_COS); float* sinT = (float*)(ws + WS_SIN);
    bf16_t* HB = (bf16_t*)(ws + WS_HB); bf16_t* Zb = (bf16_t*)(ws + WS_Z); bf16_t* Hm = (bf16_t*)(ws + WS_H);
    float* C1 = (float*)(ws + WS_C12); float* C2 = C1 + NC12; float* ST = (float*)(ws + WS_ST);
    unsigned* gcnt = (unsigned*)(ws + WS_CTL); float* KM = (float*)(ws + WS_KM);
    unsigned* LIST = (unsigned*)((unsigned char*)args.out + OUT_LIST); bf16_t* PO3 = (bf16_t*)((unsigned char*)args.out + OUT_PO3);

    if (PHM & 1u) {
        LAS float* scr = (LAS float*)(lds + wave * 16384);
        constexpr int I_QKV0 = (DM / 64) * (NQKV0 / 32), I_WO0 = (DM / 64) * (DM / 32), I_QKV1 = (DM / 64) * (NQKV1 / 32), I_WO1 = (D1 / 64) * (DM / 32), I_IN = (DM / 64) * (FF / 32), I_OUT = (FF / 64) * (DM / 32);
        constexpr int NITEMS = I_QKV0 + I_WO0 + I_QKV1 + I_WO1 + 2 * I_IN + 2 * I_OUT;
        for (int it = gw; it < NITEMS; it += ngw) {
            int rI = it;
            if (rI < I_QKV0) { transpose_item<true, false>(args.in[1], DM, NQKV0, Wqkv0, scr, rI, lane, nullptr, nullptr, nullptr, nullptr); continue; } rI -= I_QKV0;
            if (rI < I_WO0) { transpose_item<false, false>(args.in[2], DM, DM, Wo0, scr, rI, lane, nullptr, nullptr, nullptr, nullptr); continue; } rI -= I_WO0;
            if (rI < I_QKV1) { transpose_item<true, true>(args.in[3], DM, NQKV1, Wqkv1, scr, rI, lane, args.in[9], args.in[10], C1 + C_QKV1, C2 + C_QKV1); continue; } rI -= I_QKV1;
            if (rI < I_WO1) { transpose_item<false, false>(args.in[4], D1, DM, Wo1, scr, rI, lane, nullptr, nullptr, nullptr, nullptr); continue; } rI -= I_WO1;
            if (rI < 2 * I_IN) { const int l = rI / I_IN; transpose_item<false, true>(args.in[5] + (size_t)l * DM * FF, DM, FF, (bf16_t*)(ws + (l ? WS_WIN1 : WS_WIN0)), scr, rI - l * I_IN, lane, args.in[7] + l * DM, args.in[8] + l * DM, C1 + (l ? C_WIN1 : C_WIN0), C2 + (l ? C_WIN1 : C_WIN0)); continue; } rI -= 2 * I_IN;
            { const int l = rI / I_OUT; transpose_item<false, false>(args.in[6] + (size_t)l * DM * FF, FF, DM, (bf16_t*)(ws + (l ? WS_WOUT1 : WS_WOUT0)), scr, rI - l * I_OUT, lane, nullptr, nullptr, nullptr, nullptr); }
        }
        for (int idx = blockIdx.x * NTHR + tid; idx < SEQ * 32; idx += G * NTHR) {
            const int t = idx >> 5, e = idx & 31;
            const float inv = 1.0f / powf(10000.0f, (float)(2 * e) / 64.0f);
            const float ang = (float)t * inv;
            const double a = (double)ang, kk = rint(a * 0.15915494309189535), rd = fma(-kk, 6.283185307179586, a);
            const float rf = (float)rd;
            cosT[idx] = cosf(rf); sinT[idx] = sinf(rf);
        }
        for (int row = gw; row < MTOK; row += ngw) {
            const float* xr = x + (size_t)row * DM + 8 * lane;
            const f32x4 a0 = __builtin_nontemporal_load((const f32x4*)xr), a1 = __builtin_nontemporal_load((const f32x4*)(xr + 4)), b0 = __builtin_nontemporal_load((const f32x4*)(xr + 512)), b1 = __builtin_nontemporal_load((const f32x4*)(xr + 516));
            bf16_t* orow = HB + (size_t)row * DM + 8 * lane;
            u32x4 w; w.x = pk2(a0[0], a0[1]); w.y = pk2(a0[2], a0[3]); w.z = pk2(a1[0], a1[1]); w.w = pk2(a1[2], a1[3]); *(u32x4*)orow = w;
            w.x = pk2(b0[0], b0[1]); w.y = pk2(b0[2], b0[3]); w.z = pk2(b1[0], b1[1]); w.w = pk2(b1[2], b1[3]); *(u32x4*)(orow + 512) = w;
        }
    }
    __syncthreads();
    if (args.pad1 != 0) GRID_SYNC_CG();
    GRID_SYNC();

    bf16_t* Q0 = (bf16_t*)(ws + WS_Q); bf16_t* K0 = (bf16_t*)(ws + WS_K); bf16_t* VT0 = (bf16_t*)(ws + WS_VT); bf16_t* PO = (bf16_t*)(ws + WS_PO); float* PL = (float*)(ws + WS_PL);
    if (PHM & 2u) {
        pg8::Gemm g{HB, Wqkv0, MTOK, NQKV0, DM}; pg8::StaticOrder S; S.init(MTOK, NQKV0, G, (int)blockIdx.x);
        EpiQKV<0> E{Q0, K0, VT0, KM, cosT, sinT, nullptr, nullptr, nullptr};
        for (int repg = 0; repg < DUPG * DUPQ0; ++repg) pg8::gemm_phase<EpiQKV<0>, pg8::StaticOrder, G_ALIGN, G_SP2>(lds, g, S, E);
    }
    GRID_SYNC();
    if (PHM & 4u) {
        LAS unsigned* lcnt = (LAS unsigned*)(lds + LDS_MISC); LAS unsigned* lbase = lcnt + 32;
        const int r = lane & 31, hh = lane >> 5;
        for (int unit = blockIdx.x; unit < BATCH * 32 * 16; unit += G) {
            const int h = unit & 15, qb = (unit >> 4) & 31, b = unit >> 9;
            if (tid < 32) lcnt[tid] = 0u;
            __syncthreads();
            const int tq = qb * 256 + wave * 32 + r, token = b * 8192 + tq;
            bf16x8 qf[4];
#pragma unroll
            for (int ks = 0; ks < 4; ++ks) qf[ks] = *(const bf16x8*)(Q0 + (size_t)token * DM + h * 64 + ks * 16 + hh * 8);
            f32x16 gt;
#pragma unroll
            for (int i = 0; i < 16; ++i) gt[i] = 0.f;
            const float* kmr = KM + ((size_t)((b * 16 + h) * 32 + r)) * 64 + hh * 8;
#pragma unroll
            for (int ks = 0; ks < 4; ++ks) { const f32x4 k0 = *(const f32x4*)(kmr + ks * 16), k1 = *(const f32x4*)(kmr + ks * 16 + 4);
                u32x4 kw; kw.x = pk2(k0[0], k0[1]); kw.y = pk2(k0[2], k0[3]); kw.z = pk2(k1[0], k1[1]); kw.w = pk2(k1[2], k1[3]);
                gt = MFMA32(__builtin_bit_cast(bf16x8, kw), qf[ks], gt); }
            float v0 = -3.0e38f, v1 = -3.0e38f, v2 = -3.0e38f;
#define TOP_INS(val) do { float t_ = (val); const float a_ = fmaxf(v0, t_); t_ = fminf(v0, t_); v0 = a_; const float b_ = fmaxf(v1, t_); t_ = fminf(v1, t_); v1 = b_; v2 = fmaxf(v2, t_); } while (0)
#pragma unroll
            for (int i = 0; i < 16; ++i) { const int j = crow(i, hh); const float gv_ = j < qb ? gt[i] : -3.0e38f; TOP_INS(__uint_as_float((__float_as_uint(gv_) & ~31u) | (unsigned)j)); }
            { const float pv0 = __shfl_xor(v0, 32), pv1 = __shfl_xor(v1, 32), pv2 = __shfl_xor(v2, 32); TOP_INS(pv0); TOP_INS(pv1); TOP_INS(pv2); }
#undef TOP_INS
            const int i0 = (int)(__float_as_uint(v0) & 31u), i1 = (int)(__float_as_uint(v1) & 31u), i2 = (int)(__float_as_uint(v2) & 31u);
            const int nvalid = qb < 3 ? qb : 3;
            unsigned lp0 = 0, lp1 = 0, lp2 = 0;
            if (hh == 0) {
                if (0 < nvalid) lp0 = __hip_atomic_fetch_add(lcnt + i0, 1u, __ATOMIC_RELAXED, __HIP_MEMORY_SCOPE_WORKGROUP); else PL[((size_t)0 * MTOK + token) * 16 + h] = -INFINITY;
                if (1 < nvalid) lp1 = __hip_atomic_fetch_add(lcnt + i1, 1u, __ATOMIC_RELAXED, __HIP_MEMORY_SCOPE_WORKGROUP); else PL[((size_t)1 * MTOK + token) * 16 + h] = -INFINITY;
                if (2 < nvalid) lp2 = __hip_atomic_fetch_add(lcnt + i2, 1u, __ATOMIC_RELAXED, __HIP_MEMORY_SCOPE_WORKGROUP); else PL[((size_t)2 * MTOK + token) * 16 + h] = -INFINITY;
            }
            __syncthreads();
            if (tid < 32) { const unsigned c = lcnt[tid]; lbase[tid] = c ? __hip_atomic_fetch_add(gcnt + (b * 16 + h) * 32 + tid, c, __ATOMIC_RELAXED, __HIP_MEMORY_SCOPE_AGENT) : 0u; }
            __syncthreads();
            if (hh == 0) {
                unsigned* lst = LIST + (size_t)(b * 16 + h) * LIST_CAP;
                if (0 < nvalid) lst[256 * (31 * i0 - (i0 * (i0 - 1)) / 2) + lbase[i0] + lp0] = (unsigned)tq | (0u << 13);
                if (1 < nvalid) lst[256 * (31 * i1 - (i1 * (i1 - 1)) / 2) + lbase[i1] + lp1] = (unsigned)tq | (1u << 13);
                if (2 < nvalid) lst[256 * (31 * i2 - (i2 * (i2 - 1)) / 2) + lbase[i2] + lp2] = (unsigned)tq | (2u << 13);
            }
        }
    }
    __syncthreads();
    GRID_SYNC();
#ifndef DUP3
#define DUP3 1
#endif
#ifndef DUP10
#define DUP10 1
#endif
    for (int rep3 = 0; rep3 < DUP3; ++rep3) {
        const LAS unsigned char* Kl = lds; const LAS unsigned char* Vl = lds + 256 * KPB; constexpr int VPB = (256 + 8) * 2;
        const int r = lane & 31, hh = lane >> 5;
        bf16_t* dump = (bf16_t*)(ws + WS_DUMP) + (size_t)((blockIdx.x & 255) * NWAVES + wave) * 2048;
        u32x4 kreg[4], vreg[4];
#define P3_LOADKV(b_, h_, j_) do { _Pragma("unroll") for (int i = 0; i < 4; ++i) { const int c = tid + NTHR * i; \
            kreg[i] = __builtin_nontemporal_load((const u32x4*)(K0 + (size_t)((b_) * 8192 + (j_) * 256 + (c >> 3)) * DM + (h_) * 64 + (c & 7) * 8)); \
            vreg[i] = __builtin_nontemporal_load((const u32x4*)(VT0 + ((size_t)((b_) * 16 + (h_)) * 64 + (c >> 5)) * 8192 + (j_) * 256 + (c & 31) * 8)); } } while (0)
        LAS int* sh_n = (LAS int*)(lds + LDS_MISC + 512); LAS int* sh_order = sh_n + 32; LAS int* sh_myj = sh_order + 32; LAS int* sh_cnt = sh_myj + 32;
      for (int v = blockIdx.x; v < 256; v += G) {
        const int bh = (v & 7) * 8 + (v >> 5), q4 = (v >> 3) & 3, b = bh >> 4, h = bh & 15;
        __syncthreads();
        if (tid < 32) sh_n[tid] = 256 + (int)gcnt[bh * 32 + tid] + 128;
        __syncthreads();
        if (tid < 32) { const int nj = sh_n[tid]; int rank = 0;
            for (int i = 0; i < 32; ++i) { const int ni = sh_n[i]; rank += (ni > nj || (ni == nj && i < tid)) ? 1 : 0; }
            sh_order[rank] = tid; }
        __syncthreads();
        if (tid == 0) { int l0 = 0, l1 = 0, l2 = 0, l3 = 0, cnt = 0;
            for (int k = 0; k < 32; ++k) { const int jx = sh_order[k], w = sh_n[jx];
                int bin = 0, lm = l0; if (l1 < lm) { lm = l1; bin = 1; } if (l2 < lm) { lm = l2; bin = 2; } if (l3 < lm) { lm = l3; bin = 3; }
                l0 += bin == 0 ? w : 0; l1 += bin == 1 ? w : 0; l2 += bin == 2 ? w : 0; l3 += bin == 3 ? w : 0;
                if (bin == q4) { sh_myj[cnt] = jx; ++cnt; } }
            sh_cnt[0] = cnt; }
        __syncthreads();
        const int nit = sh_cnt[0];
        const bf16_t* Qbh = Q0 + (size_t)b * 8192 * DM + h * 64 + hh * 8;
        bf16x8 qf[4];
        if (nit > 0) { const int j0 = sh_myj[0]; P3_LOADKV(b, h, j0);
#pragma unroll
            for (int ks = 0; ks < 4; ++ks) qf[ks] = *(const bf16x8*)(Qbh + (size_t)(j0 * 256 + wave * 32 + r) * DM + ks * 16); }
#define RAW_BARRIER() do { asm volatile("s_waitcnt lgkmcnt(0)" ::: "memory"); __builtin_amdgcn_s_barrier(); asm volatile("" ::: "memory"); } while (0)
        for (int it = 0; it < nit; ++it) {
            const int j = sh_myj[it], jn = (it + 1 < nit) ? sh_myj[it + 1] : -1;
            RAW_BARRIER();
#pragma unroll
            for (int i = 0; i < 4; ++i) { const int c = tid + NTHR * i;
                *(LAS u32x4*)(lds + (c >> 3) * KPB + (c & 7) * 16) = kreg[i];
                *(LAS u32x4*)(lds + 256 * KPB + (c >> 5) * VPB + (c & 31) * 16) = vreg[i]; }
            RAW_BARRIER();
            if (jn >= 0) P3_LOADKV(b, h, jn);
#ifdef P3_PROBE_OWNONLY
            const int n = (rep3 + 1 < DUP3) ? 256 : 256 + (int)gcnt[bh * 32 + j], ngroups = (n + 31) >> 5;
#else
            const int n = 256 + (int)gcnt[bh * 32 + j], ngroups = (n + 31) >> 5;
#endif
            const unsigned* lst = LIST + (size_t)bh * LIST_CAP + 256 * (31 * j - (j * (j - 1)) / 2);
            int g = wave;
            int tq = j * 256 + g * 32 + r, slot = 3; bool valid = true;
            const int tqN = (jn >= 0 ? jn : j) * 256 + wave * 32 + r;
            unsigned en = 0u; bool vn = false;
            if (g + 8 < ngroups) { const int row = (g + 8) * 32 + r; vn = row < n; en = lst[vn ? row - 256 : 0]; }
            for (; g < ngroups; g += NWAVES) {
                bf16x8 q1[4]; int tq1 = tqN, slot1 = 3; unsigned en2 = 0u; bool vn2 = false;
                if (g + 8 < ngroups) { tq1 = (int)(en & 8191u); slot1 = (int)(en >> 13); }
#pragma unroll
                for (int ks = 0; ks < 4; ++ks) q1[ks] = *(const bf16x8*)(Qbh + (size_t)tq1 * DM + ks * 16);
                if (g + 16 < ngroups) { const int row = (g + 16) * 32 + r; vn2 = row < n; en2 = lst[vn2 ? row - 256 : 0]; }
                f32x16 o[2]; float lse2;
                attn_rows<8, 1, 2>(Kl, Vl, VPB, qf, r, hh, g < 8 ? g : 99, 0, o, lse2);
                {
                    LAS unsigned char* stg = lds + 73728 + wave * STG_WAVE;
                    stage_o8(stg, o, r, hh);
                    const int myinfo = tq | (slot << 13) | (valid ? (1 << 15) : 0);
                    {
                        const int R = lane >> 1, half = lane & 1;
                        const u32x4 v0 = *(const LAS u32x4*)(stg + R * STG8_PITCH + half * 32), v1 = *(const LAS u32x4*)(stg + R * STG8_PITCH + half * 32 + 16);
                        const int info = __shfl(myinfo, R), tqR = info & 8191, slotR = (info >> 13) & 3;
                        unsigned char* dstp = (slotR == 3 ? (unsigned char*)PO3 : (unsigned char*)PO + (size_t)slotR * MTOK * DM) + ((size_t)b * 8192 + tqR) * DM + h * 64 + half * 32;
                        if (!(info & (1 << 15))) dstp = (unsigned char*)dump + lane * 32;
                        __builtin_nontemporal_store(v0, (u32x4*)dstp); __builtin_nontemporal_store(v1, (u32x4*)(dstp + 16));
                    }
                    { float* plp = PL + ((size_t)slot * MTOK + (size_t)b * 8192 + tq) * 16 + h; if (!valid) plp = (float*)(dump + 1024) + lane; *plp = lse2; }
                }
#pragma unroll
                for (int ks = 0; ks < 4; ++ks) qf[ks] = q1[ks];
                tq = tq1; slot = slot1; valid = vn; en = en2; vn = vn2;
            }
        }
      }
#undef P3_LOADKV
#undef RAW_BARRIER
    }
    __syncthreads();
    GRID_SYNC();
    if (PHM & 16u) {
        const int head = lane >> 2, part = lane & 3;
        for (int token = gw; token < MTOK; token += ngw) {
            float ls[4], mxl = -INFINITY;
#pragma unroll
            for (int s = 0; s < 4; ++s) { ls[s] = PL[((size_t)s * MTOK + token) * 16 + head]; mxl = fmaxf(mxl, ls[s]); }
            float accv[16], den = 0.f;
#pragma unroll
            for (int i = 0; i < 16; ++i) accv[i] = 0.f;
#pragma unroll
            for (int s = 0; s < 4; ++s) {
                const float w = __builtin_amdgcn_exp2f(ls[s] - mxl);
                if (w > 0.f) {
                    den += w;
                    const unsigned char* src = (s == 3 ? (const unsigned char*)PO3 : (const unsigned char*)PO + (size_t)s * MTOK * DM) + (size_t)token * DM + head * 64 + part * 16;
                    const u32x4 a = *(const u32x4*)src;
                    const float ws_ = w * (1.0f / PO8_SCALE);
#pragma unroll
                    for (int k = 0; k < 4; ++k) { const f32x2_t lo = __builtin_amdgcn_cvt_pk_f32_fp8((int)a[k], false), hi = __builtin_amdgcn_cvt_pk_f32_fp8((int)a[k], true);
                        accv[4 * k] += ws_ * lo.x; accv[4 * k + 1] += ws_ * lo.y; accv[4 * k + 2] += ws_ * hi.x; accv[4 * k + 3] += ws_ * hi.y; }
                }
            }
            const float inv = 1.0f / den;
            bf16_t* dst = Q0 + (size_t)token * DM + head * 64 + part * 16;
            u32x4 w0, w1;
            w0.x = pk2(accv[0] * inv, accv[1] * inv); w0.y = pk2(accv[2] * inv, accv[3] * inv); w0.z = pk2(accv[4] * inv, accv[5] * inv); w0.w = pk2(accv[6] * inv, accv[7] * inv);
            w1.x = pk2(accv[8] * inv, accv[9] * inv); w1.y = pk2(accv[10] * inv, accv[11] * inv); w1.z = pk2(accv[12] * inv, accv[13] * inv); w1.w = pk2(accv[14] * inv, accv[15] * inv);
            *(u32x4*)dst = w0; *(u32x4*)(dst + 8) = w1;
        }
    }
    GRID_SYNC();
    if (PHM & 32u) {
        pg8::Gemm g{Q0, Wo0, MTOK, DM, DM}; pg8::StaticOrder S; S.init(MTOK, DM, G, (int)blockIdx.x);
        EpiResid<0> E{HB, Zb, nullptr, ST, nullptr, nullptr};
        for (int repg = 0; repg < DUPG; ++repg) pg8::gemm_phase<EpiResid<0>, pg8::StaticOrder, G_ALIGN, G_SP2>(lds, g, S, E);
    }
    GRID_SYNC();
    if (PHM & 64u) {
        pg8::Gemm g{Zb, (const bf16_t*)(ws + WS_WIN0), MTOK, FF, DM}; pg8::StaticOrder S; S.init(MTOK, FF, G, (int)blockIdx.x);
        EpiSqRelu E{Hm, FF, ST, C1 + C_WIN0, C2 + C_WIN0};
        for (int repg = 0; repg < DUPG * DUPU; ++repg) pg8::gemm_phase<EpiSqRelu, pg8::StaticOrder, G_ALIGN, G_SP2>(lds, g, S, E);
    }
    GRID_SYNC();
    {
        pg8::Gemm g{Hm, (const bf16_t*)(ws + WS_WOUT0), MTOK, DM, FF}; pg8::StaticOrder S; S.init(MTOK, DM, G, (int)blockIdx.x);
        EpiResid<1> E{nullptr, Zb, ST, ST + 2 * MTOK, args.in[7], args.in[8]};
        for (int repg = 0; repg < DUPG; ++repg) pg8::gemm_phase<EpiResid<1>, pg8::StaticOrder, G_ALIGN, G_SP2>(lds, g, S, E);
    }
    GRID_SYNC();

    bf16_t* Q1 = (bf16_t*)(ws + WS_Q1); bf16_t* K1 = (bf16_t*)(ws + WS_K1); bf16_t* VT1 = (bf16_t*)(ws + WS_VT1); bf16_t* PO1 = (bf16_t*)(ws + WS_PO1); float* PL1 = (float*)(ws + WS_PL1);
    if (PHM & 128u) {
        pg8::Gemm g{Zb, Wqkv1, MTOK, NQKV1, DM}; pg8::StaticOrder S; S.init(MTOK, NQKV1, G, (int)blockIdx.x);
        EpiQKV<1> E{Q1, K1, VT1, nullptr, cosT, sinT, ST + 2 * MTOK, C1 + C_QKV1, C2 + C_QKV1};
        for (int repg = 0; repg < DUPG * DUPQ1; ++repg) pg8::gemm_phase<EpiQKV<1>, pg8::StaticOrder, G_ALIGN, G_SP2>(lds, g, S, E);
    }
    GRID_SYNC();
    for (int rep10 = 0; rep10 < DUP10; ++rep10) {
        constexpr int VPB = (384 + 8) * 2; const int r = lane & 31, hh = lane >> 5;
        u32x4 kreg[6], vreg[6];
#define P10_DECODE(unit_, pp_, head_, b_, dsh_, gb_, hp_) const int pp_ = (unit_) & 31, head_ = ((unit_) >> 5) % 12, b_ = (unit_) / (32 * 12), dsh_ = 2 * (head_ >> 2), gb_ = 2 * pp_, hp_ = ((gb_ & ((64 >> dsh_) - 1)) != 0) ? 1 : 0
#define P10_LOAD(b_, head_, gb_, hp_) do { _Pragma("unroll") for (int i = 0; i < 6; ++i) { const int c = tid + NTHR * i; \
            { const int f = c >> 3, part = c & 7; kreg[i] = (u32x4){0u, 0u, 0u, 0u}; \
              if ((hp_) || f >= 128) kreg[i] = __builtin_nontemporal_load((const u32x4*)(K1 + ((size_t)(b_) * 8192 + ((gb_) - 1) * 128 + f) * D1 + (head_) * 64 + part * 8)); } \
            { const int d = c / 48, part = c - d * 48; vreg[i] = (u32x4){0u, 0u, 0u, 0u}; \
              if ((hp_) || part >= 16) vreg[i] = __builtin_nontemporal_load((const u32x4*)(VT1 + ((size_t)((b_) * 12 + (head_)) * 64 + d) * 8192 + ((gb_) - 1) * 128 + part * 8)); } } } while (0)
#define RAW_BARRIER() do { asm volatile("s_waitcnt lgkmcnt(0)" ::: "memory"); __builtin_amdgcn_s_barrier(); asm volatile("" ::: "memory"); } while (0)
        if ((int)blockIdx.x < BATCH * 12 * 32) { P10_DECODE((int)blockIdx.x, pp0, head0, b0, dsh0, gb0, hp0); P10_LOAD(b0, head0, gb0, hp0); }
        for (int unit = blockIdx.x; unit < BATCH * 12 * 32; unit += G) {
            P10_DECODE(unit, pp, head, b, dsh, gb, hasprev);
            bf16x8 qc[4];
#pragma unroll
            for (int ks = 0; ks < 4; ++ks) qc[ks] = *(const bf16x8*)(Q1 + ((size_t)b * 8192 + gb * 128 + wave * 32 + r) * D1 + head * 64 + ks * 16 + hh * 8);
            RAW_BARRIER();
#pragma unroll
            for (int i = 0; i < 6; ++i) { const int c = tid + NTHR * i;
                *(LAS u32x4*)(lds + (c >> 3) * KPB + (c & 7) * 16) = kreg[i];
                { const int d = c / 48, part = c - d * 48; *(LAS u32x4*)(lds + 384 * KPB + d * VPB + part * 16) = vreg[i]; } }
            RAW_BARRIER();
            if (unit + G < BATCH * 12 * 32) { P10_DECODE(unit + G, ppn, headn, bn, dshn, gbn, hpn); P10_LOAD(bn, headn, gbn, hpn); }
            const int rr = gb * 128 + wave * 32 + r;
            f32x16 o[2]; float lse2;
            attn_rows<5, 2, 2>(lds + wave * 32 * KPB, lds + 384 * KPB + wave * 64, VPB, qc, r, hh, wave, hasprev, o, lse2);
            const int t = ((rr & ((8192 >> dsh) - 1)) << dsh) | (rr >> (13 - dsh));
            const size_t token = (size_t)b * 8192 + t;
            {
                LAS unsigned char* stg = lds + 384 * KPB + 64 * VPB + wave * STG_WAVE;
                stage_o(stg, o, r, hh);
#pragma unroll
                for (int i = 0; i < 4; ++i) {
                    const int R = i * 8 + (lane >> 3), chunk = lane & 7;
                    const u32x4 vrow = *(const LAS u32x4*)(stg + R * STG_PITCH + chunk * 16);
                    const int tR = __shfl(t, R);
                    *(u32x4*)(PO1 + ((size_t)b * 8192 + tR) * D1 + head * 64 + chunk * 8) = vrow;
                }
            }
            PL1[token * 12 + head] = lse2;
        }
#undef P10_DECODE
#undef P10_LOAD
#undef RAW_BARRIER
    }
    __syncthreads();
    GRID_SYNC();
    {
        const int head = lane >> 2, part = lane & 3, hs = head & 3, gsel = head >> 2;
        for (int token = gw; token < MTOK; token += ngw) {
            if (lane < 48) {
                const float l0 = PL1[(size_t)token * 12 + hs], l1 = PL1[(size_t)token * 12 + 4 + hs], l2 = PL1[(size_t)token * 12 + 8 + hs];
                const float mxl = fmaxf(l0, fmaxf(l1, l2));
                const float w0 = __builtin_amdgcn_exp2f(l0 - mxl), w1 = __builtin_amdgcn_exp2f(l1 - mxl), w2 = __builtin_amdgcn_exp2f(l2 - mxl);
                const float al = (gsel == 0 ? w0 : (gsel == 1 ? w1 : w2)) / (w0 + w1 + w2);
                bf16_t* p = PO1 + (size_t)token * D1 + head * 64 + part * 16;
                u32x4 a = *(const u32x4*)p, c = *(const u32x4*)(p + 8);
                a.x = pk2(al * bf_lo(a.x), al * bf_hi(a.x)); a.y = pk2(al * bf_lo(a.y), al * bf_hi(a.y)); a.z = pk2(al * bf_lo(a.z), al * bf_hi(a.z)); a.w = pk2(al * bf_lo(a.w), al * bf_hi(a.w));
                c.x = pk2(al * bf_lo(c.x), al * bf_hi(c.x)); c.y = pk2(al * bf_lo(c.y), al * bf_hi(c.y)); c.z = pk2(al * bf_lo(c.z), al * bf_hi(c.z)); c.w = pk2(al * bf_lo(c.w), al * bf_hi(c.w));
                *(u32x4*)p = a; *(u32x4*)(p + 8) = c;
            }
        }
    }
    GRID_SYNC();
    {
        pg8::Gemm g{PO1, Wo1, MTOK, DM, D1}; pg8::StaticOrder S; S.init(MTOK, DM, G, (int)blockIdx.x);
        EpiResid<1> E{nullptr, Zb, ST + 2 * MTOK, ST + 4 * MTOK, args.in[9], args.in[10]};
        for (int repg = 0; repg < DUPG; ++repg) pg8::gemm_phase<EpiResid<1>, pg8::StaticOrder, G_ALIGN, G_SP2>(lds, g, S, E);
    }
    GRID_SYNC();
    {
        pg8::Gemm g{Zb, (const bf16_t*)(ws + WS_WIN1), MTOK, FF, DM}; pg8::StaticOrder S; S.init(MTOK, FF, G, (int)blockIdx.x);
        EpiSqRelu E{Hm, FF, ST + 4 * MTOK, C1 + C_WIN1, C2 + C_WIN1};
        for (int repg = 0; repg < DUPG * DUPU; ++repg) pg8::gemm_phase<EpiSqRelu, pg8::StaticOrder, G_ALIGN, G_SP2>(lds, g, S, E);
    }
    GRID_SYNC();
    {
        pg8::Gemm g{Hm, (const bf16_t*)(ws + WS_WOUT1), MTOK, DM, FF}; pg8::StaticOrder S; S.init(MTOK, DM, G, (int)blockIdx.x);
        EpiResid<1> E{nullptr, Zb, ST + 4 * MTOK, ST + 6 * MTOK, args.in[7] + DM, args.in[8] + DM};
        for (int repg = 0; repg < DUPG; ++repg) pg8::gemm_phase<EpiResid<1>, pg8::StaticOrder, G_ALIGN, G_SP2>(lds, g, S, E);
    }
    GRID_SYNC();
    ln_phase<true>(Zb, args.in[9] + DM, args.in[10] + DM, nullptr, args.out, gw, ngw, lane);
}

extern "C" void kernel_launch(void* const* d_in, const int* in_sizes, int n_in, void* d_out, int out_size, void* d_ws, size_t ws_size, hipStream_t stream) {
    static int grid_blocks = 0;
    if (grid_blocks == 0) {
        if (n_in != 11 || out_size != MTOK * DM || ws_size < WS_END) { fprintf(stderr, "kernel_launch: unexpected shapes (n_in %d, out %d, ws %zu)\n", n_in, out_size, ws_size); grid_blocks = -1; return; }
        int dev = 0, cus = 0, per_cu = 0;
        hipGetDevice(&dev);
        hipDeviceGetAttribute(&cus, hipDeviceAttributeMultiprocessorCount, dev);
        if (hipFuncSetAttribute((const void*)hybrid_fwd, hipFuncAttributeMaxDynamicSharedMemorySize, LDS_BYTES) != hipSuccess) { fprintf(stderr, "kernel_launch: hipFuncSetAttribute failed\n"); }
        if (hipOccupancyMaxActiveBlocksPerMultiprocessor(&per_cu, (const void*)hybrid_fwd, NTHR, LDS_BYTES) != hipSuccess || per_cu < 1) { fprintf(stderr, "kernel_launch: occupancy query says %d blocks per CU\n", per_cu); per_cu = 1; (void)hipGetLastError(); }
        if (per_cu > 1) per_cu = 1;
        grid_blocks = cus * per_cu;
    }
    if (grid_blocks < 0) return;
    (void)hipMemsetAsync((char*)d_ws + WS_CTL, 0, CTL_BYTES, stream);
    Args a{};
    for (int i = 0; i < 11; ++i) a.in[i] = (const float*)d_in[i];
    a.out = (float*)d_out; a.ws = (unsigned char*)d_ws;
    void* kargs[] = {&a};
    hipError_t e = hipLaunchCooperativeKernel((const void*)hybrid_fwd, dim3(grid_blocks), dim3(NTHR), kargs, LDS_BYTES, stream);
    if (e != hipSuccess) fprintf(stderr, "kernel_launch: cooperative launch failed: %s (grid %d)\n", hipGetErrorString(e), grid_blocks);
}
```

```cpp
#include <hip/hip_runtime.h>
#include <hip/hip_cooperative_groups.h>
#include <cstdio>
#include <cstdint>
namespace cg = cooperative_groups;
namespace pg8 {
#define PG8_LAS __attribute__((address_space(3)))
typedef unsigned short bf16_t;
typedef short bf16x8 __attribute__((ext_vector_type(8)));
typedef float f32x4 __attribute__((ext_vector_type(4)));
typedef unsigned u32x4 __attribute__((ext_vector_type(4)));
constexpr int BM = 256, BK = 64, HALF = 128, HTB = HALF * BK * 2  , STAGE_BYTES = 8 * HTB, NXCD = 8, WGM = 4;

__host__ __device__ __forceinline__ int lds_byte(int r, int c) { const int st = (r >> 4) * 2 + (c >> 5), rr = r & 15, cc = c & 31, ob = rr * 64 + cc * 2; return st * 1024 + (ob ^ (((ob >> 9) & 1) << 5)); }
__host__ __device__ __forceinline__ void stage_rc(int b, int& R, int& C) { const int st = b / 1024, sb = b % 1024, swz = sb ^ (((sb >> 9) & 1) << 5); R = (st >> 1) * 16 + swz / 64; C = (st & 1) * 32 + (swz % 64) / 2; }
__host__ __device__ __forceinline__ int perm32(int rho) { const int n = rho >> 4, i = rho & 15; return 8 * (i >> 2) + 4 * n + (i & 3); }

struct Unit { int pm, pn; };
struct Gemm { const bf16_t* A; const bf16_t* Bt; int M, N, K; };

struct StaticOrder {
    int nM, nN, nwg, G, c;
    __host__ __device__ void init(int M, int N, int G_, int c_) { nM = M / BM; nN = N / BM; nwg = nM * nN; G = G_; c = c_; }
    __host__ __device__ bool next(int i, Unit& u) const {
        const long L = (long)i * G + c; if (L >= nwg) return false;
        int wgid = (int)L; { const int q = nwg / NXCD, r = nwg % NXCD, xcd = wgid % NXCD, off = wgid / NXCD; wgid = (xcd < r ? xcd * (q + 1) : r * (q + 1) + (xcd - r) * q) + off; }
        const int nig = WGM * nN, gid = wgid / nig, fm = gid * WGM, gsz = (nM - fm) < WGM ? (nM - fm) : WGM;
        u.pm = fm + ((wgid % nig) % gsz); u.pn = (wgid % nig) / gsz; return true;
    }
    __device__ __forceinline__ void a_ready(const Unit&) const {}
    __device__ __forceinline__ void done(const Unit&) const {}
};


__device__ __forceinline__ unsigned cvt_pk_bf16(float lo, float hi) { unsigned r; asm volatile("v_cvt_pk_bf16_f32 %0, %1, %2" : "=v"(r) : "v"(lo), "v"(hi)); return r; }
typedef float f32x2 __attribute__((ext_vector_type(2)));

template <class Epi, class Sched, bool ALIGN_EPI = false, bool SP2 = false>
__device__ __forceinline__ void gemm_phase(PG8_LAS unsigned char* lds, const Gemm g, const Sched& S, const Epi& E) {
    int tid_ = threadIdx.x; asm volatile("" : "+v"(tid_));
    const int tid = tid_, wid = __builtin_amdgcn_readfirstlane(tid >> 6), lane = tid & 63, wr = wid >> 2, wc = wid & 3, fr = lane & 15, fq = lane >> 4;
    const int K = g.K, nt = K / BK;
    unsigned voffA[2], voffB[2];
#pragma unroll
    for (int i = 0; i < 2; ++i) { int R, C; stage_rc(tid * 16 + i * 8192, R, C); const int Rb = Epi::PERM ? ((R & ~31) + perm32(R & 31)) : R;
        voffA[i] = (unsigned)(R * K + C) * 2u; voffB[i] = (unsigned)(Rb * K + C) * 2u; }
    const size_t kstep = (size_t)(BK * 2);
    const size_t hstep = (size_t)HALF * K * 2;
    const size_t tstep = 2 * hstep;
    const unsigned ldsw = (unsigned)wid * 1024u;
    const int aoff = lds_byte(wr * 64 + fr, fq * 8), boff = lds_byte(wc * 32 + fr, fq * 8);
#define PG8_SA(b, h) (((b) * 2 + (h)) * HTB)
#define PG8_SB(b, h) ((4 + (b) * 2 + (h)) * HTB)
#define PG8_STAGE(bufoff, gbase, voff) do { _Pragma("unroll") for (int _i = 0; _i < 2; ++_i) \
        __builtin_amdgcn_global_load_lds((const unsigned*)((const char*)(gbase) + (voff)[_i]), (PG8_LAS unsigned*)(lds + (bufoff) + ldsw + _i * 8192), 16, 0, 0); } while (0)
#define PG8_LDA(dst, b, h) do { _Pragma("unroll") for (int m = 0; m < 4; ++m) _Pragma("unroll") for (int k = 0; k < 2; ++k) dst[m][k] = *(const PG8_LAS bf16x8*)(lds + PG8_SA(b, h) + aoff + m * 2048 + k * 1024); } while (0)
#define PG8_LDB(dst, b, h) do { _Pragma("unroll") for (int n = 0; n < 2; ++n) _Pragma("unroll") for (int k = 0; k < 2; ++k) dst[n][k] = *(const PG8_LAS bf16x8*)(lds + PG8_SB(b, h) + boff + n * 2048 + k * 1024); } while (0)
#define PG8_MMA(ai, bj, At, Bt) do { __builtin_amdgcn_s_setprio(1); _Pragma("unroll") for (int m = 0; m < 4; ++m) _Pragma("unroll") for (int n = 0; n < 2; ++n) _Pragma("unroll") for (int k = 0; k < 2; ++k) \
        acc[ai][bj][m][n] = __builtin_amdgcn_mfma_f32_16x16x32_bf16(Bt[n][k], At[m][k], acc[ai][bj][m][n], 0, 0, 0); __builtin_amdgcn_s_setprio(0); } while (0)
#define PG8_WAIT_V(n) asm volatile("s_waitcnt vmcnt(" #n ")" ::: "memory")
#define PG8_WAIT_L(n) asm volatile("s_waitcnt lgkmcnt(" #n ")" ::: "memory")
#define PG8_BAR __builtin_amdgcn_s_barrier()
#define PG8_SCHED __builtin_amdgcn_sched_barrier(0)
    Unit cur, nxt; int ui = 0;
    if (!S.next(0, cur)) return;
    f32x4 acc[2][2][4][2];
#pragma unroll
    for (int a = 0; a < 2; ++a)
#pragma unroll
        for (int b = 0; b < 2; ++b)
#pragma unroll
            for (int m = 0; m < 4; ++m)
#pragma unroll
                for (int n = 0; n < 2; ++n) acc[a][b][m][n] = (f32x4){0.f, 0.f, 0.f, 0.f};
    bf16x8 At[4][2], B0[2][2], B1[2][2];
    const char* cA = (const char*)g.A + (size_t)cur.pm * tstep; const char* cB = (const char*)g.Bt + (size_t)cur.pn * tstep;
    S.a_ready(cur);
    if constexpr (SP2) {
        PG8_STAGE(PG8_SB(0, 0), cB, voffB); PG8_STAGE(PG8_SB(0, 1), cB + hstep, voffB); PG8_STAGE(PG8_SA(0, 0), cA, voffA); PG8_STAGE(PG8_SA(0, 1), cA + hstep, voffA);
        if (wr == 1) PG8_BAR;
        PG8_WAIT_V(2); PG8_BAR;
        PG8_STAGE(PG8_SB(1, 0), cB + kstep, voffB); PG8_STAGE(PG8_SA(1, 0), cA + kstep, voffA); PG8_STAGE(PG8_SB(1, 1), cB + hstep + kstep, voffB);
        PG8_WAIT_V(6); PG8_BAR;
    } else {
        PG8_STAGE(PG8_SB(0, 0), cB, voffB); PG8_STAGE(PG8_SA(0, 0), cA, voffA); PG8_STAGE(PG8_SB(0, 1), cB + hstep, voffB); PG8_STAGE(PG8_SA(0, 1), cA + hstep, voffA);
        if (wr == 1) PG8_BAR;
        PG8_WAIT_V(4); PG8_BAR;
        PG8_STAGE(PG8_SB(1, 0), cB + kstep, voffB); PG8_STAGE(PG8_SA(1, 0), cA + kstep, voffA); PG8_STAGE(PG8_SB(1, 1), cB + hstep + kstep, voffB);
        PG8_WAIT_V(6); PG8_BAR;
    }
    for (;;) {
        const bool has_next = S.next(ui + 1, nxt);
        const char* nA = has_next ? (const char*)g.A + (size_t)nxt.pm * tstep : cA; const char* nB = has_next ? (const char*)g.Bt + (size_t)nxt.pn * tstep : cB;
        for (int t = 0; t < nt; t += 2) {
            const bool last = (t == nt - 2);
            const char* a1 = cA + (size_t)(t + 1) * kstep;
            const char* a2 = last ? nA : cA + (size_t)(t + 2) * kstep; const char* b2 = last ? nB : cB + (size_t)(t + 2) * kstep;
            const char* a3 = a2 + kstep; const char* b3 = b2 + kstep;
            if (last && has_next) S.a_ready(nxt);
            if constexpr (SP2) {
            PG8_LDB(B0, 0, 0); PG8_LDB(B1, 0, 1); PG8_SCHED; PG8_LDA(At, 0, 0); PG8_STAGE(PG8_SA(1, 1), a1 + hstep, voffA);
            PG8_WAIT_V(8); PG8_WAIT_L(0); PG8_BAR; PG8_MMA(0, 0, At, B0); PG8_MMA(0, 1, At, B1); PG8_BAR; PG8_SCHED;
            PG8_LDA(At, 0, 1); PG8_STAGE(PG8_SB(0, 0), b2, voffB); PG8_STAGE(PG8_SB(0, 1), b2 + hstep, voffB); PG8_STAGE(PG8_SA(0, 0), a2, voffA);
            PG8_WAIT_V(8); PG8_WAIT_L(0); PG8_BAR; PG8_MMA(1, 0, At, B0); PG8_MMA(1, 1, At, B1); PG8_BAR; PG8_SCHED;
            PG8_LDB(B0, 1, 0); PG8_LDB(B1, 1, 1); PG8_SCHED; PG8_LDA(At, 1, 0); PG8_STAGE(PG8_SA(0, 1), a2 + hstep, voffA);
            PG8_WAIT_V(8); PG8_WAIT_L(0); PG8_BAR; PG8_MMA(0, 0, At, B0); PG8_MMA(0, 1, At, B1); PG8_BAR; PG8_SCHED;
            PG8_LDA(At, 1, 1); PG8_STAGE(PG8_SB(1, 0), b3, voffB); PG8_STAGE(PG8_SB(1, 1), b3 + hstep, voffB); PG8_STAGE(PG8_SA(1, 0), a3, voffA);
            PG8_WAIT_V(8); PG8_WAIT_L(0); PG8_BAR; PG8_MMA(1, 0, At, B0); PG8_MMA(1, 1, At, B1); PG8_BAR; PG8_SCHED;
            } else {
            PG8_LDB(B0, 0, 0); PG8_SCHED; PG8_LDA(At, 0, 0); PG8_STAGE(PG8_SA(1, 1), a1 + hstep, voffA);
            PG8_WAIT_L(8); PG8_BAR; PG8_WAIT_L(0); PG8_MMA(0, 0, At, B0); PG8_BAR; PG8_SCHED;
            PG8_LDB(B1, 0, 1); PG8_STAGE(PG8_SB(0, 0), b2, voffB);
            PG8_BAR; PG8_WAIT_L(0); PG8_MMA(0, 1, At, B1); PG8_BAR;
            PG8_LDA(At, 0, 1); PG8_STAGE(PG8_SA(0, 0), a2, voffA);
            PG8_BAR; PG8_WAIT_L(0); PG8_MMA(1, 0, At, B0); PG8_BAR; PG8_SCHED;
            PG8_STAGE(PG8_SB(0, 1), b2 + hstep, voffB);
            PG8_WAIT_V(6); PG8_BAR; PG8_MMA(1, 1, At, B1); PG8_BAR;
            PG8_LDB(B0, 1, 0); PG8_SCHED; PG8_LDA(At, 1, 0); PG8_STAGE(PG8_SA(0, 1), a2 + hstep, voffA);
            PG8_WAIT_L(8); PG8_BAR; PG8_WAIT_L(0); PG8_MMA(0, 0, At, B0); PG8_BAR; PG8_SCHED;
            PG8_LDB(B1, 1, 1); PG8_STAGE(PG8_SB(1, 0), b3, voffB);
            PG8_BAR; PG8_WAIT_L(0); PG8_MMA(0, 1, At, B1); PG8_BAR;
            PG8_LDA(At, 1, 1); PG8_STAGE(PG8_SA(1, 0), a3, voffA);
            PG8_BAR; PG8_WAIT_L(0); PG8_MMA(1, 0, At, B0); PG8_BAR; PG8_SCHED;
            PG8_STAGE(PG8_SB(1, 1), b3 + hstep, voffB);
            PG8_WAIT_V(6); PG8_BAR; PG8_MMA(1, 1, At, B1); PG8_BAR;
            }
        }
        if constexpr (ALIGN_EPI) { if (wr == 0) PG8_BAR; }
        if constexpr (!Epi::AFTER_DRAIN) { E(acc, cur, wr, wc, fr, fq); S.done(cur); }
        if (!has_next) break;
#pragma unroll
        for (int a = 0; a < 2; ++a)
#pragma unroll
            for (int b = 0; b < 2; ++b)
#pragma unroll
                for (int m = 0; m < 4; ++m)
#pragma unroll
                    for (int n = 0; n < 2; ++n) acc[a][b][m][n] = (f32x4){0.f, 0.f, 0.f, 0.f};
        cur = nxt; cA = nA; cB = nB; ++ui;
        if constexpr (ALIGN_EPI) { if (wr == 1) PG8_BAR; }
    }
    PG8_WAIT_V(0);
    if constexpr (!ALIGN_EPI) { if (wr == 0) PG8_BAR; }
    PG8_BAR;
    if constexpr (Epi::AFTER_DRAIN) { E.fused(acc, cur, wr, wc, fr, fq, lds, wid, lane); S.done(cur); }
#undef PG8_SA
#undef PG8_SB
#undef PG8_STAGE
#undef PG8_LDA
#undef PG8_LDB
#undef PG8_MMA
#undef PG8_WAIT_V
#undef PG8_WAIT_L
#undef PG8_BAR
#undef PG8_SCHED
}
}

#define LAS __attribute__((address_space(3)))
using pg8::bf16_t; using pg8::bf16x8; using pg8::f32x4; using pg8::u32x4; using pg8::Unit;
typedef float f32x16 __attribute__((ext_vector_type(16)));
typedef float f32x2_t __attribute__((ext_vector_type(2)));
typedef __bf16 bf16x2_t __attribute__((ext_vector_type(2)));
typedef unsigned u32x2 __attribute__((ext_vector_type(2)));
#define MFMA32(a, b, c) __builtin_amdgcn_mfma_f32_32x32x16_bf16((a), (b), (c), 0, 0, 0)

constexpr int BATCH = 4, SEQ = 8192, DM = 1024, MTOK = BATCH * SEQ, FF = 4096, NQKV0 = 3072, NQKV1 = 2304, D1 = 768;
constexpr float ALPHA = 1.41421356237309505f, LN_EPS = 1e-5f, QSCALE = 0.125f * 1.4426950408889634f;
constexpr int NWAVES = 8, NTHR = 512;
constexpr int LIST_CAP = 126976;

constexpr size_t MiB = 1u << 20;
constexpr size_t WS_CTL = 0, CTL_BYTES = 2 * MiB;
constexpr size_t WS_KM = 128 * 1024, WS_BAR = 16 * 1024;
constexpr size_t WS_COS = 505 * MiB, WS_SIN = 506 * MiB;
constexpr size_t WS_C12 = 640 * 1024, WS_ST = 1 * MiB;
constexpr int NC12 = 4096 + 4096 + 2304, C_WIN0 = 0, C_WIN1 = 4096, C_QKV1 = 8192;
constexpr size_t WS_WQKV0 = 3 * MiB, WS_WO0 = 9 * MiB, WS_WQKV1 = 11 * MiB, WS_WO1 = 15 * MiB + 512 * 1024, WS_WIN0 = 17 * MiB, WS_WOUT0 = 25 * MiB, WS_WIN1 = 33 * MiB, WS_WOUT1 = 41 * MiB;
constexpr size_t WS_HB = 49 * MiB;
constexpr size_t WS_Q = 113 * MiB, WS_K = 177 * MiB, WS_VT = 241 * MiB, WS_PO = 305 * MiB, WS_PL = 497 * MiB;
constexpr size_t WS_H = 113 * MiB, WS_Z = 369 * MiB, WS_HB2 = 433 * MiB;
constexpr size_t WS_Q1 = 113 * MiB, WS_K1 = 161 * MiB, WS_VT1 = 209 * MiB, WS_PO1 = 257 * MiB, WS_PL1 = 305 * MiB;
constexpr size_t WS_DUMP = 401 * MiB, WS_END = 507 * MiB;
constexpr size_t OUT_PO3 = 0, OUT_LIST = 64 * MiB;

#ifndef DUPU
#define DUPU 1
#endif
#ifndef DUPQ0
#define DUPQ0 1
#endif
#ifndef DUPQ1
#define DUPQ1 1
#endif
#ifndef DUPG
#define DUPG 1
#endif
#ifndef G_ALIGN
#define G_ALIGN true
#endif
#ifndef G_SP2
#define G_SP2 true
#endif
#ifndef PHM
#define PHM 0xFFFFFFFFu
#endif
constexpr int RING_BYTES = 131072, LDS_BYTES = 147456, LDS_MISC = LDS_BYTES - 1024;

__device__ __forceinline__ unsigned pk2(float lo, float hi) { f32x2_t v = {lo, hi}; bf16x2_t b = __builtin_convertvector(v, bf16x2_t); return __builtin_bit_cast(unsigned, b); }
__device__ __forceinline__ float bf_lo(unsigned u) { return __uint_as_float(u << 16); }
__device__ __forceinline__ float bf_hi(unsigned u) { return __uint_as_float(u & 0xffff0000u); }
__device__ __forceinline__ int crow(int i, int hh) { return (i & 3) + 8 * (i >> 2) + 4 * hh; }
__device__ __forceinline__ float wave_sum(float v) {
#pragma unroll
    for (int o = 1; o < 64; o <<= 1) v += __shfl_xor(v, o);
    return v;
}
#define LDS_WAIT() asm volatile("s_waitcnt lgkmcnt(0)" ::: "memory")
__device__ __forceinline__ int qkv_phys(int c) { return (c & ~255) + ((c & 32) ? 128 : 0) + (((c >> 6) & 3) << 5) + (c & 31); }
__device__ __forceinline__ int swz16(int r) { return (r & ~12) | ((r & 4) << 1) | ((r & 8) >> 1); }

#define ROW_STATS(st_, row_, mu_, rs_) do { const f32x2_t sv_ = *(const f32x2_t*)((st_) + (size_t)(row_) * 2); (mu_) = sv_.x * (1.0f / DM); (rs_) = 1.0f / sqrtf(sv_.y * (1.0f / DM) - (mu_) * (mu_) + LN_EPS); } while (0)
template <int LAYER> struct EpiQKV {
    static constexpr bool PERM = true, AFTER_DRAIN = false;
    bf16_t* Q; bf16_t* Kb; bf16_t* VT; float* KM; const float* cs; const float* sn; const float* st; const float* c1; const float* c2;
    __device__ __forceinline__ void operator()(const f32x4 (&acc)[2][2][4][2], const Unit& u, int wr, int wc, int fr, int fq) const {
        constexpr int NT = LAYER == 0 ? 4 : 3, PITCH = NT * 256, NH = NT * 4;
        const int which = u.pn / NT, hg = u.pn - which * NT, head = hg * 4 + wc, e0 = 8 * fq;
        const int dsh = LAYER == 0 ? 0 : 2 * hg;
        const int rowb = u.pm * 256 + wr * 64 + fr;
        f32x4 c1v[2][2], c2v[2][2]; f32x2_t svc = {0.f, 0.f}, svn = {0.f, 0.f};
        if (LAYER == 1) {
#pragma unroll
            for (int bj = 0; bj < 2; ++bj)
#pragma unroll
                for (int n = 0; n < 2; ++n) { const int cc = u.pn * 256 + bj * 128 + wc * 32 + e0 + 4 * n; c1v[bj][n] = *(const f32x4*)(c1 + cc); c2v[bj][n] = *(const f32x4*)(c2 + cc); }
            svc = *(const f32x2_t*)(st + (size_t)rowb * 2);
        }
#define QKV_AFF(a_, bj_, n_) (LAYER == 1 ? ((a_) - mu * c1v[bj_][n_]) * rstd + c2v[bj_][n_] : (a_))
        if (which < 2) {
            bf16_t* dst = which == 0 ? Q : Kb; const float sc = which == 0 ? QSCALE : 1.f;
            f32x4 ks[2][2];
#pragma unroll
            for (int a = 0; a < 2; ++a)
#pragma unroll
                for (int b = 0; b < 2; ++b) ks[a][b] = (f32x4){0.f, 0.f, 0.f, 0.f};
            f32x4 tc[4], tn[4];
            { const int t = rowb & 8191; tc[0] = *(const f32x4*)(cs + t * 32 + e0); tc[1] = *(const f32x4*)(cs + t * 32 + e0 + 4); tc[2] = *(const f32x4*)(sn + t * 32 + e0); tc[3] = *(const f32x4*)(sn + t * 32 + e0 + 4); }
#pragma unroll
            for (int q = 0; q < 8; ++q) {
                const int ai = q >> 2, m = q & 3;
                const int row = rowb + ai * 128 + m * 16, b = row >> 13, t = row & 8191;
                if (q + 1 < 8) { const int t2 = (rowb + ((q + 1) >> 2) * 128 + ((q + 1) & 3) * 16) & 8191;
                    tn[0] = *(const f32x4*)(cs + t2 * 32 + e0); tn[1] = *(const f32x4*)(cs + t2 * 32 + e0 + 4); tn[2] = *(const f32x4*)(sn + t2 * 32 + e0); tn[3] = *(const f32x4*)(sn + t2 * 32 + e0 + 4);
                    if (LAYER == 1) svn = *(const f32x2_t*)(st + (size_t)(rowb + ((q + 1) >> 2) * 128 + ((q + 1) & 3) * 16) * 2); }
                const int rr = ((t & ((1 << dsh) - 1)) << (13 - dsh)) | (t >> dsh);
                const f32x4 c0 = tc[0], c1_ = tc[1], s0 = tc[2], s1 = tc[3];
                const float mu = LAYER == 1 ? svc.x * (1.0f / DM) : 0.f, rstd = LAYER == 1 ? 1.0f / sqrtf(svc.y * (1.0f / DM) - mu * mu + LN_EPS) : 1.f;
                const f32x4 x1a = QKV_AFF(acc[ai][0][m][0], 0, 0), x1b = QKV_AFF(acc[ai][0][m][1], 0, 1), x2a = QKV_AFF(acc[ai][1][m][0], 1, 0), x2b = QKV_AFF(acc[ai][1][m][1], 1, 1);
                const f32x4 o1a = (x1a * c0 - x2a * s0) * sc, o1b = (x1b * c1_ - x2b * s1) * sc, o2a = (x2a * c0 + x1a * s0) * sc, o2b = (x2b * c1_ + x1b * s1) * sc;
                bf16_t* p = dst + (size_t)(b * 8192 + rr) * PITCH + head * 64 + e0;
                u32x4 w; w.x = pk2(o1a[0], o1a[1]); w.y = pk2(o1a[2], o1a[3]); w.z = pk2(o1b[0], o1b[1]); w.w = pk2(o1b[2], o1b[3]);
                *(u32x4*)p = w;
                w.x = pk2(o2a[0], o2a[1]); w.y = pk2(o2a[2], o2a[3]); w.z = pk2(o2b[0], o2b[1]); w.w = pk2(o2b[2], o2b[3]);
                *(u32x4*)(p + 32) = w;
                if (LAYER == 0 && which == 1) { ks[0][0] += o1a; ks[0][1] += o1b; ks[1][0] += o2a; ks[1][1] += o2b; }
                asm volatile("" ::: "memory");
#pragma unroll
                for (int k = 0; k < 4; ++k) tc[k] = tn[k];
                svc = svn;
            }
            if (LAYER == 0 && which == 1) {
                const int b = u.pm >> 5, blk = u.pm & 31;
                float* kmp = KM + ((size_t)((b * 16 + head) * 32 + blk)) * 64; float kmv = 0.f;
#pragma unroll
                for (int a = 0; a < 2; ++a)
#pragma unroll
                    for (int n = 0; n < 2; ++n)
#pragma unroll
                        for (int i = 0; i < 4; ++i) {
                            float v = ks[a][n][i];
                            v += __shfl_xor(v, 1); v += __shfl_xor(v, 2); v += __shfl_xor(v, 4); v += __shfl_xor(v, 8);
                            if (fr == a * 8 + n * 4 + i) kmv = v;
                        }
                __hip_atomic_fetch_add(kmp + (fr >> 3) * 32 + e0 + (fr & 7), kmv * (1.0f / 256.0f), __ATOMIC_RELAXED, __HIP_MEMORY_SCOPE_AGENT);
            }
        } else {
#pragma unroll
            for (int q = 0; q < 8; ++q) {
                const int ai = q >> 2, m = q & 3;
                const int row = rowb + ai * 128 + m * 16, b = row >> 13, t = row & 8191;
                const int rr = ((t & ((1 << dsh) - 1)) << (13 - dsh)) | (t >> dsh);
                bf16_t* p = VT + ((size_t)(b * NH + head) * 64 + e0) * 8192 + swz16(rr);
                if (LAYER == 1 && q + 1 < 8) svn = *(const f32x2_t*)(st + (size_t)(rowb + ((q + 1) >> 2) * 128 + ((q + 1) & 3) * 16) * 2);
                const float mu = LAYER == 1 ? svc.x * (1.0f / DM) : 0.f, rstd = LAYER == 1 ? 1.0f / sqrtf(svc.y * (1.0f / DM) - mu * mu + LN_EPS) : 1.f;
#pragma unroll
                for (int bj = 0; bj < 2; ++bj)
#pragma unroll
                    for (int n = 0; n < 2; ++n) { const f32x4 yv = QKV_AFF(acc[ai][bj][m][n], bj, n);
#pragma unroll
                        for (int i = 0; i < 4; ++i) p[(size_t)(bj * 32 + 4 * n + i) * 8192] = (bf16_t)(pk2(yv[i], 0.f) & 0xffffu); }
                svc = svn;
            }
        }
#undef QKV_AFF
    }
};
struct EpiSqRelu {
    static constexpr bool PERM = true, AFTER_DRAIN = false;
    bf16_t* O; int ldc; const float* st; const float* c1; const float* c2;
    __device__ __forceinline__ void operator()(const f32x4 (&acc)[2][2][4][2], const Unit& u, int wr, int wc, int fr, int fq) const {
        const int row0 = u.pm * 256 + wr * 64 + fr, col0 = u.pn * 256 + wc * 32 + 8 * fq;
        f32x4 c1v[2][2], c2v[2][2]; float mus[8], rss[8];
#pragma unroll
        for (int bj = 0; bj < 2; ++bj)
#pragma unroll
            for (int n = 0; n < 2; ++n) { c1v[bj][n] = *(const f32x4*)(c1 + col0 + bj * 128 + 4 * n); c2v[bj][n] = *(const f32x4*)(c2 + col0 + bj * 128 + 4 * n); }
#pragma unroll
        for (int q = 0; q < 8; ++q) ROW_STATS(st, row0 + (q >> 2) * 128 + (q & 3) * 16, mus[q], rss[q]);
#pragma unroll
        for (int ai = 0; ai < 2; ++ai)
#pragma unroll
            for (int m = 0; m < 4; ++m) { const int row = row0 + ai * 128 + m * 16; bf16_t* rowp = O + (size_t)row * ldc + col0;
                const float mu = mus[ai * 4 + m], rstd = rss[ai * 4 + m];
#pragma unroll
                for (int bj = 0; bj < 2; ++bj) { f32x4 v0 = (acc[ai][bj][m][0] - mu * c1v[bj][0]) * rstd + c2v[bj][0], v1 = (acc[ai][bj][m][1] - mu * c1v[bj][1]) * rstd + c2v[bj][1];
#pragma unroll
                    for (int i = 0; i < 4; ++i) { const float a = fmaxf(v0[i], 0.f), b = fmaxf(v1[i], 0.f); v0[i] = a * a; v1[i] = b * b; }
                    u32x4 w; w.x = pk2(v0[0], v0[1]); w.y = pk2(v0[2], v0[3]); w.z = pk2(v1[0], v1[1]); w.w = pk2(v1[2], v1[3]);
                    __builtin_nontemporal_store(w, (u32x4*)(rowp + bj * 128)); } }
    }
};
template <int MODE> struct EpiResid {
    static constexpr bool PERM = true, AFTER_DRAIN = false;
    const bf16_t* R; bf16_t* Z; const float* stp; float* stc; const float* g; const float* b;
    __device__ __forceinline__ void operator()(const f32x4 (&acc)[2][2][4][2], const Unit& u, int wr, int wc, int fr, int fq) const {
        const int row0 = u.pm * 256 + wr * 64 + fr, col0 = u.pn * 256 + wc * 32 + 8 * fq;
        const bf16_t* src = MODE == 1 ? (const bf16_t*)Z : R;
        f32x4 gv[2][2], bv[2][2]; f32x2_t svc = {0.f, 0.f}, svn = {0.f, 0.f};
        u32x4 rc[2], rn[2]; float sq[8];
        rc[0] = *(const u32x4*)(src + (size_t)row0 * DM + col0); rc[1] = *(const u32x4*)(src + (size_t)row0 * DM + col0 + 128);
        if (MODE == 1) {
#pragma unroll
            for (int bj = 0; bj < 2; ++bj)
#pragma unroll
                for (int n = 0; n < 2; ++n) { gv[bj][n] = *(const f32x4*)(g + col0 + bj * 128 + 4 * n); bv[bj][n] = *(const f32x4*)(b + col0 + bj * 128 + 4 * n); }
            svc = *(const f32x2_t*)(stp + (size_t)row0 * 2);
        }
#pragma unroll
        for (int q = 0; q < 8; ++q) {
            const int ai = q >> 2, m = q & 3, row = row0 + ai * 128 + m * 16; const size_t off = (size_t)row * DM + col0;
            if (q + 1 < 8) { const int row2 = row0 + ((q + 1) >> 2) * 128 + ((q + 1) & 3) * 16; const size_t off2 = (size_t)row2 * DM + col0; rn[0] = *(const u32x4*)(src + off2); rn[1] = *(const u32x4*)(src + off2 + 128);
                if (MODE == 1) svn = *(const f32x2_t*)(stp + (size_t)row2 * 2); }
            const float mu = MODE == 1 ? svc.x * (1.0f / DM) : 0.f, rstd = MODE == 1 ? 1.0f / sqrtf(svc.y * (1.0f / DM) - mu * mu + LN_EPS) : 1.f;
            float s1 = 0.f, s2 = 0.f;
#pragma unroll
            for (int bj = 0; bj < 2; ++bj) { const u32x4 rv = rc[bj];
                f32x4 h0 = (f32x4){bf_lo(rv.x), bf_hi(rv.x), bf_lo(rv.y), bf_hi(rv.y)}, h1 = (f32x4){bf_lo(rv.z), bf_hi(rv.z), bf_lo(rv.w), bf_hi(rv.w)};
                if (MODE == 1) { h0 = (h0 - mu) * rstd * gv[bj][0] + bv[bj][0]; h1 = (h1 - mu) * rstd * gv[bj][1] + bv[bj][1]; }
                const f32x4 z0 = ALPHA * h0 + acc[ai][bj][m][0], z1 = ALPHA * h1 + acc[ai][bj][m][1];
                u32x4 w; w.x = pk2(z0[0], z0[1]); w.y = pk2(z0[2], z0[3]); w.z = pk2(z1[0], z1[1]); w.w = pk2(z1[2], z1[3]);
                *(u32x4*)(Z + off + bj * 128) = w;
                const float r0 = bf_lo(w.x), r1 = bf_hi(w.x), r2 = bf_lo(w.y), r3 = bf_hi(w.y), r4 = bf_lo(w.z), r5 = bf_hi(w.z), r6 = bf_lo(w.w), r7 = bf_hi(w.w);
                s1 += ((r0 + r1) + (r2 + r3)) + ((r4 + r5) + (r6 + r7));
                s2 += ((r0 * r0 + r1 * r1) + (r2 * r2 + r3 * r3)) + ((r4 * r4 + r5 * r5) + (r6 * r6 + r7 * r7)); }
            s1 += __shfl_xor(s1, 16); s1 += __shfl_xor(s1, 32); s2 += __shfl_xor(s2, 16); s2 += __shfl_xor(s2, 32);
            sq[q] = (fq & 1) ? s2 : s1;
            asm volatile("" ::: "memory");
            rc[0] = rn[0]; rc[1] = rn[1]; svc = svn;
        }
#pragma unroll
        for (int p = 0; p < 4; ++p) {
            const int qa = 2 * p, qb = 2 * p + 1;
            const float val = (fq < 2) ? sq[qa] : sq[qb];
            const int rowp = row0 + ((fq < 2) ? ((qa >> 2) * 128 + (qa & 3) * 16) : ((qb >> 2) * 128 + (qb & 3) * 16));
            __hip_atomic_fetch_add(stc + (size_t)rowp * 2 + (fq & 1), val, __ATOMIC_RELAXED, __HIP_MEMORY_SCOPE_AGENT);
        }
    }
};

template <bool PERMQ, bool SCALED> __device__ __forceinline__ void transpose_item(const float* W, int K, int N, bf16_t* WT, LAS float* scr, int item, int lane, const float* gk, const float* bk, float* c1, float* c2) {
    const int nblk = N / 32, kb = item / nblk, nb = item % nblk, k0 = 64 * kb, n0 = 32 * nb;
    float p1 = 0.f, p2 = 0.f;
#pragma unroll 8
    for (int i = 0; i < 32; ++i) { const int kk = 2 * i + (lane >> 5); float v = W[(size_t)(k0 + kk) * N + n0 + (lane & 31)];
        if (SCALED) { p2 += v * bk[k0 + kk]; v *= gk[k0 + kk]; p1 += bf_lo(pk2(v, 0.f)); }
        scr[kk * 33 + (lane & 31)] = v; }
    LDS_WAIT();
    if (SCALED) { p1 += __shfl_xor(p1, 32); p2 += __shfl_xor(p2, 32);
        if (lane < 32) { const int oc = PERMQ ? qkv_phys(n0 + lane) : (n0 + lane); __hip_atomic_fetch_add(c1 + oc, p1, __ATOMIC_RELAXED, __HIP_MEMORY_SCOPE_AGENT); __hip_atomic_fetch_add(c2 + oc, p2, __ATOMIC_RELAXED, __HIP_MEMORY_SCOPE_AGENT); } }
    const int c = lane & 7;
#pragma unroll
    for (int j = 0; j < 4; ++j) { const int n = (lane >> 3) + 8 * j; const LAS float* sp = scr + (8 * c) * 33 + n;
        u32x4 o; o.x = pk2(sp[0 * 33], sp[1 * 33]); o.y = pk2(sp[2 * 33], sp[3 * 33]); o.z = pk2(sp[4 * 33], sp[5 * 33]); o.w = pk2(sp[6 * 33], sp[7 * 33]);
        const int orow = PERMQ ? qkv_phys(n0 + n) : (n0 + n);
        *(u32x4*)(WT + (size_t)orow * K + k0 + 8 * c) = o; }
    LDS_WAIT();
}

template <bool F32OUT> __device__ __forceinline__ void ln_phase(const bf16_t* Z, const float* g, const float* bt, bf16_t* ob, float* of, int gw, int ngw, int lane) {
    f32x4 gv[4], bv[4];
#pragma unroll
    for (int q = 0; q < 2; ++q) { gv[2 * q] = *(const f32x4*)(g + 512 * q + 8 * lane); gv[2 * q + 1] = *(const f32x4*)(g + 512 * q + 8 * lane + 4);
                                  bv[2 * q] = *(const f32x4*)(bt + 512 * q + 8 * lane); bv[2 * q + 1] = *(const f32x4*)(bt + 512 * q + 8 * lane + 4); }
    for (int row = gw; row < MTOK; row += ngw) {
        const bf16_t* zr = Z + (size_t)row * DM + 8 * lane;
        const u32x4 a = *(const u32x4*)zr, b = *(const u32x4*)(zr + 512);
        float v[16] = {bf_lo(a.x), bf_hi(a.x), bf_lo(a.y), bf_hi(a.y), bf_lo(a.z), bf_hi(a.z), bf_lo(a.w), bf_hi(a.w),
                       bf_lo(b.x), bf_hi(b.x), bf_lo(b.y), bf_hi(b.y), bf_lo(b.z), bf_hi(b.z), bf_lo(b.w), bf_hi(b.w)};
        float s = 0.f;
#pragma unroll
        for (int i = 0; i < 16; ++i) s += v[i];
        const float mean = wave_sum(s) * (1.0f / DM);
        float q = 0.f;
#pragma unroll
        for (int i = 0; i < 16; ++i) { v[i] -= mean; q += v[i] * v[i]; }
        const float rstd = 1.0f / sqrtf(wave_sum(q) * (1.0f / DM) + LN_EPS);
#pragma unroll
        for (int i = 0; i < 16; ++i) v[i] = v[i] * rstd * gv[i >> 2][i & 3] + bv[i >> 2][i & 3];
        if (F32OUT) {
            float* orow = of + (size_t)row * DM + 8 * lane;
            __builtin_nontemporal_store((f32x4){v[0], v[1], v[2], v[3]}, (f32x4*)orow); __builtin_nontemporal_store((f32x4){v[4], v[5], v[6], v[7]}, (f32x4*)(orow + 4));
            __builtin_nontemporal_store((f32x4){v[8], v[9], v[10], v[11]}, (f32x4*)(orow + 512)); __builtin_nontemporal_store((f32x4){v[12], v[13], v[14], v[15]}, (f32x4*)(orow + 516));
        } else {
            bf16_t* orow = ob + (size_t)row * DM + 8 * lane;
            u32x4 w; w.x = pk2(v[0], v[1]); w.y = pk2(v[2], v[3]); w.z = pk2(v[4], v[5]); w.w = pk2(v[6], v[7]); *(u32x4*)orow = w;
            w.x = pk2(v[8], v[9]); w.y = pk2(v[10], v[11]); w.z = pk2(v[12], v[13]); w.w = pk2(v[14], v[15]); *(u32x4*)(orow + 512) = w;
        }
    }
}

constexpr int KPB = 144;
template <int NKT, int MODE, int GT>
__device__ __forceinline__ void attn_rows(const LAS unsigned char* Kl, const LAS unsigned char* Vl, const int vpb, const bf16x8 (&qf)[4], const int r, const int hh, const int p0, const int p1,
                                          f32x16 (&o)[2], float& lse2) {
    constexpr int NG = (NKT + GT - 1) / GT;
    float mrun = -INFINITY, lrun = 0.f;
#pragma unroll
    for (int i = 0; i < 16; ++i) { o[0][i] = 0.f; o[1][i] = 0.f; }
#pragma unroll
    for (int grp = 0; grp < NG; ++grp) {
        constexpr int dummy = 0; (void)dummy;
        const int kt0 = grp * GT;
        const int nt = (NKT - kt0) < GT ? (NKT - kt0) : GT;
        const bool gact = MODE == 0 ? true : (MODE == 1 ? (kt0 <= p0) : (p1 != 0 || (p0 + kt0 + nt - 1 >= 4)));
        if (gact) {
            bf16x8 kf[GT][4];
#pragma unroll
            for (int q = 0; q < GT; ++q)
#pragma unroll
                for (int ks = 0; ks < 4; ++ks) if (q < nt) kf[q][ks] = *(const LAS bf16x8*)(Kl + ((kt0 + q) * 32 + r) * KPB + ks * 32 + hh * 16);
            f32x16 s[GT];
#pragma unroll
            for (int q = 0; q < GT; ++q)
#pragma unroll
                for (int i = 0; i < 16; ++i) s[q][i] = 0.f;
#pragma unroll
            for (int ks = 0; ks < 4; ++ks)
#pragma unroll
                for (int q = 0; q < GT; ++q) if (q < nt) s[q] = MFMA32(kf[q][ks], qf[ks], s[q]);
            bf16x8 vf[GT][2][2];
#pragma unroll
            for (int q = 0; q < GT; ++q)
#pragma unroll
                for (int s2 = 0; s2 < 2; ++s2)
#pragma unroll
                    for (int dt = 0; dt < 2; ++dt) if (q < nt) vf[q][s2][dt] = *(const LAS bf16x8*)(Vl + (dt * 32 + r) * vpb + ((kt0 + q) * 32 + s2 * 16 + hh * 8) * 2);
            if (MODE == 1) { if (p0 < 8) {
#pragma unroll
                for (int q = 0; q < GT; ++q) if (q < nt) { const int lim = (p0 - (kt0 + q)) * 32 + r;
#pragma unroll
                    for (int i = 0; i < 16; ++i) if (crow(i, hh) > lim) s[q][i] = -INFINITY; } } }
            if (MODE == 2) {
#pragma unroll
                for (int q = 0; q < GT; ++q) if (q < nt) { const int kt = kt0 + q;
                    if (kt == 0) {
#pragma unroll
                        for (int i = 0; i < 16; ++i) if (crow(i, hh) < r) s[q][i] = -INFINITY; }
                    if (kt == NKT - 1) {
#pragma unroll
                        for (int i = 0; i < 16; ++i) if (crow(i, hh) > r) s[q][i] = -INFINITY; } }
                if (p1 == 0) {
#pragma unroll
                    for (int q = 0; q < GT; ++q) if (q < nt) { if (p0 + kt0 + q < 4) {
#pragma unroll
                        for (int i = 0; i < 16; ++i) s[q][i] = -INFINITY; } } }
            }
            float mx = -INFINITY;
#pragma unroll
            for (int q = 0; q < GT; ++q) if (q < nt) {
#pragma unroll
                for (int i = 0; i < 16; ++i) mx = fmaxf(mx, s[q][i]); }
            mx = fmaxf(mx, __shfl_xor(mx, 32));
            const float mnew = fmaxf(mrun, mx);
            const float sc = __builtin_amdgcn_exp2f(mrun - mnew);
            mrun = mnew; lrun *= sc;
            if (grp > 0) {
#pragma unroll
                for (int i = 0; i < 16; ++i) { o[0][i] *= sc; o[1][i] *= sc; }
            }
#pragma unroll
            for (int q = 0; q < GT; ++q) if (q < nt) {
#pragma unroll
                for (int i = 0; i < 16; ++i) { const float p = __builtin_amdgcn_exp2f(s[q][i] - mnew); s[q][i] = p; lrun += p; }
#pragma unroll
                for (int s2 = 0; s2 < 2; ++s2) {
                    u32x4 pw; pw.x = pk2(s[q][8 * s2], s[q][8 * s2 + 1]); pw.y = pk2(s[q][8 * s2 + 2], s[q][8 * s2 + 3]); pw.z = pk2(s[q][8 * s2 + 4], s[q][8 * s2 + 5]); pw.w = pk2(s[q][8 * s2 + 6], s[q][8 * s2 + 7]);
                    const bf16x8 pf = __builtin_bit_cast(bf16x8, pw);
#pragma unroll
                    for (int dt = 0; dt < 2; ++dt) o[dt] = MFMA32(vf[q][s2][dt], pf, o[dt]);
                }
            }
        }
    }
    const float l = lrun + __shfl_xor(lrun, 32);
    const float inv = 1.0f / l;
#pragma unroll
    for (int i = 0; i < 16; ++i) { o[0][i] *= inv; o[1][i] *= inv; }
    lse2 = mrun + __builtin_amdgcn_logf(l);
}
__device__ __forceinline__ void store_o(bf16_t* dst, const f32x16 (&o)[2], int hh) {
#pragma unroll
    for (int dt = 0; dt < 2; ++dt)
#pragma unroll
        for (int g4 = 0; g4 < 4; ++g4) { u32x2 w; w.x = pk2(o[dt][4 * g4], o[dt][4 * g4 + 1]); w.y = pk2(o[dt][4 * g4 + 2], o[dt][4 * g4 + 3]); *(u32x2*)(dst + dt * 32 + 8 * g4 + 4 * hh) = w; }
}

constexpr int STG_PITCH = 144, STG_WAVE = 32 * STG_PITCH;
__device__ __forceinline__ void stage_o(LAS unsigned char* stg, const f32x16 (&o)[2], int r, int hh) {
#pragma unroll
    for (int dt = 0; dt < 2; ++dt)
#pragma unroll
        for (int g4 = 0; g4 < 4; ++g4) { u32x2 w; w.x = pk2(o[dt][4 * g4], o[dt][4 * g4 + 1]); w.y = pk2(o[dt][4 * g4 + 2], o[dt][4 * g4 + 3]); *(LAS u32x2*)(stg + r * STG_PITCH + dt * 64 + g4 * 16 + hh * 8) = w; }
    LDS_WAIT();
}
constexpr int STG8_PITCH = 80; constexpr float PO8_SCALE = 16.0f;
__device__ __forceinline__ void stage_o8(LAS unsigned char* stg, const f32x16 (&o)[2], int r, int hh) {
#pragma unroll
    for (int dt = 0; dt < 2; ++dt)
#pragma unroll
        for (int g4 = 0; g4 < 4; ++g4) {
            int w = __builtin_amdgcn_cvt_pk_fp8_f32(o[dt][4 * g4] * PO8_SCALE, o[dt][4 * g4 + 1] * PO8_SCALE, 0, false);
            w = __builtin_amdgcn_cvt_pk_fp8_f32(o[dt][4 * g4 + 2] * PO8_SCALE, o[dt][4 * g4 + 3] * PO8_SCALE, w, true);
            *(LAS int*)(stg + r * STG8_PITCH + dt * 32 + g4 * 8 + hh * 4) = w; }
    LDS_WAIT();
}
#define XB_TMO      128
#define XB_XCNT(j)  (256  + 64 * (j))
#define XB_XSUB(j)  (1280 + 64 * (j))
#define XB_XGEN(j)  (2304 + 64 * (j))
#define XB_TOP      3328
#define XB_TOPGEN   3392
#define XCD_BAR_WORDS 3456
#define XB_SPIN_CAP (1u << 18)

__device__ __forceinline__ unsigned xb_ld(unsigned* p)              { return __hip_atomic_load(p, __ATOMIC_RELAXED, __HIP_MEMORY_SCOPE_AGENT); }
__device__ __forceinline__ unsigned xb_add(unsigned* p, unsigned v) { return __hip_atomic_fetch_add(p, v, __ATOMIC_RELAXED, __HIP_MEMORY_SCOPE_AGENT); }
__device__ __forceinline__ unsigned xb_xcc_id() { return (unsigned)__builtin_amdgcn_s_getreg((3 << 11) | 20) & 0xFu; }
#define XB_SPIN(cond, bar) do { unsigned _sp = 0; while (cond) { __builtin_amdgcn_s_sleep(1); \
    if ((++_sp & 255u) == 0u) { if (xb_ld(&(bar)[XB_TMO])) break; if (_sp > XB_SPIN_CAP) { atomicAdd(&(bar)[XB_TMO], 1u); break; } } } } while (0)

struct XcdBarrier {
    unsigned* bar; unsigned x;
    volatile LAS unsigned* st;
};

__device__ __forceinline__ XcdBarrier xcd_barrier_post(unsigned* bar, volatile LAS unsigned* st) {
    XcdBarrier b; b.bar = bar; b.x = xb_xcc_id(); b.st = st;
    if (threadIdx.x == 0) (void)xb_add(&bar[XB_XCNT(b.x)], 1u);
    return b;
}
__device__ __forceinline__ void xcd_barrier_complete(unsigned* bar, unsigned x, unsigned& nloc, unsigned& nx) {
    const unsigned G = gridDim.x * gridDim.y * gridDim.z;
    unsigned sum, cnt, mine, sp = 0u;
    for (;;) {
        sum = 0u; cnt = 0u; mine = 0u;
#pragma unroll
        for (unsigned j = 0; j < 16; ++j) { const unsigned c = xb_ld(&bar[XB_XCNT(j)]); sum += c; cnt += (c > 0u) ? 1u : 0u; mine = (j == x) ? c : mine; }
        if (sum == G) break;
        __builtin_amdgcn_s_sleep(1);
        if ((++sp & 255u) == 0u) { if (xb_ld(&bar[XB_TMO])) break; if (sp > XB_SPIN_CAP) { atomicAdd(&bar[XB_TMO], 1u); break; } }
    }
    nloc = mine > 0u ? mine : 1u; nx = cnt > 0u ? cnt : 1u;
}

__device__ __forceinline__ void xcd_barrier(const XcdBarrier& b) {
    asm volatile("s_waitcnt vmcnt(0)" ::: "memory");
    __syncthreads();
    if (threadIdx.x == 0) {
        unsigned* bar = b.bar;
        __builtin_amdgcn_s_waitcnt(0);
        unsigned nloc = b.st[0], nx = b.st[1];
        if (nloc == 0u) { xcd_barrier_complete(bar, b.x, nloc, nx); b.st[0] = nloc; b.st[1] = nx; }
        const unsigned old = xb_add(&bar[XB_XSUB(b.x)], 1u);
        const unsigned gen = old / nloc;
        if (old + 1u == (gen + 1u) * nloc) {
            __builtin_amdgcn_fence(__ATOMIC_RELEASE, "agent");
            asm volatile("s_waitcnt vmcnt(0)" ::: "memory");
            const unsigned og = xb_add(&bar[XB_TOP], 1u);
            const unsigned tg = og / nx;
            if (og + 1u == (tg + 1u) * nx) xb_add(&bar[XB_TOPGEN], 1u);
            else XB_SPIN(xb_ld(&bar[XB_TOPGEN]) == tg, bar);
            __builtin_amdgcn_fence(__ATOMIC_ACQUIRE, "agent");
            xb_add(&bar[XB_XGEN(b.x)], 1u);
            asm volatile("s_waitcnt vmcnt(0)" ::: "memory");
        } else {
            XB_SPIN(xb_ld(&bar[XB_XGEN(b.x)]) == gen, bar);
            __builtin_amdgcn_fence(__ATOMIC_ACQUIRE, "agent");
            asm volatile("s_waitcnt vmcnt(0)" ::: "memory");
        }
    }
    __syncthreads();
}

struct Args { const float* in[11]; float* out; unsigned char* ws; int pad0, pad1; };

__global__ void __launch_bounds__(NTHR) hybrid_fwd(Args args) {
    extern __shared__ __attribute__((aligned(16))) unsigned char lds_raw[];
    LAS unsigned char* lds = (LAS unsigned char*)lds_raw;
    cg::grid_group grid = cg::this_grid();
    int tid = threadIdx.x, lane = tid & 63, wave = __builtin_amdgcn_readfirstlane(tid >> 6);
    const int G = gridDim.x, ngw = G * NWAVES; int gw = blockIdx.x * NWAVES + wave;
#define GRID_SYNC_CG() do { grid.sync(); asm volatile("" : "+v"(tid), "+v"(lane)); } while (0)
#define GRID_SYNC() do { xcd_barrier(xbar); asm volatile("" : "+v"(tid), "+v"(lane)); } while (0)
    if (tid < 2) ((LAS unsigned*)(lds + LDS_MISC + 256))[tid] = 0u;
    __syncthreads();
    const XcdBarrier xbar = xcd_barrier_post((unsigned*)(args.ws + WS_BAR), (volatile LAS unsigned*)(lds + LDS_MISC + 256));
    unsigned char* ws = args.ws;
    const float* x = args.in[0];
    bf16_t* Wqkv0 = (bf16_t*)(ws + WS_WQKV0); bf16_t* Wo0 = (bf16_t*)(ws + WS_WO0); bf16_t* Wqkv1 = (bf16_t*)(ws + WS_WQKV1); bf16_t* Wo1 = (bf16_t*)(ws + WS_WO1);
    float* cosT = (float*)(ws + WS_COS); float* sinT = (float*)(ws + WS_SIN);
    bf16_t* HB = (bf16_t*)(ws + WS_HB); bf16_t* Zb = (bf16_t*)(ws + WS_Z); bf16_t* Hm = (bf16_t*)(ws + WS_H);
    float* C1 = (float*)(ws + WS_C12); float* C2 = C1 + NC12; float* ST = (float*)(ws + WS_ST);
    unsigned* gcnt = (unsigned*)(ws + WS_CTL); float* KM = (float*)(ws + WS_KM);
    unsigned* LIST = (unsigned*)((unsigned char*)args.out + OUT_LIST); bf16_t* PO3 = (bf16_t*)((unsigned char*)args.out + OUT_PO3);

    if (PHM & 1u) {
        LAS float* scr = (LAS float*)(lds + wave * 16384);
        constexpr int I_QKV0 = (DM / 64) * (NQKV0 / 32), I_WO0 = (DM / 64) * (DM / 32), I_QKV1 = (DM / 64) * (NQKV1 / 32), I_WO1 = (D1 / 64) * (DM / 32), I_IN = (DM / 64) * (FF / 32), I_OUT = (FF / 64) * (DM / 32);
        constexpr int NITEMS = I_QKV0 + I_WO0 + I_QKV1 + I_WO1 + 2 * I_IN + 2 * I_OUT;
        for (int it = gw; it < NITEMS; it += ngw) {
            int rI = it;
            if (rI < I_QKV0) { transpose_item<true, false>(args.in[1], DM, NQKV0, Wqkv0, scr, rI, lane, nullptr, nullptr, nullptr, nullptr); continue; } rI -= I_QKV0;
            if (rI < I_WO0) { transpose_item<false, false>(args.in[2], DM, DM, Wo0, scr, rI, lane, nullptr, nullptr, nullptr, nullptr); continue; } rI -= I_WO0;
            if (rI < I_QKV1) { transpose_item<true, true>(args.in[3], DM, NQKV1, Wqkv1, scr, rI, lane, args.in[9], args.in[10], C1 + C_QKV1, C2 + C_QKV1); continue; } rI -= I_QKV1;
            if (rI < I_WO1) { transpose_item<false, false>(args.in[4], D1, DM, Wo1, scr, rI, lane, nullptr, nullptr, nullptr, nullptr); continue; } rI -= I_WO1;
            if (rI < 2 * I_IN) { const int l = rI / I_IN; transpose_item<false, true>(args.in[5] + (size_t)l * DM * FF, DM, FF, (bf16_t*)(ws + (l ? WS_WIN1 : WS_WIN0)), scr, rI - l * I_IN, lane, args.in[7] + l * DM, args.in[8] + l * DM, C1 + (l ? C_WIN1 : C_WIN0), C2 + (l ? C_WIN1 : C_WIN0)); continue; } rI -= 2 * I_IN;
            { const int l = rI / I_OUT; transpose_item<false, false>(args.in[6] + (size_t)l * DM * FF, FF, DM, (bf16_t*)(ws + (l ? WS_WOUT1 : WS_WOUT0)), scr, rI - l * I_OUT, lane, nullptr, nullptr, nullptr, nullptr); }
        }
        for (int idx = blockIdx.x * NTHR + tid; idx < SEQ * 32; idx += G * NTHR) {
            const int t = idx >> 5, e = idx & 31;
            const float inv = 1.0f / powf(10000.0f, (float)(2 * e) / 64.0f);
            const float ang = (float)t * inv;
            const double a = (double)ang, kk = rint(a * 0.15915494309189535), rd = fma(-kk, 6.283185307179586, a);
            const float rf = (float)rd;
            cosT[idx] = cosf(rf); sinT[idx] = sinf(rf);
        }
        for (int row = gw; row < MTOK; row += ngw) {
            const float* xr = x + (size_t)row * DM + 8 * lane;
            const f32x4 a0 = __builtin_nontemporal_load((const f32x4*)xr), a1 = __builtin_nontemporal_load((const f32x4*)(xr + 4)), b0 = __builtin_nontemporal_load((const f32x4*)(xr + 512)), b1 = __builtin_nontemporal_load((const f32x4*)(xr + 516));
            bf16_t* orow = HB + (size_t)row * DM + 8 * lane;
            u32x4 w; w.x = pk2(a0[0], a0[1]); w.y = pk2(a0[2], a0[3]); w.z = pk2(a1[0], a1[1]); w.w = pk2(a1[2], a1[3]); *(u32x4*)orow = w;
            w.x = pk2(b0[0], b0[1]); w.y = pk2(b0[2], b0[3]); w.z = pk2(b1[0], b1[1]); w.w = pk2(b1[2], b1[3]); *(u32x4*)(orow + 512) = w;
        }
    }
    __syncthreads();
    if (args.pad1 != 0) GRID_SYNC_CG();
    GRID_SYNC();

    bf16_t* Q0 = (bf16_t*)(ws + WS_Q); bf16_t* K0 = (bf16_t*)(ws + WS_K); bf16_t* VT0 = (bf16_t*)(ws + WS_VT); bf16_t* PO = (bf16_t*)(ws + WS_PO); float* PL = (float*)(ws + WS_PL);
    if (PHM & 2u) {
        pg8::Gemm g{HB, Wqkv0, MTOK, NQKV0, DM}; pg8::StaticOrder S; S.init(MTOK, NQKV0, G, (int)blockIdx.x);
        EpiQKV<0> E{Q0, K0, VT0, KM, cosT, sinT, nullptr, nullptr, nullptr};
        for (int repg = 0; repg < DUPG * DUPQ0; ++repg) pg8::gemm_phase<EpiQKV<0>, pg8::StaticOrder, G_ALIGN, G_SP2>(lds, g, S, E);
    }
    GRID_SYNC();
    if (PHM & 4u) {
        LAS unsigned* lcnt = (LAS unsigned*)(lds + LDS_MISC); LAS unsigned* lbase = lcnt + 32;
        const int r = lane & 31, hh = lane >> 5;
        for (int unit = blockIdx.x; unit < BATCH * 32 * 16; unit += G) {
            const int h = unit & 15, qb = (unit >> 4) & 31, b = unit >> 9;
            if (tid < 32) lcnt[tid] = 0u;
            __syncthreads();
            const int tq = qb * 256 + wave * 32 + r, token = b * 8192 + tq;
            bf16x8 qf[4];
#pragma unroll
            for (int ks = 0; ks < 4; ++ks) qf[ks] = *(const bf16x8*)(Q0 + (size_t)token * DM + h * 64 + ks * 16 + hh * 8);
            f32x16 gt;
#pragma unroll
            for (int i = 0; i < 16; ++i) gt[i] = 0.f;
            const float* kmr = KM + ((size_t)((b * 16 + h) * 32 + r)) * 64 + hh * 8;
#pragma unroll
            for (int ks = 0; ks < 4; ++ks) { const f32x4 k0 = *(const f32x4*)(kmr + ks * 16), k1 = *(const f32x4*)(kmr + ks * 16 + 4);
                u32x4 kw; kw.x = pk2(k0[0], k0[1]); kw.y = pk2(k0[2], k0[3]); kw.z = pk2(k1[0], k1[1]); kw.w = pk2(k1[2], k1[3]);
                gt = MFMA32(__builtin_bit_cast(bf16x8, kw), qf[ks], gt); }
            float v0 = -3.0e38f, v1 = -3.0e38f, v2 = -3.0e38f;
#define TOP_INS(val) do { float t_ = (val); const float a_ = fmaxf(v0, t_); t_ = fminf(v0, t_); v0 = a_; const float b_ = fmaxf(v1, t_); t_ = fminf(v1, t_); v1 = b_; v2 = fmaxf(v2, t_); } while (0)
#pragma unroll
            for (int i = 0; i < 16; ++i) { const int j = crow(i, hh); const float gv_ = j < qb ? gt[i] : -3.0e38f; TOP_INS(__uint_as_float((__float_as_uint(gv_) & ~31u) | (unsigned)j)); }
            { const float pv0 = __shfl_xor(v0, 32), pv1 = __shfl_xor(v1, 32), pv2 = __shfl_xor(v2, 32); TOP_INS(pv0); TOP_INS(pv1); TOP_INS(pv2); }
#undef TOP_INS
            const int i0 = (int)(__float_as_uint(v0) & 31u), i1 = (int)(__float_as_uint(v1) & 31u), i2 = (int)(__float_as_uint(v2) & 31u);
            const int nvalid = qb < 3 ? qb : 3;
            unsigned lp0 = 0, lp1 = 0, lp2 = 0;
            if (hh == 0) {
                if (0 < nvalid) lp0 = __hip_atomic_fetch_add(lcnt + i0, 1u, __ATOMIC_RELAXED, __HIP_MEMORY_SCOPE_WORKGROUP); else PL[((size_t)0 * MTOK + token) * 16 + h] = -INFINITY;
                if (1 < nvalid) lp1 = __hip_atomic_fetch_add(lcnt + i1, 1u, __ATOMIC_RELAXED, __HIP_MEMORY_SCOPE_WORKGROUP); else PL[((size_t)1 * MTOK + token) * 16 + h] = -INFINITY;
                if (2 < nvalid) lp2 = __hip_atomic_fetch_add(lcnt + i2, 1u, __ATOMIC_RELAXED, __HIP_MEMORY_SCOPE_WORKGROUP); else PL[((size_t)2 * MTOK + token) * 16 + h] = -INFINITY;
            }
            __syncthreads();
            if (tid < 32) { const unsigned c = lcnt[tid]; lbase[tid] = c ? __hip_atomic_fetch_add(gcnt + (b * 16 + h) * 32 + tid, c, __ATOMIC_RELAXED, __HIP_MEMORY_SCOPE_AGENT) : 0u; }
            __syncthreads();
            if (hh == 0) {
                unsigned* lst = LIST + (size_t)(b * 16 + h) * LIST_CAP;
                if (0 < nvalid) lst[256 * (31 * i0 - (i0 * (i0 - 1)) / 2) + lbase[i0] + lp0] = (unsigned)tq | (0u << 13);
                if (1 < nvalid) lst[256 * (31 * i1 - (i1 * (i1 - 1)) / 2) + lbase[i1] + lp1] = (unsigned)tq | (1u << 13);
                if (2 < nvalid) lst[256 * (31 * i2 - (i2 * (i2 - 1)) / 2) + lbase[i2] + lp2] = (unsigned)tq | (2u << 13);
            }
        }
    }
    __syncthreads();
    GRID_SYNC();
#ifndef DUP3
#define DUP3 1
#endif
#ifndef DUP10
#define DUP10 1
#endif
    for (int rep3 = 0; rep3 < DUP3; ++rep3) {
        const LAS unsigned char* Kl = lds; const LAS unsigned char* Vl = lds + 256 * KPB; constexpr int VPB = (256 + 8) * 2;
        const int r = lane & 31, hh = lane >> 5;
        bf16_t* dump = (bf16_t*)(ws + WS_DUMP) + (size_t)((blockIdx.x & 255) * NWAVES + wave) * 2048;
        u32x4 kreg[4], vreg[4];
#define P3_LOADKV(b_, h_, j_) do { _Pragma("unroll") for (int i = 0; i < 4; ++i) { const int c = tid + NTHR * i; \
            kreg[i] = __builtin_nontemporal_load((const u32x4*)(K0 + (size_t)((b_) * 8192 + (j_) * 256 + (c >> 3)) * DM + (h_) * 64 + (c & 7) * 8)); \
            vreg[i] = __builtin_nontemporal_load((const u32x4*)(VT0 + ((size_t)((b_) * 16 + (h_)) * 64 + (c >> 5)) * 8192 + (j_) * 256 + (c & 31) * 8)); } } while (0)
        LAS int* sh_n = (LAS int*)(lds + LDS_MISC + 512); LAS int* sh_order = sh_n + 32; LAS int* sh_myj = sh_order + 32; LAS int* sh_cnt = sh_myj + 32;
      for (int v = blockIdx.x; v < 256; v += G) {
        const int bh = (v & 7) * 8 + (v >> 5), q4 = (v >> 3) & 3, b = bh >> 4, h = bh & 15;
        __syncthreads();
        if (tid < 32) sh_n[tid] = 256 + (int)gcnt[bh * 32 + tid] + 128;
        __syncthreads();
        if (tid < 32) { const int nj = sh_n[tid]; int rank = 0;
            for (int i = 0; i < 32; ++i) { const int ni = sh_n[i]; rank += (ni > nj || (ni == nj && i < tid)) ? 1 : 0; }
            sh_order[rank] = tid; }
        __syncthreads();
        if (tid == 0) { int l0 = 0, l1 = 0, l2 = 0, l3 = 0, cnt = 0;
            for (int k = 0; k < 32; ++k) { const int jx = sh_order[k], w = sh_n[jx];
                int bin = 0, lm = l0; if (l1 < lm) { lm = l1; bin = 1; } if (l2 < lm) { lm = l2; bin = 2; } if (l3 < lm) { lm = l3; bin = 3; }
                l0 += bin == 0 ? w : 0; l1 += bin == 1 ? w : 0; l2 += bin == 2 ? w : 0; l3 += bin == 3 ? w : 0;
                if (bin == q4) { sh_myj[cnt] = jx; ++cnt; } }
            sh_cnt[0] = cnt; }
        __syncthreads();
        const int nit = sh_cnt[0];
        const bf16_t* Qbh = Q0 + (size_t)b * 8192 * DM + h * 64 + hh * 8;
        bf16x8 qf[4];
        if (nit > 0) { const int j0 = sh_myj[0]; P3_LOADKV(b, h, j0);
#pragma unroll
            for (int ks = 0; ks < 4; ++ks) qf[ks] = *(const bf16x8*)(Qbh + (size_t)(j0 * 256 + wave * 32 + r) * DM + ks * 16); }
#define RAW_BARRIER() do { asm volatile("s_waitcnt lgkmcnt(0)" ::: "memory"); __builtin_amdgcn_s_barrier(); asm volatile("" ::: "memory"); } while (0)
        for (int it = 0; it < nit; ++it) {
            const int j = sh_myj[it], jn = (it + 1 < nit) ? sh_myj[it + 1] : -1;
            RAW_BARRIER();
#pragma unroll
            for (int i = 0; i < 4; ++i) { const int c = tid + NTHR * i;
                *(LAS u32x4*)(lds + (c >> 3) * KPB + (c & 7) * 16) = kreg[i];
                *(LAS u32x4*)(lds + 256 * KPB + (c >> 5) * VPB + (c & 31) * 16) = vreg[i]; }
            RAW_BARRIER();
            if (jn >= 0) P3_LOADKV(b, h, jn);
#ifdef P3_PROBE_OWNONLY
            const int n = (rep3 + 1 < DUP3) ? 256 : 256 + (int)gcnt[bh * 32 + j], ngroups = (n + 31) >> 5;
#else
            const int n = 256 + (int)gcnt[bh * 32 + j], ngroups = (n + 31) >> 5;
#endif
            const unsigned* lst = LIST + (size_t)bh * LIST_CAP + 256 * (31 * j - (j * (j - 1)) / 2);
            int g = wave;
            int tq = j * 256 + g * 32 + r, slot = 3; bool valid = true;
            const int tqN = (jn >= 0 ? jn : j) * 256 + wave * 32 + r;
            unsigned en = 0u; bool vn = false;
            if (g + 8 < ngroups) { const int row = (g + 8) * 32 + r; vn = row < n; en = lst[vn ? row - 256 : 0]; }
            for (; g < ngroups; g += NWAVES) {
                bf16x8 q1[4]; int tq1 = tqN, slot1 = 3; unsigned en2 = 0u; bool vn2 = false;
                if (g + 8 < ngroups) { tq1 = (int)(en & 8191u); slot1 = (int)(en >> 13); }
#pragma unroll
                for (int ks = 0; ks < 4; ++ks) q1[ks] = *(const bf16x8*)(Qbh + (size_t)tq1 * DM + ks * 16);
                if (g + 16 < ngroups) { const int row = (g + 16) * 32 + r; vn2 = row < n; en2 = lst[vn2 ? row - 256 : 0]; }
                f32x16 o[2]; float lse2;
                attn_rows<8, 1, 2>(Kl, Vl, VPB, qf, r, hh, g < 8 ? g : 99, 0, o, lse2);
                {
                    LAS unsigned char* stg = lds + 73728 + wave * STG_WAVE;
                    stage_o8(stg, o, r, hh);
                    const int myinfo = tq | (slot << 13) | (valid ? (1 << 15) : 0);
                    {
                        const int R = lane >> 1, half = lane & 1;
                        const u32x4 v0 = *(const LAS u32x4*)(stg + R * STG8_PITCH + half * 32), v1 = *(const LAS u32x4*)(stg + R * STG8_PITCH + half * 32 + 16);
                        const int info = __shfl(myinfo, R), tqR = info & 8191, slotR = (info >> 13) & 3;
                        unsigned char* dstp = (slotR == 3 ? (unsigned char*)PO3 : (unsigned char*)PO + (size_t)slotR * MTOK * DM) + ((size_t)b * 8192 + tqR) * DM + h * 64 + half * 32;
                        if (!(info & (1 << 15))) dstp = (unsigned char*)dump + lane * 32;
                        __builtin_nontemporal_store(v0, (u32x4*)dstp); __builtin_nontemporal_store(v1, (u32x4*)(dstp + 16));
                    }
                    { float* plp = PL + ((size_t)slot * MTOK + (size_t)b * 8192 + tq) * 16 + h; if (!valid) plp = (float*)(dump + 1024) + lane; *plp = lse2; }
                }
#pragma unroll
                for (int ks = 0; ks < 4; ++ks) qf[ks] = q1[ks];
                tq = tq1; slot = slot1; valid = vn; en = en2; vn = vn2;
            }
        }
      }
#undef P3_LOADKV
#undef RAW_BARRIER
    }
    __syncthreads();
    GRID_SYNC();
    if (PHM & 16u) {
        const int head = lane >> 2, part = lane & 3;
        for (int token = gw; token < MTOK; token += ngw) {
            float ls[4], mxl = -INFINITY;
#pragma unroll
            for (int s = 0; s < 4; ++s) { ls[s] = PL[((size_t)s * MTOK + token) * 16 + head]; mxl = fmaxf(mxl, ls[s]); }
            float accv[16], den = 0.f;
#pragma unroll
            for (int i = 0; i < 16; ++i) accv[i] = 0.f;
#pragma unroll
            for (int s = 0; s < 4; ++s) {
                const float w = __builtin_amdgcn_exp2f(ls[s] - mxl);
                if (w > 0.f) {
                    den += w;
                    const unsigned char* src = (s == 3 ? (const unsigned char*)PO3 : (const unsigned char*)PO + (size_t)s * MTOK * DM) + (size_t)token * DM + head * 64 + part * 16;
                    const u32x4 a = *(const u32x4*)src;
                    const float ws_ = w * (1.0f / PO8_SCALE);
#pragma unroll
                    for (int k = 0; k < 4; ++k) { const f32x2_t lo = __builtin_amdgcn_cvt_pk_f32_fp8((int)a[k], false), hi = __builtin_amdgcn_cvt_pk_f32_fp8((int)a[k], true);
                        accv[4 * k] += ws_ * lo.x; accv[4 * k + 1] += ws_ * lo.y; accv[4 * k + 2] += ws_ * hi.x; accv[4 * k + 3] += ws_ * hi.y; }
                }
            }
            const float inv = 1.0f / den;
            bf16_t* dst = Q0 + (size_t)token * DM + head * 64 + part * 16;
            u32x4 w0, w1;
            w0.x = pk2(accv[0] * inv, accv[1] * inv); w0.y = pk2(accv[2] * inv, accv[3] * inv); w0.z = pk2(accv[4] * inv, accv[5] * inv); w0.w = pk2(accv[6] * inv, accv[7] * inv);
            w1.x = pk2(accv[8] * inv, accv[9] * inv); w1.y = pk2(accv[10] * inv, accv[11] * inv); w1.z = pk2(accv[12] * inv, accv[13] * inv); w1.w = pk2(accv[14] * inv, accv[15] * inv);
            *(u32x4*)dst = w0; *(u32x4*)(dst + 8) = w1;
        }
    }
    GRID_SYNC();
    if (PHM & 32u) {
        pg8::Gemm g{Q0, Wo0, MTOK, DM, DM}; pg8::StaticOrder S; S.init(MTOK, DM, G, (int)blockIdx.x);
        EpiResid<0> E{HB, Zb, nullptr, ST, nullptr, nullptr};
        for (int repg = 0; repg < DUPG; ++repg) pg8::gemm_phase<EpiResid<0>, pg8::StaticOrder, G_ALIGN, G_SP2>(lds, g, S, E);
    }
    GRID_SYNC();
    if (PHM & 64u) {
        pg8::Gemm g{Zb, (const bf16_t*)(ws + WS_WIN0), MTOK, FF, DM}; pg8::StaticOrder S; S.init(MTOK, FF, G, (int)blockIdx.x);
        EpiSqRelu E{Hm, FF, ST, C1 + C_WIN0, C2 + C_WIN0};
        for (int repg = 0; repg < DUPG * DUPU; ++repg) pg8::gemm_phase<EpiSqRelu, pg8::StaticOrder, G_ALIGN, G_SP2>(lds, g, S, E);
    }
    GRID_SYNC();
    {
        pg8::Gemm g{Hm, (const bf16_t*)(ws + WS_WOUT0), MTOK, DM, FF}; pg8::StaticOrder S; S.init(MTOK, DM, G, (int)blockIdx.x);
        EpiResid<1> E{nullptr, Zb, ST, ST + 2 * MTOK, args.in[7], args.in[8]};
        for (int repg = 0; repg < DUPG; ++repg) pg8::gemm_phase<EpiResid<1>, pg8::StaticOrder, G_ALIGN, G_SP2>(lds, g, S, E);
    }
    GRID_SYNC();

    bf16_t* Q1 = (bf16_t*)(ws + WS_Q1); bf16_t* K1 = (bf16_t*)(ws + WS_K1); bf16_t* VT1 = (bf16_t*)(ws + WS_VT1); bf16_t* PO1 = (bf16_t*)(ws + WS_PO1); float* PL1 = (float*)(ws + WS_PL1);
    if (PHM & 128u) {
        pg8::Gemm g{Zb, Wqkv1, MTOK, NQKV1, DM}; pg8::StaticOrder S; S.init(MTOK, NQKV1, G, (int)blockIdx.x);
        EpiQKV<1> E{Q1, K1, VT1, nullptr, cosT, sinT, ST + 2 * MTOK, C1 + C_QKV1, C2 + C_QKV1};
        for (int repg = 0; repg < DUPG * DUPQ1; ++repg) pg8::gemm_phase<EpiQKV<1>, pg8::StaticOrder, G_ALIGN, G_SP2>(lds, g, S, E);
    }
    GRID_SYNC();
    for (int rep10 = 0; rep10 < DUP10; ++rep10) {
        constexpr int VPB = (384 + 8) * 2; const int r = lane & 31, hh = lane >> 5;
        u32x4 kreg[6], vreg[6];
#define P10_DECODE(unit_, pp_, head_, b_, dsh_, gb_, hp_) const int pp_ = (unit_) & 31, head_ = ((unit_) >> 5) % 12, b_ = (unit_) / (32 * 12), dsh_ = 2 * (head_ >> 2), gb_ = 2 * pp_, hp_ = ((gb_ & ((64 >> dsh_) - 1)) != 0) ? 1 : 0
#define P10_LOAD(b_, head_, gb_, hp_) do { _Pragma("unroll") for (int i = 0; i < 6; ++i) { const int c = tid + NTHR * i; \
            { const int f = c >> 3, part = c & 7; kreg[i] = (u32x4){0u, 0u, 0u, 0u}; \
              if ((hp_) || f >= 128) kreg[i] = __builtin_nontemporal_load((const u32x4*)(K1 + ((size_t)(b_) * 8192 + ((gb_) - 1) * 128 + f) * D1 + (head_) * 64 + part * 8)); } \
            { const int d = c / 48, part = c - d * 48; vreg[i] = (u32x4){0u, 0u, 0u, 0u}; \
              if ((hp_) || part >= 16) vreg[i] = __builtin_nontemporal_load((const u32x4*)(VT1 + ((size_t)((b_) * 12 + (head_)) * 64 + d) * 8192 + ((gb_) - 1) * 128 + part * 8)); } } } while (0)
#define RAW_BARRIER() do { asm volatile("s_waitcnt lgkmcnt(0)" ::: "memory"); __builtin_amdgcn_s_barrier(); asm volatile("" ::: "memory"); } while (0)
        if ((int)blockIdx.x < BATCH * 12 * 32) { P10_DECODE((int)blockIdx.x, pp0, head0, b0, dsh0, gb0, hp0); P10_LOAD(b0, head0, gb0, hp0); }
        for (int unit = blockIdx.x; unit < BATCH * 12 * 32; unit += G) {
            P10_DECODE(unit, pp, head, b, dsh, gb, hasprev);
            bf16x8 qc[4];
#pragma unroll
            for (int ks = 0; ks < 4; ++ks) qc[ks] = *(const bf16x8*)(Q1 + ((size_t)b * 8192 + gb * 128 + wave * 32 + r) * D1 + head * 64 + ks * 16 + hh * 8);
            RAW_BARRIER();
#pragma unroll
            for (int i = 0; i < 6; ++i) { const int c = tid + NTHR * i;
                *(LAS u32x4*)(lds + (c >> 3) * KPB + (c & 7) * 16) = kreg[i];
                { const int d = c / 48, part = c - d * 48; *(LAS u32x4*)(lds + 384 * KPB + d * VPB + part * 16) = vreg[i]; } }
            RAW_BARRIER();
            if (unit + G < BATCH * 12 * 32) { P10_DECODE(unit + G, ppn, headn, bn, dshn, gbn, hpn); P10_LOAD(bn, headn, gbn, hpn); }
            const int rr = gb * 128 + wave * 32 + r;
            f32x16 o[2]; float lse2;
            attn_rows<5, 2, 2>(lds + wave * 32 * KPB, lds + 384 * KPB + wave * 64, VPB, qc, r, hh, wave, hasprev, o, lse2);
            const int t = ((rr & ((8192 >> dsh) - 1)) << dsh) | (rr >> (13 - dsh));
            const size_t token = (size_t)b * 8192 + t;
            {
                LAS unsigned char* stg = lds + 384 * KPB + 64 * VPB + wave * STG_WAVE;
                stage_o(stg, o, r, hh);
#pragma unroll
                for (int i = 0; i < 4; ++i) {
                    const int R = i * 8 + (lane >> 3), chunk = lane & 7;
                    const u32x4 vrow = *(const LAS u32x4*)(stg + R * STG_PITCH + chunk * 16);
                    const int tR = __shfl(t, R);
                    *(u32x4*)(PO1 + ((size_t)b * 8192 + tR) * D1 + head * 64 + chunk * 8) = vrow;
                }
            }
            PL1[token * 12 + head] = lse2;
        }
#undef P10_DECODE
#undef P10_LOAD
#undef RAW_BARRIER
    }
    __syncthreads();
    GRID_SYNC();
    {
        const int head = lane >> 2, part = lane & 3, hs = head & 3, gsel = head >> 2;
        for (int token = gw; token < MTOK; token += ngw) {
            if (lane < 48) {
                const float l0 = PL1[(size_t)token * 12 + hs], l1 = PL1[(size_t)token * 12 + 4 + hs], l2 = PL1[(size_t)token * 12 + 8 + hs];
                const float mxl = fmaxf(l0, fmaxf(l1, l2));
                const float w0 = __builtin_amdgcn_exp2f(l0 - mxl), w1 = __builtin_amdgcn_exp2f(l1 - mxl), w2 = __builtin_amdgcn_exp2f(l2 - mxl);
                const float al = (gsel == 0 ? w0 : (gsel == 1 ? w1 : w2)) / (w0 + w1 + w2);
                bf16_t* p = PO1 + (size_t)token * D1 + head * 64 + part * 16;
                u32x4 a = *(const u32x4*)p, c = *(const u32x4*)(p + 8);
                a.x = pk2(al * bf_lo(a.x), al * bf_hi(a.x)); a.y = pk2(al * bf_lo(a.y), al * bf_hi(a.y)); a.z = pk2(al * bf_lo(a.z), al * bf_hi(a.z)); a.w = pk2(al * bf_lo(a.w), al * bf_hi(a.w));
                c.x = pk2(al * bf_lo(c.x), al * bf_hi(c.x)); c.y = pk2(al * bf_lo(c.y), al * bf_hi(c.y)); c.z = pk2(al * bf_lo(c.z), al * bf_hi(c.z)); c.w = pk2(al * bf_lo(c.w), al * bf_hi(c.w));
                *(u32x4*)p = a; *(u32x4*)(p + 8) = c;
            }
        }
    }
    GRID_SYNC();
    {
        pg8::Gemm g{PO1, Wo1, MTOK, DM, D1}; pg8::StaticOrder S; S.init(MTOK, DM, G, (int)blockIdx.x);
        EpiResid<1> E{nullptr, Zb, ST + 2 * MTOK, ST + 4 * MTOK, args.in[9], args.in[10]};
        for (int repg = 0; repg < DUPG; ++repg) pg8::gemm_phase<EpiResid<1>, pg8::StaticOrder, G_ALIGN, G_SP2>(lds, g, S, E);
    }
    GRID_SYNC();
    {
        pg8::Gemm g{Zb, (const bf16_t*)(ws + WS_WIN1), MTOK, FF, DM}; pg8::StaticOrder S; S.init(MTOK, FF, G, (int)blockIdx.x);
        EpiSqRelu E{Hm, FF, ST + 4 * MTOK, C1 + C_WIN1, C2 + C_WIN1};
        for (int repg = 0; repg < DUPG * DUPU; ++repg) pg8::gemm_phase<EpiSqRelu, pg8::StaticOrder, G_ALIGN, G_SP2>(lds, g, S, E);
    }
    GRID_SYNC();
    {
        pg8::Gemm g{Hm, (const bf16_t*)(ws + WS_WOUT1), MTOK, DM, FF}; pg8::StaticOrder S; S.init(MTOK, DM, G, (int)blockIdx.x);
        EpiResid<1> E{nullptr, Zb, ST + 4 * MTOK, ST + 6 * MTOK, args.in[7] + DM, args.in[8] + DM};
        for (int repg = 0; repg < DUPG; ++repg) pg8::gemm_phase<EpiResid<1>, pg8::StaticOrder, G_ALIGN, G_SP2>(lds, g, S, E);
    }
    GRID_SYNC();
    ln_phase<true>(Zb, args.in[9] + DM, args.in[10] + DM, nullptr, args.out, gw, ngw, lane);
}

extern "C" void kernel_launch(void* const* d_in, const int* in_sizes, int n_in, void* d_out, int out_size, void* d_ws, size_t ws_size, hipStream_t stream) {
    static int grid_blocks = 0;
    if (grid_blocks == 0) {
        if (n_in != 11 || out_size != MTOK * DM || ws_size < WS_END) { fprintf(stderr, "kernel_launch: unexpected shapes (n_in %d, out %d, ws %zu)\n", n_in, out_size, ws_size); grid_blocks = -1; return; }
        int dev = 0, cus = 0, per_cu = 0;
        hipGetDevice(&dev);
        hipDeviceGetAttribute(&cus, hipDeviceAttributeMultiprocessorCount, dev);
        if (hipFuncSetAttribute((const void*)hybrid_fwd, hipFuncAttributeMaxDynamicSharedMemorySize, LDS_BYTES) != hipSuccess) { fprintf(stderr, "kernel_launch: hipFuncSetAttribute failed\n"); }
        if (hipOccupancyMaxActiveBlocksPerMultiprocessor(&per_cu, (const void*)hybrid_fwd, NTHR, LDS_BYTES) != hipSuccess || per_cu < 1) { fprintf(stderr, "kernel_launch: occupancy query says %d blocks per CU\n", per_cu); per_cu = 1; (void)hipGetLastError(); }
        if (per_cu > 1) per_cu = 1;
        grid_blocks = cus * per_cu;
    }
    if (grid_blocks < 0) return;
    (void)hipMemsetAsync((char*)d_ws + WS_CTL, 0, CTL_BYTES, stream);
    Args a{};
    for (int i = 0; i < 11; ++i) a.in[i] = (const float*)d_in[i];
    a.out = (float*)d_out; a.ws = (unsigned char*)d_ws;
    void* kargs[] = {&a};
    hipError_t e = hipLaunchCooperativeKernel((const void*)hybrid_fwd, dim3(grid_blocks), dim3(NTHR), kargs, LDS_BYTES, stream);
    if (e != hipSuccess) fprintf(stderr, "kernel_launch: cooperative launch failed: %s (grid %d)\n", hipGetErrorString(e), grid_blocks);
}
```

```cpp
#include <hip/hip_runtime.h>
#include <hip/hip_cooperative_groups.h>
#include <cstdio>
#include <cstdint>
namespace cg = cooperative_groups;
namespace pg8 {
#define PG8_LAS __attribute__((address_space(3)))
typedef unsigned short bf16_t;
typedef short bf16x8 __attribute__((ext_vector_type(8)));
typedef float f32x4 __attribute__((ext_vector_type(4)));
typedef unsigned u32x4 __attribute__((ext_vector_type(4)));
constexpr int BM = 256, BK = 64, HALF = 128, HTB = HALF * BK * 2  , STAGE_BYTES = 8 * HTB, NXCD = 8, WGM = 4;

__host__ __device__ __forceinline__ int lds_byte(int r, int c) { const int st = (r >> 4) * 2 + (c >> 5), rr = r & 15, cc = c & 31, ob = rr * 64 + cc * 2; return st * 1024 + (ob ^ (((ob >> 9) & 1) << 5)); }
__host__ __device__ __forceinline__ void stage_rc(int b, int& R, int& C) { const int st = b / 1024, sb = b % 1024, swz = sb ^ (((sb >> 9) & 1) << 5); R = (st >> 1) * 16 + swz / 64; C = (st & 1) * 32 + (swz % 64) / 2; }
__host__ __device__ __forceinline__ int perm32(int rho) { const int n = rho >> 4, i = rho & 15; return 8 * (i >> 2) + 4 * n + (i & 3); }

struct Unit { int pm, pn; };
struct Gemm { const bf16_t* A; const bf16_t* Bt; int M, N, K; };

struct StaticOrder {
    int nM, nN, nwg, G, c;
    __host__ __device__ void init(int M, int N, int G_, int c_) { nM = M / BM; nN = N / BM; nwg = nM * nN; G = G_; c = c_; }
    __host__ __device__ bool next(int i, Unit& u) const {
        const long L = (long)i * G + c; if (L >= nwg) return false;
        int wgid = (int)L; { const int q = nwg / NXCD, r = nwg % NXCD, xcd = wgid % NXCD, off = wgid / NXCD; wgid = (xcd < r ? xcd * (q + 1) : r * (q + 1) + (xcd - r) * q) + off; }
        const int nig = WGM * nN, gid = wgid / nig, fm = gid * WGM, gsz = (nM - fm) < WGM ? (nM - fm) : WGM;
        u.pm = fm + ((wgid % nig) % gsz); u.pn = (wgid % nig) / gsz; return true;
    }
    __device__ __forceinline__ void a_ready(const Unit&) const {}
    __device__ __forceinline__ void done(const Unit&) const {}
};


__device__ __forceinline__ unsigned cvt_pk_bf16(float lo, float hi) { unsigned r; asm volatile("v_cvt_pk_bf16_f32 %0, %1, %2" : "=v"(r) : "v"(lo), "v"(hi)); return r; }
typedef float f32x2 __attribute__((ext_vector_type(2)));

template <class Epi, class Sched, bool ALIGN_EPI = false, bool SP2 = false>
__device__ __forceinline__ void gemm_phase(PG8_LAS unsigned char* lds, const Gemm g, const Sched& S, const Epi& E) {
    int tid_ = threadIdx.x; asm volatile("" : "+v"(tid_));
    const int tid = tid_, wid = __builtin_amdgcn_readfirstlane(tid >> 6), lane = tid & 63, wr = wid >> 2, wc = wid & 3, fr = lane & 15, fq = lane >> 4;
    const int K = g.K, nt = K / BK;
    unsigned voffA[2], voffB[2];
#pragma unroll
    for (int i = 0; i < 2; ++i) { int R, C; stage_rc(tid * 16 + i * 8192, R, C); const int Rb = Epi::PERM ? ((R & ~31) + perm32(R & 31)) : R;
        voffA[i] = (unsigned)(R * K + C) * 2u; voffB[i] = (unsigned)(Rb * K + C) * 2u; }
    const size_t kstep = (size_t)(BK * 2);
    const size_t hstep = (size_t)HALF * K * 2;
    const size_t tstep = 2 * hstep;
    const unsigned ldsw = (unsigned)wid * 1024u;
    const int aoff = lds_byte(wr * 64 + fr, fq * 8), boff = lds_byte(wc * 32 + fr, fq * 8);
#define PG8_SA(b, h) (((b) * 2 + (h)) * HTB)
#define PG8_SB(b, h) ((4 + (b) * 2 + (h)) * HTB)
#define PG8_STAGE(bufoff, gbase, voff) do { _Pragma("unroll") for (int _i = 0; _i < 2; ++_i) \
        __builtin_amdgcn_global_load_lds((const unsigned*)((const char*)(gbase) + (voff)[_i]), (PG8_LAS unsigned*)(lds + (bufoff) + ldsw + _i * 8192), 16, 0, 0); } while (0)
#define PG8_LDA(dst, b, h) do { _Pragma("unroll") for (int m = 0; m < 4; ++m) _Pragma("unroll") for (int k = 0; k < 2; ++k) dst[m][k] = *(const PG8_LAS bf16x8*)(lds + PG8_SA(b, h) + aoff + m * 2048 + k * 1024); } while (0)
#define PG8_LDB(dst, b, h) do { _Pragma("unroll") for (int n = 0; n < 2; ++n) _Pragma("unroll") for (int k = 0; k < 2; ++k) dst[n][k] = *(const PG8_LAS bf16x8*)(lds + PG8_SB(b, h) + boff + n * 2048 + k * 1024); } while (0)
#define PG8_MMA(ai, bj, At, Bt) do { __builtin_amdgcn_s_setprio(1); _Pragma("unroll") for (int m = 0; m < 4; ++m) _Pragma("unroll") for (int n = 0; n < 2; ++n) _Pragma("unroll") for (int k = 0; k < 2; ++k) \
        acc[ai][bj][m][n] = __builtin_amdgcn_mfma_f32_16x16x32_bf16(Bt[n][k], At[m][k], acc[ai][bj][m][n], 0, 0, 0); __builtin_amdgcn_s_setprio(0); } while (0)
#define PG8_WAIT_V(n) asm volatile("s_waitcnt vmcnt(" #n ")" ::: "memory")
#define PG8_WAIT_L(n) asm volatile("s_waitcnt lgkmcnt(" #n ")" ::: "memory")
#define PG8_BAR __builtin_amdgcn_s_barrier()
#define PG8_SCHED __builtin_amdgcn_sched_barrier(0)
    Unit cur, nxt; int ui = 0;
    if (!S.next(0, cur)) return;
    f32x4 acc[2][2][4][2];
#pragma unroll
    for (int a = 0; a < 2; ++a)
#pragma unroll
        for (int b = 0; b < 2; ++b)
#pragma unroll
            for (int m = 0; m < 4; ++m)
#pragma unroll
                for (int n = 0; n < 2; ++n) acc[a][b][m][n] = (f32x4){0.f, 0.f, 0.f, 0.f};
    bf16x8 At[4][2], B0[2][2], B1[2][2];
    const char* cA = (const char*)g.A + (size_t)cur.pm * tstep; const char* cB = (const char*)g.Bt + (size_t)cur.pn * tstep;
    S.a_ready(cur);
    if constexpr (SP2) {
        PG8_STAGE(PG8_SB(0, 0), cB, voffB); PG8_STAGE(PG8_SB(0, 1), cB + hstep, voffB); PG8_STAGE(PG8_SA(0, 0), cA, voffA); PG8_STAGE(PG8_SA(0, 1), cA + hstep, voffA);
        if (wr == 1) PG8_BAR;
        PG8_WAIT_V(2); PG8_BAR;
        PG8_STAGE(PG8_SB(1, 0), cB + kstep, voffB); PG8_STAGE(PG8_SA(1, 0), cA + kstep, voffA); PG8_STAGE(PG8_SB(1, 1), cB + hstep + kstep, voffB);
        PG8_WAIT_V(6); PG8_BAR;
    } else {
        PG8_STAGE(PG8_SB(0, 0), cB, voffB); PG8_STAGE(PG8_SA(0, 0), cA, voffA); PG8_STAGE(PG8_SB(0, 1), cB + hstep, voffB); PG8_STAGE(PG8_SA(0, 1), cA + hstep, voffA);
        if (wr == 1) PG8_BAR;
        PG8_WAIT_V(4); PG8_BAR;
        PG8_STAGE(PG8_SB(1, 0), cB + kstep, voffB); PG8_STAGE(PG8_SA(1, 0), cA + kstep, voffA); PG8_STAGE(PG8_SB(1, 1), cB + hstep + kstep, voffB);
        PG8_WAIT_V(6); PG8_BAR;
    }
    for (;;) {
        const bool has_next = S.next(ui + 1, nxt);
        const char* nA = has_next ? (const char*)g.A + (size_t)nxt.pm * tstep : cA; const char* nB = has_next ? (const char*)g.Bt + (size_t)nxt.pn * tstep : cB;
        for (int t = 0; t < nt; t += 2) {
            const bool last = (t == nt - 2);
            const char* a1 = cA + (size_t)(t + 1) * kstep;
            const char* a2 = last ? nA : cA + (size_t)(t + 2) * kstep; const char* b2 = last ? nB : cB + (size_t)(t + 2) * kstep;
            const char* a3 = a2 + kstep; const char* b3 = b2 + kstep;
            if (last && has_next) S.a_ready(nxt);
            if constexpr (SP2) {
            PG8_LDB(B0, 0, 0); PG8_LDB(B1, 0, 1); PG8_SCHED; PG8_LDA(At, 0, 0); PG8_STAGE(PG8_SA(1, 1), a1 + hstep, voffA);
            PG8_WAIT_V(8); PG8_WAIT_L(0); PG8_BAR; PG8_MMA(0, 0, At, B0); PG8_MMA(0, 1, At, B1); PG8_BAR; PG8_SCHED;
            PG8_LDA(At, 0, 1); PG8_STAGE(PG8_SB(0, 0), b2, voffB); PG8_STAGE(PG8_SB(0, 1), b2 + hstep, voffB); PG8_STAGE(PG8_SA(0, 0), a2, voffA);
            PG8_WAIT_V(8); PG8_WAIT_L(0); PG8_BAR; PG8_MMA(1, 0, At, B0); PG8_MMA(1, 1, At, B1); PG8_BAR; PG8_SCHED;
            PG8_LDB(B0, 1, 0); PG8_LDB(B1, 1, 1); PG8_SCHED; PG8_LDA(At, 1, 0); PG8_STAGE(PG8_SA(0, 1), a2 + hstep, voffA);
            PG8_WAIT_V(8); PG8_WAIT_L(0); PG8_BAR; PG8_MMA(0, 0, At, B0); PG8_MMA(0, 1, At, B1); PG8_BAR; PG8_SCHED;
            PG8_LDA(At, 1, 1); PG8_STAGE(PG8_SB(1, 0), b3, voffB); PG8_STAGE(PG8_SB(1, 1), b3 + hstep, voffB); PG8_STAGE(PG8_SA(1, 0), a3, voffA);
            PG8_WAIT_V(8); PG8_WAIT_L(0); PG8_BAR; PG8_MMA(1, 0, At, B0); PG8_MMA(1, 1, At, B1); PG8_BAR; PG8_SCHED;
            } else {
            PG8_LDB(B0, 0, 0); PG8_SCHED; PG8_LDA(At, 0, 0); PG8_STAGE(PG8_SA(1, 1), a1 + hstep, voffA);
            PG8_WAIT_L(8); PG8_BAR; PG8_WAIT_L(0); PG8_MMA(0, 0, At, B0); PG8_BAR; PG8_SCHED;
            PG8_LDB(B1, 0, 1); PG8_STAGE(PG8_SB(0, 0), b2, voffB);
            PG8_BAR; PG8_WAIT_L(0); PG8_MMA(0, 1, At, B1); PG8_BAR;
            PG8_LDA(At, 0, 1); PG8_STAGE(PG8_SA(0, 0), a2, voffA);
            PG8_BAR; PG8_WAIT_L(0); PG8_MMA(1, 0, At, B0); PG8_BAR; PG8_SCHED;
            PG8_STAGE(PG8_SB(0, 1), b2 + hstep, voffB);
            PG8_WAIT_V(6); PG8_BAR; PG8_MMA(1, 1, At, B1); PG8_BAR;
            PG8_LDB(B0, 1, 0); PG8_SCHED; PG8_LDA(At, 1, 0); PG8_STAGE(PG8_SA(0, 1), a2 + hstep, voffA);
            PG8_WAIT_L(8); PG8_BAR; PG8_WAIT_L(0); PG8_MMA(0, 0, At, B0); PG8_BAR; PG8_SCHED;
            PG8_LDB(B1, 1, 1); PG8_STAGE(PG8_SB(1, 0), b3, voffB);
            PG8_BAR; PG8_WAIT_L(0); PG8_MMA(0, 1, At, B1); PG8_BAR;
            PG8_LDA(At, 1, 1); PG8_STAGE(PG8_SA(1, 0), a3, voffA);
            PG8_BAR; PG8_WAIT_L(0); PG8_MMA(1, 0, At, B0); PG8_BAR; PG8_SCHED;
            PG8_STAGE(PG8_SB(1, 1), b3 + hstep, voffB);
            PG8_WAIT_V(6); PG8_BAR; PG8_MMA(1, 1, At, B1); PG8_BAR;
            }
        }
        if constexpr (ALIGN_EPI) { if (wr == 0) PG8_BAR; }
        if constexpr (!Epi::AFTER_DRAIN) { E(acc, cur, wr, wc, fr, fq); S.done(cur); }
        if (!has_next) break;
#pragma unroll
        for (int a = 0; a < 2; ++a)
#pragma unroll
            for (int b = 0; b < 2; ++b)
#pragma unroll
                for (int m = 0; m < 4; ++m)
#pragma unroll
                    for (int n = 0; n < 2; ++n) acc[a][b][m][n] = (f32x4){0.f, 0.f, 0.f, 0.f};
        cur = nxt; cA = nA; cB = nB; ++ui;
        if constexpr (ALIGN_EPI) { if (wr == 1) PG8_BAR; }
    }
    PG8_WAIT_V(0);
    if constexpr (!ALIGN_EPI) { if (wr == 0) PG8_BAR; }
    PG8_BAR;
    if constexpr (Epi::AFTER_DRAIN) { E.fused(acc, cur, wr, wc, fr, fq, lds, wid, lane); S.done(cur); }
#undef PG8_SA
#undef PG8_SB
#undef PG8_STAGE
#undef PG8_LDA
#undef PG8_LDB
#undef PG8_MMA
#undef PG8_WAIT_V
#undef PG8_WAIT_L
#undef PG8_BAR
#undef PG8_SCHED
}
}

#define LAS __attribute__((address_space(3)))
using pg8::bf16_t; using pg8::bf16x8; using pg8::f32x4; using pg8::u32x4; using pg8::Unit;
typedef float f32x16 __attribute__((ext_vector_type(16)));
typedef float f32x2_t __attribute__((ext_vector_type(2)));
typedef __bf16 bf16x2_t __attribute__((ext_vector_type(2)));
typedef unsigned u32x2 __attribute__((ext_vector_type(2)));
#define MFMA32(a, b, c) __builtin_amdgcn_mfma_f32_32x32x16_bf16((a), (b), (c), 0, 0, 0)

constexpr int BATCH = 4, SEQ = 8192, DM = 1024, MTOK = BATCH * SEQ, FF = 4096, NQKV0 = 3072, NQKV1 = 2304, D1 = 768;
constexpr float ALPHA = 1.41421356237309505f, LN_EPS = 1e-5f, QSCALE = 0.125f * 1.4426950408889634f;
constexpr int NWAVES = 8, NTHR = 512;
constexpr int LIST_CAP = 126976;

constexpr size_t MiB = 1u << 20;
constexpr size_t WS_CTL = 0, CTL_BYTES = 2 * MiB;
constexpr size_t WS_KM = 128 * 1024, WS_BAR = 16 * 1024;
constexpr size_t WS_COS = 505 * MiB, WS_SIN = 506 * MiB;
constexpr size_t WS_C12 = 640 * 1024, WS_ST = 1 * MiB;
constexpr int NC12 = 4096 + 4096 + 2304, C_WIN0 = 0, C_WIN1 = 4096, C_QKV1 = 8192;
constexpr size_t WS_WQKV0 = 3 * MiB, WS_WO0 = 9 * MiB, WS_WQKV1 = 11 * MiB, WS_WO1 = 15 * MiB + 512 * 1024, WS_WIN0 = 17 * MiB, WS_WOUT0 = 25 * MiB, WS_WIN1 = 33 * MiB, WS_WOUT1 = 41 * MiB;
constexpr size_t WS_HB = 49 * MiB;
constexpr size_t WS_Q = 113 * MiB, WS_K = 177 * MiB, WS_VT = 241 * MiB, WS_PO = 305 * MiB, WS_PL = 497 * MiB;
constexpr size_t WS_H = 113 * MiB, WS_Z = 369 * MiB, WS_HB2 = 433 * MiB;
constexpr size_t WS_Q1 = 113 * MiB, WS_K1 = 161 * MiB, WS_VT1 = 209 * MiB, WS_PO1 = 257 * MiB, WS_PL1 = 305 * MiB;
constexpr size_t WS_DUMP = 401 * MiB, WS_END = 507 * MiB;
constexpr size_t OUT_PO3 = 0, OUT_LIST = 64 * MiB;

#ifndef DUPU
#define DUPU 1
#endif
#ifndef DUPQ0
#define DUPQ0 1
#endif
#ifndef DUPQ1
#define DUPQ1 1
#endif
#ifndef DUPG
#define DUPG 1
#endif
#ifndef G_ALIGN
#define G_ALIGN true
#endif
#ifndef G_SP2
#define G_SP2 true
#endif
#ifndef PHM
#define PHM 0xFFFFFFFFu
#endif
constexpr int RING_BYTES = 131072, LDS_BYTES = 147456, LDS_MISC = LDS_BYTES - 1024;

__device__ __forceinline__ unsigned pk2(float lo, float hi) { f32x2_t v = {lo, hi}; bf16x2_t b = __builtin_convertvector(v, bf16x2_t); return __builtin_bit_cast(unsigned, b); }
__device__ __forceinline__ float bf_lo(unsigned u) { return __uint_as_float(u << 16); }
__device__ __forceinline__ float bf_hi(unsigned u) { return __uint_as_float(u & 0xffff0000u); }
__device__ __forceinline__ int crow(int i, int hh) { return (i & 3) + 8 * (i >> 2) + 4 * hh; }
__device__ __forceinline__ float wave_sum(float v) {
#pragma unroll
    for (int o = 1; o < 64; o <<= 1) v += __shfl_xor(v, o);
    return v;
}
#define LDS_WAIT() asm volatile("s_waitcnt lgkmcnt(0)" ::: "memory")
__device__ __forceinline__ int qkv_phys(int c) { return (c & ~255) + ((c & 32) ? 128 : 0) + (((c >> 6) & 3) << 5) + (c & 31); }
__device__ __forceinline__ int swz16(int r) { return (r & ~12) | ((r & 4) << 1) | ((r & 8) >> 1); }

#define ROW_STATS(st_, row_, mu_, rs_) do { const f32x2_t sv_ = *(const f32x2_t*)((st_) + (size_t)(row_) * 2); (mu_) = sv_.x * (1.0f / DM); (rs_) = 1.0f / sqrtf(sv_.y * (1.0f / DM) - (mu_) * (mu_) + LN_EPS); } while (0)
template <int LAYER> struct EpiQKV {
    static constexpr bool PERM = true, AFTER_DRAIN = false;
    bf16_t* Q; bf16_t* Kb; bf16_t* VT; float* KM; const float* cs; const float* sn; const float* st; const float* c1; const float* c2;
    __device__ __forceinline__ void operator()(const f32x4 (&acc)[2][2][4][2], const Unit& u, int wr, int wc, int fr, int fq) const {
        constexpr int NT = LAYER == 0 ? 4 : 3, PITCH = NT * 256, NH = NT * 4;
        const int which = u.pn / NT, hg = u.pn - which * NT, head = hg * 4 + wc, e0 = 8 * fq;
        const int dsh = LAYER == 0 ? 0 : 2 * hg;
        const int rowb = u.pm * 256 + wr * 64 + fr;
        f32x4 c1v[2][2], c2v[2][2]; f32x2_t svc = {0.f, 0.f}, svn = {0.f, 0.f};
        if (LAYER == 1) {
#pragma unroll
            for (int bj = 0; bj < 2; ++bj)
#pragma unroll
                for (int n = 0; n < 2; ++n) { const int cc = u.pn * 256 + bj * 128 + wc * 32 + e0 + 4 * n; c1v[bj][n] = *(const f32x4*)(c1 + cc); c2v[bj][n] = *(const f32x4*)(c2 + cc); }
            svc = *(const f32x2_t*)(st + (size_t)rowb * 2);
        }
#define QKV_AFF(a_, bj_, n_) (LAYER == 1 ? ((a_) - mu * c1v[bj_][n_]) * rstd + c2v[bj_][n_] : (a_))
        if (which < 2) {
            bf16_t* dst = which == 0 ? Q : Kb; const float sc = which == 0 ? QSCALE : 1.f;
            f32x4 ks[2][2];
#pragma unroll
            for (int a = 0; a < 2; ++a)
#pragma unroll
                for (int b = 0; b < 2; ++b) ks[a][b] = (f32x4){0.f, 0.f, 0.f, 0.f};
            f32x4 tc[4], tn[4];
            { const int t = rowb & 8191; tc[0] = *(const f32x4*)(cs + t * 32 + e0); tc[1] = *(const f32x4*)(cs + t * 32 + e0 + 4); tc[2] = *(const f32x4*)(sn + t * 32 + e0); tc[3] = *(const f32x4*)(sn + t * 32 + e0 + 4); }
#pragma unroll
            for (int q = 0; q < 8; ++q) {
                const int ai = q >> 2, m = q & 3;
                const int row = rowb + ai * 128 + m * 16, b = row >> 13, t = row & 8191;
                if (q + 1 < 8) { const int t2 = (rowb + ((q + 1) >> 2) * 128 + ((q + 1) & 3) * 16) & 8191;
                    tn[0] = *(const f32x4*)(cs + t2 * 32 + e0); tn[1] = *(const f32x4*)(cs + t2 * 32 + e0 + 4); tn[2] = *(const f32x4*)(sn + t2 * 32 + e0); tn[3] = *(const f32x4*)(sn + t2 * 32 + e0 + 4);
                    if (LAYER == 1) svn = *(const f32x2_t*)(st + (size_t)(rowb + ((q + 1) >> 2) * 128 + ((q + 1) & 3) * 16) * 2); }
                const int rr = ((t & ((1 << dsh) - 1)) << (13 - dsh)) | (t >> dsh);
                const f32x4 c0 = tc[0], c1_ = tc[1], s0 = tc[2], s1 = tc[3];
                const float mu = LAYER == 1 ? svc.x * (1.0f / DM) : 0.f, rstd = LAYER == 1 ? 1.0f / sqrtf(svc.y * (1.0f / DM) - mu * mu + LN_EPS) : 1.f;
                const f32x4 x1a = QKV_AFF(acc[ai][0][m][0], 0, 0), x1b = QKV_AFF(acc[ai][0][m][1], 0, 1), x2a = QKV_AFF(acc[ai][1][m][0], 1, 0), x2b = QKV_AFF(acc[ai][1][m][1], 1, 1);
                const f32x4 o1a = (x1a * c0 - x2a * s0) * sc, o1b = (x1b * c1_ - x2b * s1) * sc, o2a = (x2a * c0 + x1a * s0) * sc, o2b = (x2b * c1_ + x1b * s1) * sc;
                bf16_t* p = dst + (size_t)(b * 8192 + rr) * PITCH + head * 64 + e0;
                u32x4 w; w.x = pk2(o1a[0], o1a[1]); w.y = pk2(o1a[2], o1a[3]); w.z = pk2(o1b[0], o1b[1]); w.w = pk2(o1b[2], o1b[3]);
                *(u32x4*)p = w;
                w.x = pk2(o2a[0], o2a[1]); w.y = pk2(o2a[2], o2a[3]); w.z = pk2(o2b[0], o2b[1]); w.w = pk2(o2b[2], o2b[3]);
                *(u32x4*)(p + 32) = w;
                if (LAYER == 0 && which == 1) { ks[0][0] += o1a; ks[0][1] += o1b; ks[1][0] += o2a; ks[1][1] += o2b; }
                asm volatile("" ::: "memory");
#pragma unroll
                for (int k = 0; k < 4; ++k) tc[k] = tn[k];
                svc = svn;
            }
            if (LAYER == 0 && which == 1) {
                const int b = u.pm >> 5, blk = u.pm & 31;
                float* kmp = KM + ((size_t)((b * 16 + head) * 32 + blk)) * 64; float kmv = 0.f;
#pragma unroll
                for (int a = 0; a < 2; ++a)
#pragma unroll
                    for (int n = 0; n < 2; ++n)
#pragma unroll
                        for (int i = 0; i < 4; ++i) {
                            float v = ks[a][n][i];
                            v += __shfl_xor(v, 1); v += __shfl_xor(v, 2); v += __shfl_xor(v, 4); v += __shfl_xor(v, 8);
                            if (fr == a * 8 + n * 4 + i) kmv = v;
                        }
                __hip_atomic_fetch_add(kmp + (fr >> 3) * 32 + e0 + (fr & 7), kmv * (1.0f / 256.0f), __ATOMIC_RELAXED, __HIP_MEMORY_SCOPE_AGENT);
            }
        } else {
#pragma unroll
            for (int q = 0; q < 8; ++q) {
                const int ai = q >> 2, m = q & 3;
                const int row = rowb + ai * 128 + m * 16, b = row >> 13, t = row & 8191;
                const int rr = ((t & ((1 << dsh) - 1)) << (13 - dsh)) | (t >> dsh);
                bf16_t* p = VT + ((size_t)(b * NH + head) * 64 + e0) * 8192 + swz16(rr);
                if (LAYER == 1 && q + 1 < 8) svn = *(const f32x2_t*)(st + (size_t)(rowb + ((q + 1) >> 2) * 128 + ((q + 1) & 3) * 16) * 2);
                const float mu = LAYER == 1 ? svc.x * (1.0f / DM) : 0.f, rstd = LAYER == 1 ? 1.0f / sqrtf(svc.y * (1.0f / DM) - mu * mu + LN_EPS) : 1.f;
#pragma unroll
                for (int bj = 0; bj < 2; ++bj)
#pragma unroll
                    for (int n = 0; n < 2; ++n) { const f32x4 yv = QKV_AFF(acc[ai][bj][m][n], bj, n);
#pragma unroll
                        for (int i = 0; i < 4; ++i) p[(size_t)(bj * 32 + 4 * n + i) * 8192] = (bf16_t)(pk2(yv[i], 0.f) & 0xffffu); }
                svc = svn;
            }
        }
#undef QKV_AFF
    }
};
struct EpiSqRelu {
    static constexpr bool PERM = true, AFTER_DRAIN = false;
    bf16_t* O; int ldc; const float* st; const float* c1; const float* c2;
    __device__ __forceinline__ void operator()(const f32x4 (&acc)[2][2][4][2], const Unit& u, int wr, int wc, int fr, int fq) const {
        const int row0 = u.pm * 256 + wr * 64 + fr, col0 = u.pn * 256 + wc * 32 + 8 * fq;
        f32x4 c1v[2][2], c2v[2][2]; float mus[8], rss[8];
#pragma unroll
        for (int bj = 0; bj < 2; ++bj)
#pragma unroll
            for (int n = 0; n < 2; ++n) { c1v[bj][n] = *(const f32x4*)(c1 + col0 + bj * 128 + 4 * n); c2v[bj][n] = *(const f32x4*)(c2 + col0 + bj * 128 + 4 * n); }
#pragma unroll
        for (int q = 0; q < 8; ++q) ROW_STATS(st, row0 + (q >> 2) * 128 + (q & 3) * 16, mus[q], rss[q]);
#pragma unroll
        for (int ai = 0; ai < 2; ++ai)
#pragma unroll
            for (int m = 0; m < 4; ++m) { const int row = row0 + ai * 128 + m * 16; bf16_t* rowp = O + (size_t)row * ldc + col0;
                const float mu = mus[ai * 4 + m], rstd = rss[ai * 4 + m];
#pragma unroll
                for (int bj = 0; bj < 2; ++bj) { f32x4 v0 = (acc[ai][bj][m][0] - mu * c1v[bj][0]) * rstd + c2v[bj][0], v1 = (acc[ai][bj][m][1] - mu * c1v[bj][1]) * rstd + c2v[bj][1];
#pragma unroll
                    for (int i = 0; i < 4; ++i) { const float a = fmaxf(v0[i], 0.f), b = fmaxf(v1[i], 0.f); v0[i] = a * a; v1[i] = b * b; }
                    u32x4 w; w.x = pk2(v0[0], v0[1]); w.y = pk2(v0[2], v0[3]); w.z = pk2(v1[0], v1[1]); w.w = pk2(v1[2], v1[3]);
                    __builtin_nontemporal_store(w, (u32x4*)(rowp + bj * 128)); } }
    }
};
template <int MODE> struct EpiResid {
    static constexpr bool PERM = true, AFTER_DRAIN = false;
    const bf16_t* R; bf16_t* Z; const float* stp; float* stc; const float* g; const float* b;
    __device__ __forceinline__ void operator()(const f32x4 (&acc)[2][2][4][2], const Unit& u, int wr, int wc, int fr, int fq) const {
        const int row0 = u.pm * 256 + wr * 64 + fr, col0 = u.pn * 256 + wc * 32 + 8 * fq;
        const bf16_t* src = MODE == 1 ? (const bf16_t*)Z : R;
        f32x4 gv[2][2], bv[2][2]; f32x2_t svc = {0.f, 0.f}, svn = {0.f, 0.f};
        u32x4 rc[2], rn[2]; float sq[8];
        rc[0] = *(const u32x4*)(src + (size_t)row0 * DM + col0); rc[1] = *(const u32x4*)(src + (size_t)row0 * DM + col0 + 128);
        if (MODE == 1) {
#pragma unroll
            for (int bj = 0; bj < 2; ++bj)
#pragma unroll
                for (int n = 0; n < 2; ++n) { gv[bj][n] = *(const f32x4*)(g + col0 + bj * 128 + 4 * n); bv[bj][n] = *(const f32x4*)(b + col0 + bj * 128 + 4 * n); }
            svc = *(const f32x2_t*)(stp + (size_t)row0 * 2);
        }
#pragma unroll
        for (int q = 0; q < 8; ++q) {
            const int ai = q >> 2, m = q & 3, row = row0 + ai * 128 + m * 16; const size_t off = (size_t)row * DM + col0;
            if (q + 1 < 8) { const int row2 = row0 + ((q + 1) >> 2) * 128 + ((q + 1) & 3) * 16; const size_t off2 = (size_t)row2 * DM + col0; rn[0] = *(const u32x4*)(src + off2); rn[1] = *(const u32x4*)(src + off2 + 128);
                if (MODE == 1) svn = *(const f32x2_t*)(stp + (size_t)row2 * 2); }
            const float mu = MODE == 1 ? svc.x * (1.0f / DM) : 0.f, rstd = MODE == 1 ? 1.0f / sqrtf(svc.y * (1.0f / DM) - mu * mu + LN_EPS) : 1.f;
            float s1 = 0.f, s2 = 0.f;
#pragma unroll
            for (int bj = 0; bj < 2; ++bj) { const u32x4 rv = rc[bj];
                f32x4 h0 = (f32x4){bf_lo(rv.x), bf_hi(rv.x), bf_lo(rv.y), bf_hi(rv.y)}, h1 = (f32x4){bf_lo(rv.z), bf_hi(rv.z), bf_lo(rv.w), bf_hi(rv.w)};
                if (MODE == 1) { h0 = (h0 - mu) * rstd * gv[bj][0] + bv[bj][0]; h1 = (h1 - mu) * rstd * gv[bj][1] + bv[bj][1]; }
                const f32x4 z0 = ALPHA * h0 + acc[ai][bj][m][0], z1 = ALPHA * h1 + acc[ai][bj][m][1];
                u32x4 w; w.x = pk2(z0[0], z0[1]); w.y = pk2(z0[2], z0[3]); w.z = pk2(z1[0], z1[1]); w.w = pk2(z1[2], z1[3]);
                *(u32x4*)(Z + off + bj * 128) = w;
                const float r0 = bf_lo(w.x), r1 = bf_hi(w.x), r2 = bf_lo(w.y), r3 = bf_hi(w.y), r4 = bf_lo(w.z), r5 = bf_hi(w.z), r6 = bf_lo(w.w), r7 = bf_hi(w.w);
                s1 += ((r0 + r1) + (r2 + r3)) + ((r4 + r5) + (r6 + r7));
                s2 += ((r0 * r0 + r1 * r1) + (r2 * r2 + r3 * r3)) + ((r4 * r4 + r5 * r5) + (r6 * r6 + r7 * r7)); }
            s1 += __shfl_xor(s1, 16); s1 += __shfl_xor(s1, 32); s2 += __shfl_xor(s2, 16); s2 += __shfl_xor(s2, 32);
            sq[q] = (fq & 1) ? s2 : s1;
            asm volatile("" ::: "memory");
            rc[0] = rn[0]; rc[1] = rn[1]; svc = svn;
        }
#pragma unroll
        for (int p = 0; p < 4; ++p) {
            const int qa = 2 * p, qb = 2 * p + 1;
            const float val = (fq < 2) ? sq[qa] : sq[qb];
            const int rowp = row0 + ((fq < 2) ? ((qa >> 2) * 128 + (qa & 3) * 16) : ((qb >> 2) * 128 + (qb & 3) * 16));
            __hip_atomic_fetch_add(stc + (size_t)rowp * 2 + (fq & 1), val, __ATOMIC_RELAXED, __HIP_MEMORY_SCOPE_AGENT);
        }
    }
};

template <bool PERMQ, bool SCALED> __device__ __forceinline__ void transpose_item(const float* W, int K, int N, bf16_t* WT, LAS float* scr, int item, int lane, const float* gk, const float* bk, float* c1, float* c2) {
    const int nblk = N / 32, kb = item / nblk, nb = item % nblk, k0 = 64 * kb, n0 = 32 * nb;
    float p1 = 0.f, p2 = 0.f;
#pragma unroll 8
    for (int i = 0; i < 32; ++i) { const int kk = 2 * i + (lane >> 5); float v = __builtin_nontemporal_load(W + (size_t)(k0 + kk) * N + n0 + (lane & 31));
        if (SCALED) { p2 += v * bk[k0 + kk]; v *= gk[k0 + kk]; p1 += bf_lo(pk2(v, 0.f)); }
        scr[kk * 33 + (lane & 31)] = v; }
    LDS_WAIT();
    if (SCALED) { p1 += __shfl_xor(p1, 32); p2 += __shfl_xor(p2, 32);
        if (lane < 32) { const int oc = PERMQ ? qkv_phys(n0 + lane) : (n0 + lane); __hip_atomic_fetch_add(c1 + oc, p1, __ATOMIC_RELAXED, __HIP_MEMORY_SCOPE_AGENT); __hip_atomic_fetch_add(c2 + oc, p2, __ATOMIC_RELAXED, __HIP_MEMORY_SCOPE_AGENT); } }
    const int c = lane & 7;
#pragma unroll
    for (int j = 0; j < 4; ++j) { const int n = (lane >> 3) + 8 * j; const LAS float* sp = scr + (8 * c) * 33 + n;
        u32x4 o; o.x = pk2(sp[0 * 33], sp[1 * 33]); o.y = pk2(sp[2 * 33], sp[3 * 33]); o.z = pk2(sp[4 * 33], sp[5 * 33]); o.w = pk2(sp[6 * 33], sp[7 * 33]);
        const int orow = PERMQ ? qkv_phys(n0 + n) : (n0 + n);
        *(u32x4*)(WT + (size_t)orow * K + k0 + 8 * c) = o; }
    LDS_WAIT();
}

template <bool F32OUT> __device__ __forceinline__ void ln_phase(const bf16_t* Z, const float* g, const float* bt, bf16_t* ob, float* of, int gw, int ngw, int lane) {
    f32x4 gv[4], bv[4];
#pragma unroll
    for (int q = 0; q < 2; ++q) { gv[2 * q] = *(const f32x4*)(g + 512 * q + 8 * lane); gv[2 * q + 1] = *(const f32x4*)(g + 512 * q + 8 * lane + 4);
                                  bv[2 * q] = *(const f32x4*)(bt + 512 * q + 8 * lane); bv[2 * q + 1] = *(const f32x4*)(bt + 512 * q + 8 * lane + 4); }
    for (int row = gw; row < MTOK; row += ngw) {
        const bf16_t* zr = Z + (size_t)row * DM + 8 * lane;
        const u32x4 a = *(const u32x4*)zr, b = *(const u32x4*)(zr + 512);
        float v[16] = {bf_lo(a.x), bf_hi(a.x), bf_lo(a.y), bf_hi(a.y), bf_lo(a.z), bf_hi(a.z), bf_lo(a.w), bf_hi(a.w),
                       bf_lo(b.x), bf_hi(b.x), bf_lo(b.y), bf_hi(b.y), bf_lo(b.z), bf_hi(b.z), bf_lo(b.w), bf_hi(b.w)};
        float s = 0.f;
#pragma unroll
        for (int i = 0; i < 16; ++i) s += v[i];
        const float mean = wave_sum(s) * (1.0f / DM);
        float q = 0.f;
#pragma unroll
        for (int i = 0; i < 16; ++i) { v[i] -= mean; q += v[i] * v[i]; }
        const float rstd = 1.0f / sqrtf(wave_sum(q) * (1.0f / DM) + LN_EPS);
#pragma unroll
        for (int i = 0; i < 16; ++i) v[i] = v[i] * rstd * gv[i >> 2][i & 3] + bv[i >> 2][i & 3];
        if (F32OUT) {
            float* orow = of + (size_t)row * DM + 8 * lane;
            __builtin_nontemporal_store((f32x4){v[0], v[1], v[2], v[3]}, (f32x4*)orow); __builtin_nontemporal_store((f32x4){v[4], v[5], v[6], v[7]}, (f32x4*)(orow + 4));
            __builtin_nontemporal_store((f32x4){v[8], v[9], v[10], v[11]}, (f32x4*)(orow + 512)); __builtin_nontemporal_store((f32x4){v[12], v[13], v[14], v[15]}, (f32x4*)(orow + 516));
        } else {
            bf16_t* orow = ob + (size_t)row * DM + 8 * lane;
            u32x4 w; w.x = pk2(v[0], v[1]); w.y = pk2(v[2], v[3]); w.z = pk2(v[4], v[5]); w.w = pk2(v[6], v[7]); *(u32x4*)orow = w;
            w.x = pk2(v[8], v[9]); w.y = pk2(v[10], v[11]); w.z = pk2(v[12], v[13]); w.w = pk2(v[14], v[15]); *(u32x4*)(orow + 512) = w;
        }
    }
}

constexpr int KPB = 144;
template <int NKT, int MODE, int GT>
__device__ __forceinline__ void attn_rows(const LAS unsigned char* Kl, const LAS unsigned char* Vl, const int vpb, const bf16x8 (&qf)[4], const int r, const int hh, const int p0, const int p1,
                                          f32x16 (&o)[2], float& lse2) {
    constexpr int NG = (NKT + GT - 1) / GT;
    float mrun = -INFINITY, lrun = 0.f;
#pragma unroll
    for (int i = 0; i < 16; ++i) { o[0][i] = 0.f; o[1][i] = 0.f; }
#pragma unroll
    for (int grp = 0; grp < NG; ++grp) {
        constexpr int dummy = 0; (void)dummy;
        const int kt0 = grp * GT;
        const int nt = (NKT - kt0) < GT ? (NKT - kt0) : GT;
        const bool gact = MODE == 0 ? true : (MODE == 1 ? (kt0 <= p0) : (p1 != 0 || (p0 + kt0 + nt - 1 >= 4)));
        if (gact) {
            bf16x8 kf[GT][4];
#pragma unroll
            for (int q = 0; q < GT; ++q)
#pragma unroll
                for (int ks = 0; ks < 4; ++ks) if (q < nt) kf[q][ks] = *(const LAS bf16x8*)(Kl + ((kt0 + q) * 32 + r) * KPB + ks * 32 + hh * 16);
            f32x16 s[GT];
#pragma unroll
            for (int q = 0; q < GT; ++q)
#pragma unroll
                for (int i = 0; i < 16; ++i) s[q][i] = 0.f;
#pragma unroll
            for (int ks = 0; ks < 4; ++ks)
#pragma unroll
                for (int q = 0; q < GT; ++q) if (q < nt) s[q] = MFMA32(kf[q][ks], qf[ks], s[q]);
            bf16x8 vf[GT][2][2];
#pragma unroll
            for (int q = 0; q < GT; ++q)
#pragma unroll
                for (int s2 = 0; s2 < 2; ++s2)
#pragma unroll
                    for (int dt = 0; dt < 2; ++dt) if (q < nt) vf[q][s2][dt] = *(const LAS bf16x8*)(Vl + (dt * 32 + r) * vpb + ((kt0 + q) * 32 + s2 * 16 + hh * 8) * 2);
            if (MODE == 1) { if (p0 < 8) {
#pragma unroll
                for (int q = 0; q < GT; ++q) if (q < nt) { const int lim = (p0 - (kt0 + q)) * 32 + r;
#pragma unroll
                    for (int i = 0; i < 16; ++i) if (crow(i, hh) > lim) s[q][i] = -INFINITY; } } }
            if (MODE == 2) {
#pragma unroll
                for (int q = 0; q < GT; ++q) if (q < nt) { const int kt = kt0 + q;
                    if (kt == 0) {
#pragma unroll
                        for (int i = 0; i < 16; ++i) if (crow(i, hh) < r) s[q][i] = -INFINITY; }
                    if (kt == NKT - 1) {
#pragma unroll
                        for (int i = 0; i < 16; ++i) if (crow(i, hh) > r) s[q][i] = -INFINITY; } }
                if (p1 == 0) {
#pragma unroll
                    for (int q = 0; q < GT; ++q) if (q < nt) { if (p0 + kt0 + q < 4) {
#pragma unroll
                        for (int i = 0; i < 16; ++i) s[q][i] = -INFINITY; } } }
            }
            float mx = -INFINITY;
#pragma unroll
            for (int q = 0; q < GT; ++q) if (q < nt) {
#pragma unroll
                for (int i = 0; i < 16; ++i) mx = fmaxf(mx, s[q][i]); }
            mx = fmaxf(mx, __shfl_xor(mx, 32));
            const float mnew = fmaxf(mrun, mx);
            const float sc = __builtin_amdgcn_exp2f(mrun - mnew);
            mrun = mnew; lrun *= sc;
            if (grp > 0) {
#pragma unroll
                for (int i = 0; i < 16; ++i) { o[0][i] *= sc; o[1][i] *= sc; }
            }
#pragma unroll
            for (int q = 0; q < GT; ++q) if (q < nt) {
#pragma unroll
                for (int i = 0; i < 16; ++i) { const float p = __builtin_amdgcn_exp2f(s[q][i] - mnew); s[q][i] = p; lrun += p; }
#pragma unroll
                for (int s2 = 0; s2 < 2; ++s2) {
                    u32x4 pw; pw.x = pk2(s[q][8 * s2], s[q][8 * s2 + 1]); pw.y = pk2(s[q][8 * s2 + 2], s[q][8 * s2 + 3]); pw.z = pk2(s[q][8 * s2 + 4], s[q][8 * s2 + 5]); pw.w = pk2(s[q][8 * s2 + 6], s[q][8 * s2 + 7]);
                    const bf16x8 pf = __builtin_bit_cast(bf16x8, pw);
#pragma unroll
                    for (int dt = 0; dt < 2; ++dt) o[dt] = MFMA32(vf[q][s2][dt], pf, o[dt]);
                }
            }
        }
    }
    const float l = lrun + __shfl_xor(lrun, 32);
    const float inv = 1.0f / l;
#pragma unroll
    for (int i = 0; i < 16; ++i) { o[0][i] *= inv; o[1][i] *= inv; }
    lse2 = mrun + __builtin_amdgcn_logf(l);
}
__device__ __forceinline__ void store_o(bf16_t* dst, const f32x16 (&o)[2], int hh) {
#pragma unroll
    for (int dt = 0; dt < 2; ++dt)
#pragma unroll
        for (int g4 = 0; g4 < 4; ++g4) { u32x2 w; w.x = pk2(o[dt][4 * g4], o[dt][4 * g4 + 1]); w.y = pk2(o[dt][4 * g4 + 2], o[dt][4 * g4 + 3]); *(u32x2*)(dst + dt * 32 + 8 * g4 + 4 * hh) = w; }
}

constexpr int STG_PITCH = 144, STG_WAVE = 32 * STG_PITCH;
__device__ __forceinline__ void stage_o(LAS unsigned char* stg, const f32x16 (&o)[2], int r, int hh) {
#pragma unroll
    for (int dt = 0; dt < 2; ++dt)
#pragma unroll
        for (int g4 = 0; g4 < 4; ++g4) { u32x2 w; w.x = pk2(o[dt][4 * g4], o[dt][4 * g4 + 1]); w.y = pk2(o[dt][4 * g4 + 2], o[dt][4 * g4 + 3]); *(LAS u32x2*)(stg + r * STG_PITCH + dt * 64 + g4 * 16 + hh * 8) = w; }
    LDS_WAIT();
}
constexpr int STG8_PITCH = 80; constexpr float PO8_SCALE = 16.0f;
__device__ __forceinline__ void stage_o8(LAS unsigned char* stg, const f32x16 (&o)[2], int r, int hh) {
#pragma unroll
    for (int dt = 0; dt < 2; ++dt)
#pragma unroll
        for (int g4 = 0; g4 < 4; ++g4) {
            int w = __builtin_amdgcn_cvt_pk_fp8_f32(o[dt][4 * g4] * PO8_SCALE, o[dt][4 * g4 + 1] * PO8_SCALE, 0, false);
            w = __builtin_amdgcn_cvt_pk_fp8_f32(o[dt][4 * g4 + 2] * PO8_SCALE, o[dt][4 * g4 + 3] * PO8_SCALE, w, true);
            *(LAS int*)(stg + r * STG8_PITCH + dt * 32 + g4 * 8 + hh * 4) = w; }
    LDS_WAIT();
}
#define XB_TMO      128
#define XB_XCNT(j)  (256  + 64 * (j))
#define XB_XSUB(j)  (1280 + 64 * (j))
#define XB_XGEN(j)  (2304 + 64 * (j))
#define XB_TOP      3328
#define XB_TOPGEN   3392
#define XCD_BAR_WORDS 3456
#define XB_SPIN_CAP (1u << 18)

__device__ __forceinline__ unsigned xb_ld(unsigned* p)              { return __hip_atomic_load(p, __ATOMIC_RELAXED, __HIP_MEMORY_SCOPE_AGENT); }
__device__ __forceinline__ unsigned xb_add(unsigned* p, unsigned v) { return __hip_atomic_fetch_add(p, v, __ATOMIC_RELAXED, __HIP_MEMORY_SCOPE_AGENT); }
__device__ __forceinline__ unsigned xb_xcc_id() { return (unsigned)__builtin_amdgcn_s_getreg((3 << 11) | 20) & 0xFu; }
#define XB_SPIN(cond, bar) do { unsigned _sp = 0; while (cond) { __builtin_amdgcn_s_sleep(1); \
    if ((++_sp & 255u) == 0u) { if (xb_ld(&(bar)[XB_TMO])) break; if (_sp > XB_SPIN_CAP) { atomicAdd(&(bar)[XB_TMO], 1u); break; } } } } while (0)

struct XcdBarrier {
    unsigned* bar; unsigned x;
    volatile LAS unsigned* st;
};

__device__ __forceinline__ XcdBarrier xcd_barrier_post(unsigned* bar, volatile LAS unsigned* st) {
    XcdBarrier b; b.bar = bar; b.x = xb_xcc_id(); b.st = st;
    if (threadIdx.x == 0) (void)xb_add(&bar[XB_XCNT(b.x)], 1u);
    return b;
}
__device__ __forceinline__ void xcd_barrier_complete(unsigned* bar, unsigned x, unsigned& nloc, unsigned& nx) {
    const unsigned G = gridDim.x * gridDim.y * gridDim.z;
    unsigned sum, cnt, mine, sp = 0u;
    for (;;) {
        sum = 0u; cnt = 0u; mine = 0u;
#pragma unroll
        for (unsigned j = 0; j < 16; ++j) { const unsigned c = xb_ld(&bar[XB_XCNT(j)]); sum += c; cnt += (c > 0u) ? 1u : 0u; mine = (j == x) ? c : mine; }
        if (sum == G) break;
        __builtin_amdgcn_s_sleep(1);
        if ((++sp & 255u) == 0u) { if (xb_ld(&bar[XB_TMO])) break; if (sp > XB_SPIN_CAP) { atomicAdd(&bar[XB_TMO], 1u); break; } }
    }
    nloc = mine > 0u ? mine : 1u; nx = cnt > 0u ? cnt : 1u;
}

__device__ __forceinline__ void xcd_barrier(const XcdBarrier& b) {
    asm volatile("s_waitcnt vmcnt(0)" ::: "memory");
    __syncthreads();
    if (threadIdx.x == 0) {
        unsigned* bar = b.bar;
        __builtin_amdgcn_s_waitcnt(0);
        unsigned nloc = b.st[0], nx = b.st[1];
        if (nloc == 0u) { xcd_barrier_complete(bar, b.x, nloc, nx); b.st[0] = nloc; b.st[1] = nx; }
        const unsigned old = xb_add(&bar[XB_XSUB(b.x)], 1u);
        const unsigned gen = old / nloc;
        if (old + 1u == (gen + 1u) * nloc) {
            __builtin_amdgcn_fence(__ATOMIC_RELEASE, "agent");
            asm volatile("s_waitcnt vmcnt(0)" ::: "memory");
            const unsigned og = xb_add(&bar[XB_TOP], 1u);
            const unsigned tg = og / nx;
            if (og + 1u == (tg + 1u) * nx) xb_add(&bar[XB_TOPGEN], 1u);
            else XB_SPIN(xb_ld(&bar[XB_TOPGEN]) == tg, bar);
            __builtin_amdgcn_fence(__ATOMIC_ACQUIRE, "agent");
            xb_add(&bar[XB_XGEN(b.x)], 1u);
            asm volatile("s_waitcnt vmcnt(0)" ::: "memory");
        } else {
            XB_SPIN(xb_ld(&bar[XB_XGEN(b.x)]) == gen, bar);
            __builtin_amdgcn_fence(__ATOMIC_ACQUIRE, "agent");
            asm volatile("s_waitcnt vmcnt(0)" ::: "memory");
        }
    }
    __syncthreads();
}

struct Args { const float* in[11]; float* out; unsigned char* ws; int pad0, pad1; };

__global__ void __launch_bounds__(NTHR) hybrid_fwd(Args args) {
    extern __shared__ __attribute__((aligned(16))) unsigned char lds_raw[];
    LAS unsigned char* lds = (LAS unsigned char*)lds_raw;
    cg::grid_group grid = cg::this_grid();
    int tid = threadIdx.x, lane = tid & 63, wave = __builtin_amdgcn_readfirstlane(tid >> 6);
    const int G = gridDim.x, ngw = G * NWAVES; int gw = blockIdx.x * NWAVES + wave;
#define GRID_SYNC_CG() do { grid.sync(); asm volatile("" : "+v"(tid), "+v"(lane)); } while (0)
#define GRID_SYNC() do { xcd_barrier(xbar); asm volatile("" : "+v"(tid), "+v"(lane)); } while (0)
    if (tid < 2) ((LAS unsigned*)(lds + LDS_MISC + 256))[tid] = 0u;
    __syncthreads();
    const XcdBarrier xbar = xcd_barrier_post((unsigned*)(args.ws + WS_BAR), (volatile LAS unsigned*)(lds + LDS_MISC + 256));
    unsigned char* ws = args.ws;
    const float* x = args.in[0];
    bf16_t* Wqkv0 = (bf16_t*)(ws + WS_WQKV0); bf16_t* Wo0 = (bf16_t*)(ws + WS_WO0); bf16_t* Wqkv1 = (bf16_t*)(ws + WS_WQKV1); bf16_t* Wo1 = (bf16_t*)(ws + WS_WO1);
    float* cosT = (float*)(ws + WS_COS); float* sinT = (float*)(ws + WS_SIN);
    bf16_t* HB = (bf16_t*)(ws + WS_HB); bf16_t* Zb = (bf16_t*)(ws + WS_Z); bf16_t* Hm = (bf16_t*)(ws + WS_H);
    float* C1 = (float*)(ws + WS_C12); float* C2 = C1 + NC12; float* ST = (float*)(ws + WS_ST);
    unsigned* gcnt = (unsigned*)(ws + WS_CTL); float* KM = (float*)(ws + WS_KM);
    unsigned* LIST = (unsigned*)((unsigned char*)args.out + OUT_LIST); bf16_t* PO3 = (bf16_t*)((unsigned char*)args.out + OUT_PO3);

    if (PHM & 1u) {
        LAS float* scr = (LAS float*)(lds + wave * 16384);
        constexpr int I_QKV0 = (DM / 64) * (NQKV0 / 32), I_WO0 = (DM / 64) * (DM / 32), I_QKV1 = (DM / 64) * (NQKV1 / 32), I_WO1 = (D1 / 64) * (DM / 32), I_IN = (DM / 64) * (FF / 32), I_OUT = (FF / 64) * (DM / 32);
        constexpr int NITEMS = I_QKV0 + I_WO0 + I_QKV1 + I_WO1 + 2 * I_IN + 2 * I_OUT;
        for (int it = gw; it < NITEMS; it += ngw) {
            int rI = it;
            if (rI < I_QKV0) { transpose_item<true, false>(args.in[1], DM, NQKV0, Wqkv0, scr, rI, lane, nullptr, nullptr, nullptr, nullptr); continue; } rI -= I_QKV0;
            if (rI < I_WO0) { transpose_item<false, false>(args.in[2], DM, DM, Wo0, scr, rI, lane, nullptr, nullptr, nullptr, nullptr); continue; } rI -= I_WO0;
            if (rI < I_QKV1) { transpose_item<true, true>(args.in[3], DM, NQKV1, Wqkv1, scr, rI, lane, args.in[9], args.in[10], C1 + C_QKV1, C2 + C_QKV1); continue; } rI -= I_QKV1;
            if (rI < I_WO1) { transpose_item<false, false>(args.in[4], D1, DM, Wo1, scr, rI, lane, nullptr, nullptr, nullptr, nullptr); continue; } rI -= I_WO1;
            if (rI < 2 * I_IN) { const int l = rI / I_IN; transpose_item<false, true>(args.in[5] + (size_t)l * DM * FF, DM, FF, (bf16_t*)(ws + (l ? WS_WIN1 : WS_WIN0)), scr, rI - l * I_IN, lane, args.in[7] + l * DM, args.in[8] + l * DM, C1 + (l ? C_WIN1 : C_WIN0), C2 + (l ? C_WIN1 : C_WIN0)); continue; } rI -= 2 * I_IN;
            { const int l = rI / I_OUT; transpose_item<false, false>(args.in[6] + (size_t)l * DM * FF, FF, DM, (bf16_t*)(ws + (l ? WS_WOUT1 : WS_WOUT0)), scr, rI - l * I_OUT, lane, nullptr, nullptr, nullptr, nullptr); }
        }
        for (int idx = blockIdx.x * NTHR + tid; idx < SEQ * 32; idx += G * NTHR) {
            const int t = idx >> 5, e = idx & 31;
            const float inv = 1.0f / powf(10000.0f, (float)(2 * e) / 64.0f);
            const float ang = (float)t * inv;
            const double a = (double)ang, kk = rint(a * 0.15915494309189535), rd = fma(-kk, 6.283185307179586, a);
            const float rf = (float)rd;
            cosT[idx] = cosf(rf); sinT[idx] = sinf(rf);
        }
        for (int row = gw; row < MTOK; row += ngw) {
            const float* xr = x + (size_t)row * DM + 8 * lane;
            const f32x4 a0 = __builtin_nontemporal_load((const f32x4*)xr), a1 = __builtin_nontemporal_load((const f32x4*)(xr + 4)), b0 = __builtin_nontemporal_load((const f32x4*)(xr + 512)), b1 = __builtin_nontemporal_load((const f32x4*)(xr + 516));
            bf16_t* orow = HB + (size_t)row * DM + 8 * lane;
            u32x4 w; w.x = pk2(a0[0], a0[1]); w.y = pk2(a0[2], a0[3]); w.z = pk2(a1[0], a1[1]); w.w = pk2(a1[2], a1[3]); *(u32x4*)orow = w;
            w.x = pk2(b0[0], b0[1]); w.y = pk2(b0[2], b0[3]); w.z = pk2(b1[0], b1[1]); w.w = pk2(b1[2], b1[3]); *(u32x4*)(orow + 512) = w;
        }
    }
    __syncthreads();
    if (args.pad1 != 0) GRID_SYNC_CG();
    GRID_SYNC();

    bf16_t* Q0 = (bf16_t*)(ws + WS_Q); bf16_t* K0 = (bf16_t*)(ws + WS_K); bf16_t* VT0 = (bf16_t*)(ws + WS_VT); bf16_t* PO = (bf16_t*)(ws + WS_PO); float* PL = (float*)(ws + WS_PL);
    if (PHM & 2u) {
        pg8::Gemm g{HB, Wqkv0, MTOK, NQKV0, DM}; pg8::StaticOrder S; S.init(MTOK, NQKV0, G, (int)blockIdx.x);
        EpiQKV<0> E{Q0, K0, VT0, KM, cosT, sinT, nullptr, nullptr, nullptr};
        for (int repg = 0; repg < DUPG * DUPQ0; ++repg) pg8::gemm_phase<EpiQKV<0>, pg8::StaticOrder, G_ALIGN, G_SP2>(lds, g, S, E);
    }
    GRID_SYNC();
    if (PHM & 4u) {
        LAS unsigned* lcnt = (LAS unsigned*)(lds + LDS_MISC); LAS unsigned* lbase = lcnt + 32;
        const int r = lane & 31, hh = lane >> 5;
        for (int unit = blockIdx.x; unit < BATCH * 32 * 16; unit += G) {
            const int h = unit & 15, qb = (unit >> 4) & 31, b = unit >> 9;
            if (tid < 32) lcnt[tid] = 0u;
            __syncthreads();
            const int tq = qb * 256 + wave * 32 + r, token = b * 8192 + tq;
            bf16x8 qf[4];
#pragma unroll
            for (int ks = 0; ks < 4; ++ks) qf[ks] = *(const bf16x8*)(Q0 + (size_t)token * DM + h * 64 + ks * 16 + hh * 8);
            f32x16 gt;
#pragma unroll
            for (int i = 0; i < 16; ++i) gt[i] = 0.f;
            const float* kmr = KM + ((size_t)((b * 16 + h) * 32 + r)) * 64 + hh * 8;
#pragma unroll
            for (int ks = 0; ks < 4; ++ks) { const f32x4 k0 = *(const f32x4*)(kmr + ks * 16), k1 = *(const f32x4*)(kmr + ks * 16 + 4);
                u32x4 kw; kw.x = pk2(k0[0], k0[1]); kw.y = pk2(k0[2], k0[3]); kw.z = pk2(k1[0], k1[1]); kw.w = pk2(k1[2], k1[3]);
                gt = MFMA32(__builtin_bit_cast(bf16x8, kw), qf[ks], gt); }
            float v0 = -3.0e38f, v1 = -3.0e38f, v2 = -3.0e38f;
#define TOP_INS(val) do { float t_ = (val); const float a_ = fmaxf(v0, t_); t_ = fminf(v0, t_); v0 = a_; const float b_ = fmaxf(v1, t_); t_ = fminf(v1, t_); v1 = b_; v2 = fmaxf(v2, t_); } while (0)
#pragma unroll
            for (int i = 0; i < 16; ++i) { const int j = crow(i, hh); const float gv_ = j < qb ? gt[i] : -3.0e38f; TOP_INS(__uint_as_float((__float_as_uint(gv_) & ~31u) | (unsigned)j)); }
            { const float pv0 = __shfl_xor(v0, 32), pv1 = __shfl_xor(v1, 32), pv2 = __shfl_xor(v2, 32); TOP_INS(pv0); TOP_INS(pv1); TOP_INS(pv2); }
#undef TOP_INS
            const int i0 = (int)(__float_as_uint(v0) & 31u), i1 = (int)(__float_as_uint(v1) & 31u), i2 = (int)(__float_as_uint(v2) & 31u);
            const int nvalid = qb < 3 ? qb : 3;
            unsigned lp0 = 0, lp1 = 0, lp2 = 0;
            if (hh == 0) {
                if (0 < nvalid) lp0 = __hip_atomic_fetch_add(lcnt + i0, 1u, __ATOMIC_RELAXED, __HIP_MEMORY_SCOPE_WORKGROUP); else PL[((size_t)0 * MTOK + token) * 16 + h] = -INFINITY;
                if (1 < nvalid) lp1 = __hip_atomic_fetch_add(lcnt + i1, 1u, __ATOMIC_RELAXED, __HIP_MEMORY_SCOPE_WORKGROUP); else PL[((size_t)1 * MTOK + token) * 16 + h] = -INFINITY;
                if (2 < nvalid) lp2 = __hip_atomic_fetch_add(lcnt + i2, 1u, __ATOMIC_RELAXED, __HIP_MEMORY_SCOPE_WORKGROUP); else PL[((size_t)2 * MTOK + token) * 16 + h] = -INFINITY;
            }
            __syncthreads();
            if (tid < 32) { const unsigned c = lcnt[tid]; lbase[tid] = c ? __hip_atomic_fetch_add(gcnt + (b * 16 + h) * 32 + tid, c, __ATOMIC_RELAXED, __HIP_MEMORY_SCOPE_AGENT) : 0u; }
            __syncthreads();
            if (hh == 0) {
                unsigned* lst = LIST + (size_t)(b * 16 + h) * LIST_CAP;
                if (0 < nvalid) lst[256 * (31 * i0 - (i0 * (i0 - 1)) / 2) + lbase[i0] + lp0] = (unsigned)tq | (0u << 13);
                if (1 < nvalid) lst[256 * (31 * i1 - (i1 * (i1 - 1)) / 2) + lbase[i1] + lp1] = (unsigned)tq | (1u << 13);
                if (2 < nvalid) lst[256 * (31 * i2 - (i2 * (i2 - 1)) / 2) + lbase[i2] + lp2] = (unsigned)tq | (2u << 13);
            }
        }
    }
    __syncthreads();
    GRID_SYNC();
#ifndef DUP3
#define DUP3 1
#endif
#ifndef DUP10
#define DUP10 1
#endif
    for (int rep3 = 0; rep3 < DUP3; ++rep3) {
        const LAS unsigned char* Kl = lds; const LAS unsigned char* Vl = lds + 256 * KPB; constexpr int VPB = (256 + 8) * 2;
        const int r = lane & 31, hh = lane >> 5;
        bf16_t* dump = (bf16_t*)(ws + WS_DUMP) + (size_t)((blockIdx.x & 255) * NWAVES + wave) * 2048;
        u32x4 kreg[4], vreg[4];
#define P3_LOADKV(b_, h_, j_) do { _Pragma("unroll") for (int i = 0; i < 4; ++i) { const int c = tid + NTHR * i; \
            kreg[i] = __builtin_nontemporal_load((const u32x4*)(K0 + (size_t)((b_) * 8192 + (j_) * 256 + (c >> 3)) * DM + (h_) * 64 + (c & 7) * 8)); \
            vreg[i] = __builtin_nontemporal_load((const u32x4*)(VT0 + ((size_t)((b_) * 16 + (h_)) * 64 + (c >> 5)) * 8192 + (j_) * 256 + (c & 31) * 8)); } } while (0)
        LAS int* sh_n = (LAS int*)(lds + LDS_MISC + 512); LAS int* sh_order = sh_n + 32; LAS int* sh_myj = sh_order + 32; LAS int* sh_cnt = sh_myj + 32;
      for (int v = blockIdx.x; v < 256; v += G) {
        const int bh = (v & 7) * 8 + (v >> 5), q4 = (v >> 3) & 3, b = bh >> 4, h = bh & 15;
        __syncthreads();
        if (tid < 32) sh_n[tid] = 256 + (int)gcnt[bh * 32 + tid] + 128;
        __syncthreads();
        if (tid < 32) { const int nj = sh_n[tid]; int rank = 0;
            for (int i = 0; i < 32; ++i) { const int ni = sh_n[i]; rank += (ni > nj || (ni == nj && i < tid)) ? 1 : 0; }
            sh_order[rank] = tid; }
        __syncthreads();
        if (tid == 0) { int l0 = 0, l1 = 0, l2 = 0, l3 = 0, cnt = 0;
            for (int k = 0; k < 32; ++k) { const int jx = sh_order[k], w = sh_n[jx];
                int bin = 0, lm = l0; if (l1 < lm) { lm = l1; bin = 1; } if (l2 < lm) { lm = l2; bin = 2; } if (l3 < lm) { lm = l3; bin = 3; }
                l0 += bin == 0 ? w : 0; l1 += bin == 1 ? w : 0; l2 += bin == 2 ? w : 0; l3 += bin == 3 ? w : 0;
                if (bin == q4) { sh_myj[cnt] = jx; ++cnt; } }
            sh_cnt[0] = cnt; }
        __syncthreads();
        const int nit = sh_cnt[0];
        const bf16_t* Qbh = Q0 + (size_t)b * 8192 * DM + h * 64 + hh * 8;
        bf16x8 qf[4];
        if (nit > 0) { const int j0 = sh_myj[0]; P3_LOADKV(b, h, j0);
#pragma unroll
            for (int ks = 0; ks < 4; ++ks) qf[ks] = *(const bf16x8*)(Qbh + (size_t)(j0 * 256 + wave * 32 + r) * DM + ks * 16); }
#define RAW_BARRIER() do { asm volatile("s_waitcnt lgkmcnt(0)" ::: "memory"); __builtin_amdgcn_s_barrier(); asm volatile("" ::: "memory"); } while (0)
        for (int it = 0; it < nit; ++it) {
            const int j = sh_myj[it], jn = (it + 1 < nit) ? sh_myj[it + 1] : -1;
            RAW_BARRIER();
#pragma unroll
            for (int i = 0; i < 4; ++i) { const int c = tid + NTHR * i;
                *(LAS u32x4*)(lds + (c >> 3) * KPB + (c & 7) * 16) = kreg[i];
                *(LAS u32x4*)(lds + 256 * KPB + (c >> 5) * VPB + (c & 31) * 16) = vreg[i]; }
            RAW_BARRIER();
            if (jn >= 0) P3_LOADKV(b, h, jn);
#ifdef P3_PROBE_OWNONLY
            const int n = (rep3 + 1 < DUP3) ? 256 : 256 + (int)gcnt[bh * 32 + j], ngroups = (n + 31) >> 5;
#else
            const int n = 256 + (int)gcnt[bh * 32 + j], ngroups = (n + 31) >> 5;
#endif
            const unsigned* lst = LIST + (size_t)bh * LIST_CAP + 256 * (31 * j - (j * (j - 1)) / 2);
            int g = wave;
            int tq = j * 256 + g * 32 + r, slot = 3; bool valid = true;
            const int tqN = (jn >= 0 ? jn : j) * 256 + wave * 32 + r;
            unsigned en = 0u; bool vn = false;
            if (g + 8 < ngroups) { const int row = (g + 8) * 32 + r; vn = row < n; en = lst[vn ? row - 256 : 0]; }
            for (; g < ngroups; g += NWAVES) {
                bf16x8 q1[4]; int tq1 = tqN, slot1 = 3; unsigned en2 = 0u; bool vn2 = false;
                if (g + 8 < ngroups) { tq1 = (int)(en & 8191u); slot1 = (int)(en >> 13); }
#pragma unroll
                for (int ks = 0; ks < 4; ++ks) q1[ks] = *(const bf16x8*)(Qbh + (size_t)tq1 * DM + ks * 16);
                if (g + 16 < ngroups) { const int row = (g + 16) * 32 + r; vn2 = row < n; en2 = lst[vn2 ? row - 256 : 0]; }
                f32x16 o[2]; float lse2;
                attn_rows<8, 1, 2>(Kl, Vl, VPB, qf, r, hh, g < 8 ? g : 99, 0, o, lse2);
                {
                    LAS unsigned char* stg = lds + 73728 + wave * STG_WAVE;
                    stage_o8(stg, o, r, hh);
                    const int myinfo = tq | (slot << 13) | (valid ? (1 << 15) : 0);
                    {
                        const int R = lane >> 1, half = lane & 1;
                        const u32x4 v0 = *(const LAS u32x4*)(stg + R * STG8_PITCH + half * 32), v1 = *(const LAS u32x4*)(stg + R * STG8_PITCH + half * 32 + 16);
                        const int info = __shfl(myinfo, R), tqR = info & 8191, slotR = (info >> 13) & 3;
                        unsigned char* dstp = (slotR == 3 ? (unsigned char*)PO3 : (unsigned char*)PO + (size_t)slotR * MTOK * DM) + ((size_t)b * 8192 + tqR) * DM + h * 64 + half * 32;
                        if (!(info & (1 << 15))) dstp = (unsigned char*)dump + lane * 32;
                        __builtin_nontemporal_store(v0, (u32x4*)dstp); __builtin_nontemporal_store(v1, (u32x4*)(dstp + 16));
                    }
                    { float* plp = PL + ((size_t)slot * MTOK + (size_t)b * 8192 + tq) * 16 + h; if (!valid) plp = (float*)(dump + 1024) + lane; *plp = lse2; }
                }
#pragma unroll
                for (int ks = 0; ks < 4; ++ks) qf[ks] = q1[ks];
                tq = tq1; slot = slot1; valid = vn; en = en2; vn = vn2;
            }
        }
      }
#undef P3_LOADKV
#undef RAW_BARRIER
    }
    __syncthreads();
    GRID_SYNC();
    if (PHM & 16u) {
        const int head = lane >> 2, part = lane & 3;
        for (int token = gw; token < MTOK; token += ngw) {
            float ls[4], mxl = -INFINITY;
#pragma unroll
            for (int s = 0; s < 4; ++s) { ls[s] = PL[((size_t)s * MTOK + token) * 16 + head]; mxl = fmaxf(mxl, ls[s]); }
            float accv[16], den = 0.f;
#pragma unroll
            for (int i = 0; i < 16; ++i) accv[i] = 0.f;
#pragma unroll
            for (int s = 0; s < 4; ++s) {
                const float w = __builtin_amdgcn_exp2f(ls[s] - mxl);
                if (w > 0.f) {
                    den += w;
                    const unsigned char* src = (s == 3 ? (const unsigned char*)PO3 : (const unsigned char*)PO + (size_t)s * MTOK * DM) + (size_t)token * DM + head * 64 + part * 16;
                    const u32x4 a = *(const u32x4*)src;
                    const float ws_ = w * (1.0f / PO8_SCALE);
#pragma unroll
                    for (int k = 0; k < 4; ++k) { const f32x2_t lo = __builtin_amdgcn_cvt_pk_f32_fp8((int)a[k], false), hi = __builtin_amdgcn_cvt_pk_f32_fp8((int)a[k], true);
                        accv[4 * k] += ws_ * lo.x; accv[4 * k + 1] += ws_ * lo.y; accv[4 * k + 2] += ws_ * hi.x; accv[4 * k + 3] += ws_ * hi.y; }
                }
            }
            const float inv = 1.0f / den;
            bf16_t* dst = Q0 + (size_t)token * DM + head * 64 + part * 16;
            u32x4 w0, w1;
            w0.x = pk2(accv[0] * inv, accv[1] * inv); w0.y = pk2(accv[2] * inv, accv[3] * inv); w0.z = pk2(accv[4] * inv, accv[5] * inv); w0.w = pk2(accv[6] * inv, accv[7] * inv);
            w1.x = pk2(accv[8] * inv, accv[9] * inv); w1.y = pk2(accv[10] * inv, accv[11] * inv); w1.z = pk2(accv[12] * inv, accv[13] * inv); w1.w = pk2(accv[14] * inv, accv[15] * inv);
            *(u32x4*)dst = w0; *(u32x4*)(dst + 8) = w1;
        }
    }
    GRID_SYNC();
    if (PHM & 32u) {
        pg8::Gemm g{Q0, Wo0, MTOK, DM, DM}; pg8::StaticOrder S; S.init(MTOK, DM, G, (int)blockIdx.x);
        EpiResid<0> E{HB, Zb, nullptr, ST, nullptr, nullptr};
        for (int repg = 0; repg < DUPG; ++repg) pg8::gemm_phase<EpiResid<0>, pg8::StaticOrder, G_ALIGN, G_SP2>(lds, g, S, E);
    }
    GRID_SYNC();
    if (PHM & 64u) {
        pg8::Gemm g{Zb, (const bf16_t*)(ws + WS_WIN0), MTOK, FF, DM}; pg8::StaticOrder S; S.init(MTOK, FF, G, (int)blockIdx.x);
        EpiSqRelu E{Hm, FF, ST, C1 + C_WIN0, C2 + C_WIN0};
        for (int repg = 0; repg < DUPG * DUPU; ++repg) pg8::gemm_phase<EpiSqRelu, pg8::StaticOrder, G_ALIGN, G_SP2>(lds, g, S, E);
    }
    GRID_SYNC();
    {
        pg8::Gemm g{Hm, (const bf16_t*)(ws + WS_WOUT0), MTOK, DM, FF}; pg8::StaticOrder S; S.init(MTOK, DM, G, (int)blockIdx.x);
        EpiResid<1> E{nullptr, Zb, ST, ST + 2 * MTOK, args.in[7], args.in[8]};
        for (int repg = 0; repg < DUPG; ++repg) pg8::gemm_phase<EpiResid<1>, pg8::StaticOrder, G_ALIGN, G_SP2>(lds, g, S, E);
    }
    GRID_SYNC();

    bf16_t* Q1 = (bf16_t*)(ws + WS_Q1); bf16_t* K1 = (bf16_t*)(ws + WS_K1); bf16_t* VT1 = (bf16_t*)(ws + WS_VT1); bf16_t* PO1 = (bf16_t*)(ws + WS_PO1); float* PL1 = (float*)(ws + WS_PL1);
    if (PHM & 128u) {
        pg8::Gemm g{Zb, Wqkv1, MTOK, NQKV1, DM}; pg8::StaticOrder S; S.init(MTOK, NQKV1, G, (int)blockIdx.x);
        EpiQKV<1> E{Q1, K1, VT1, nullptr, cosT, sinT, ST + 2 * MTOK, C1 + C_QKV1, C2 + C_QKV1};
        for (int repg = 0; repg < DUPG * DUPQ1; ++repg) pg8::gemm_phase<EpiQKV<1>, pg8::StaticOrder, G_ALIGN, G_SP2>(lds, g, S, E);
    }
    GRID_SYNC();
    for (int rep10 = 0; rep10 < DUP10; ++rep10) {
        constexpr int VPB = (384 + 8) * 2; const int r = lane & 31, hh = lane >> 5;
        u32x4 kreg[6], vreg[6];
#define P10_DECODE(unit_, pp_, head_, b_, dsh_, gb_, hp_) const int pp_ = (unit_) & 31, head_ = ((unit_) >> 5) % 12, b_ = (unit_) / (32 * 12), dsh_ = 2 * (head_ >> 2), gb_ = 2 * pp_, hp_ = ((gb_ & ((64 >> dsh_) - 1)) != 0) ? 1 : 0
#define P10_LOAD(b_, head_, gb_, hp_) do { _Pragma("unroll") for (int i = 0; i < 6; ++i) { const int c = tid + NTHR * i; \
            { const int f = c >> 3, part = c & 7; kreg[i] = (u32x4){0u, 0u, 0u, 0u}; \
              if ((hp_) || f >= 128) kreg[i] = __builtin_nontemporal_load((const u32x4*)(K1 + ((size_t)(b_) * 8192 + ((gb_) - 1) * 128 + f) * D1 + (head_) * 64 + part * 8)); } \
            { const int d = c / 48, part = c - d * 48; vreg[i] = (u32x4){0u, 0u, 0u, 0u}; \
              if ((hp_) || part >= 16) vreg[i] = __builtin_nontemporal_load((const u32x4*)(VT1 + ((size_t)((b_) * 12 + (head_)) * 64 + d) * 8192 + ((gb_) - 1) * 128 + part * 8)); } } } while (0)
#define RAW_BARRIER() do { asm volatile("s_waitcnt lgkmcnt(0)" ::: "memory"); __builtin_amdgcn_s_barrier(); asm volatile("" ::: "memory"); } while (0)
        if ((int)blockIdx.x < BATCH * 12 * 32) { P10_DECODE((int)blockIdx.x, pp0, head0, b0, dsh0, gb0, hp0); P10_LOAD(b0, head0, gb0, hp0); }
        for (int unit = blockIdx.x; unit < BATCH * 12 * 32; unit += G) {
            P10_DECODE(unit, pp, head, b, dsh, gb, hasprev);
            bf16x8 qc[4];
#pragma unroll
            for (int ks = 0; ks < 4; ++ks) qc[ks] = *(const bf16x8*)(Q1 + ((size_t)b * 8192 + gb * 128 + wave * 32 + r) * D1 + head * 64 + ks * 16 + hh * 8);
            RAW_BARRIER();
#pragma unroll
            for (int i = 0; i < 6; ++i) { const int c = tid + NTHR * i;
                *(LAS u32x4*)(lds + (c >> 3) * KPB + (c & 7) * 16) = kreg[i];
                { const int d = c / 48, part = c - d * 48; *(LAS u32x4*)(lds + 384 * KPB + d * VPB + part * 16) = vreg[i]; } }
            RAW_BARRIER();
            if (unit + G < BATCH * 12 * 32) { P10_DECODE(unit + G, ppn, headn, bn, dshn, gbn, hpn); P10_LOAD(bn, headn, gbn, hpn); }
            const int rr = gb * 128 + wave * 32 + r;
            f32x16 o[2]; float lse2;
            attn_rows<5, 2, 2>(lds + wave * 32 * KPB, lds + 384 * KPB + wave * 64, VPB, qc, r, hh, wave, hasprev, o, lse2);
            const int t = ((rr & ((8192 >> dsh) - 1)) << dsh) | (rr >> (13 - dsh));
            const size_t token = (size_t)b * 8192 + t;
            {
                LAS unsigned char* stg = lds + 384 * KPB + 64 * VPB + wave * STG_WAVE;
                stage_o(stg, o, r, hh);
#pragma unroll
                for (int i = 0; i < 4; ++i) {
                    const int R = i * 8 + (lane >> 3), chunk = lane & 7;
                    const u32x4 vrow = *(const LAS u32x4*)(stg + R * STG_PITCH + chunk * 16);
                    const int tR = __shfl(t, R);
                    *(u32x4*)(PO1 + ((size_t)b * 8192 + tR) * D1 + head * 64 + chunk * 8) = vrow;
                }
            }
            PL1[token * 12 + head] = lse2;
        }
#undef P10_DECODE
#undef P10_LOAD
#undef RAW_BARRIER
    }
    __syncthreads();
    GRID_SYNC();
    {
        const int head = lane >> 2, part = lane & 3, hs = head & 3, gsel = head >> 2;
        for (int token = gw; token < MTOK; token += ngw) {
            if (lane < 48) {
                const float l0 = PL1[(size_t)token * 12 + hs], l1 = PL1[(size_t)token * 12 + 4 + hs], l2 = PL1[(size_t)token * 12 + 8 + hs];
                const float mxl = fmaxf(l0, fmaxf(l1, l2));
                const float w0 = __builtin_amdgcn_exp2f(l0 - mxl), w1 = __builtin_amdgcn_exp2f(l1 - mxl), w2 = __builtin_amdgcn_exp2f(l2 - mxl);
                const float al = (gsel == 0 ? w0 : (gsel == 1 ? w1 : w2)) / (w0 + w1 + w2);
                bf16_t* p = PO1 + (size_t)token * D1 + head * 64 + part * 16;
                u32x4 a = *(const u32x4*)p, c = *(const u32x4*)(p + 8);
                a.x = pk2(al * bf_lo(a.x), al * bf_hi(a.x)); a.y = pk2(al * bf_lo(a.y), al * bf_hi(a.y)); a.z = pk2(al * bf_lo(a.z), al * bf_hi(a.z)); a.w = pk2(al * bf_lo(a.w), al * bf_hi(a.w));
                c.x = pk2(al * bf_lo(c.x), al * bf_hi(c.x)); c.y = pk2(al * bf_lo(c.y), al * bf_hi(c.y)); c.z = pk2(al * bf_lo(c.z), al * bf_hi(c.z)); c.w = pk2(al * bf_lo(c.w), al * bf_hi(c.w));
                *(u32x4*)p = a; *(u32x4*)(p + 8) = c;
            }
        }
    }
    GRID_SYNC();
    {
        pg8::Gemm g{PO1, Wo1, MTOK, DM, D1}; pg8::StaticOrder S; S.init(MTOK, DM, G, (int)blockIdx.x);
        EpiResid<1> E{nullptr, Zb, ST + 2 * MTOK, ST + 4 * MTOK, args.in[9], args.in[10]};
        for (int repg = 0; repg < DUPG; ++repg) pg8::gemm_phase<EpiResid<1>, pg8::StaticOrder, G_ALIGN, G_SP2>(lds, g, S, E);
    }
    GRID_SYNC();
    {
        pg8::Gemm g{Zb, (const bf16_t*)(ws + WS_WIN1), MTOK, FF, DM}; pg8::StaticOrder S; S.init(MTOK, FF, G, (int)blockIdx.x);
        EpiSqRelu E{Hm, FF, ST + 4 * MTOK, C1 + C_WIN1, C2 + C_WIN1};
        for (int repg = 0; repg < DUPG * DUPU; ++repg) pg8::gemm_phase<EpiSqRelu, pg8::StaticOrder, G_ALIGN, G_SP2>(lds, g, S, E);
    }
    GRID_SYNC();
    {
        pg8::Gemm g{Hm, (const bf16_t*)(ws + WS_WOUT1), MTOK, DM, FF}; pg8::StaticOrder S; S.init(MTOK, DM, G, (int)blockIdx.x);
        EpiResid<1> E{nullptr, Zb, ST + 4 * MTOK, ST + 6 * MTOK, args.in[7] + DM, args.in[8] + DM};
        for (int repg = 0; repg < DUPG; ++repg) pg8::gemm_phase<EpiResid<1>, pg8::StaticOrder, G_ALIGN, G_SP2>(lds, g, S, E);
    }
    GRID_SYNC();
    ln_phase<true>(Zb, args.in[9] + DM, args.in[10] + DM, nullptr, args.out, gw, ngw, lane);
}

extern "C" void kernel_launch(void* const* d_in, const int* in_sizes, int n_in, void* d_out, int out_size, void* d_ws, size_t ws_size, hipStream_t stream) {
    static int grid_blocks = 0;
    if (grid_blocks == 0) {
        if (n_in != 11 || out_size != MTOK * DM || ws_size < WS_END) { fprintf(stderr, "kernel_launch: unexpected shapes (n_in %d, out %d, ws %zu)\n", n_in, out_size, ws_size); grid_blocks = -1; return; }
        int dev = 0, cus = 0, per_cu = 0;
        hipGetDevice(&dev);
        hipDeviceGetAttribute(&cus, hipDeviceAttributeMultiprocessorCount, dev);
        if (hipFuncSetAttribute((const void*)hybrid_fwd, hipFuncAttributeMaxDynamicSharedMemorySize, LDS_BYTES) != hipSuccess) { fprintf(stderr, "kernel_launch: hipFuncSetAttribute failed\n"); }
        if (hipOccupancyMaxActiveBlocksPerMultiprocessor(&per_cu, (const void*)hybrid_fwd, NTHR, LDS_BYTES) != hipSuccess || per_cu < 1) { fprintf(stderr, "kernel_launch: occupancy query says %d blocks per CU\n", per_cu); per_cu = 1; (void)hipGetLastError(); }
        if (per_cu > 1) per_cu = 1;
        grid_blocks = cus * per_cu;
    }
    if (grid_blocks < 0) return;
    (void)hipMemsetAsync((char*)d_ws + WS_CTL, 0, CTL_BYTES, stream);
    Args a{};
    for (int i = 0; i < 11; ++i) a.in[i] = (const float*)d_in[i];
    a.out = (float*)d_out; a.ws = (unsigned char*)d_ws;
    void* kargs[] = {&a};
    hipError_t e = hipLaunchCooperativeKernel((const void*)hybrid_fwd, dim3(grid_blocks), dim3(NTHR), kargs, LDS_BYTES, stream);
    if (e != hipSuccess) fprintf(stderr, "kernel_launch: cooperative launch failed: %s (grid %d)\n", hipGetErrorString(e), grid_blocks);
}
```

```cpp
#include <hip/hip_runtime.h>
#include <hip/hip_cooperative_groups.h>
#include <cstdio>
#include <cstdint>
namespace cg = cooperative_groups;
namespace pg8 {
#define PG8_LAS __attribute__((address_space(3)))
typedef unsigned short bf16_t;
typedef short bf16x8 __attribute__((ext_vector_type(8)));
typedef float f32x4 __attribute__((ext_vector_type(4)));
typedef unsigned u32x4 __attribute__((ext_vector_type(4)));
constexpr int BM = 256, BK = 64, HALF = 128, HTB = HALF * BK * 2  , STAGE_BYTES = 8 * HTB, NXCD = 8, WGM = 4;

__host__ __device__ __forceinline__ int lds_byte(int r, int c) { const int st = (r >> 4) * 2 + (c >> 5), rr = r & 15, cc = c & 31, ob = rr * 64 + cc * 2; return st * 1024 + (ob ^ (((ob >> 9) & 1) << 5)); }
__host__ __device__ __forceinline__ void stage_rc(int b, int& R, int& C) { const int st = b / 1024, sb = b % 1024, swz = sb ^ (((sb >> 9) & 1) << 5); R = (st >> 1) * 16 + swz / 64; C = (st & 1) * 32 + (swz % 64) / 2; }
__host__ __device__ __forceinline__ int perm32(int rho) { const int n = rho >> 4, i = rho & 15; return 8 * (i >> 2) + 4 * n + (i & 3); }

struct Unit { int pm, pn; };
struct Gemm { const bf16_t* A; const bf16_t* Bt; int M, N, K; };

struct StaticOrder {
    int nM, nN, nwg, G, c;
    __host__ __device__ void init(int M, int N, int G_, int c_) { nM = M / BM; nN = N / BM; nwg = nM * nN; G = G_; c = c_; }
    __host__ __device__ bool next(int i, Unit& u) const {
        const long L = (long)i * G + c; if (L >= nwg) return false;
        int wgid = (int)L; { const int q = nwg / NXCD, r = nwg % NXCD, xcd = wgid % NXCD, off = wgid / NXCD; wgid = (xcd < r ? xcd * (q + 1) : r * (q + 1) + (xcd - r) * q) + off; }
        const int nig = WGM * nN, gid = wgid / nig, fm = gid * WGM, gsz = (nM - fm) < WGM ? (nM - fm) : WGM;
        u.pm = fm + ((wgid % nig) % gsz); u.pn = (wgid % nig) / gsz; return true;
    }
    __device__ __forceinline__ void a_ready(const Unit&) const {}
    __device__ __forceinline__ void done(const Unit&) const {}
};


__device__ __forceinline__ unsigned cvt_pk_bf16(float lo, float hi) { unsigned r; asm volatile("v_cvt_pk_bf16_f32 %0, %1, %2" : "=v"(r) : "v"(lo), "v"(hi)); return r; }
typedef float f32x2 __attribute__((ext_vector_type(2)));

template <class Epi, class Sched, bool ALIGN_EPI = false, bool SP2 = false>
__device__ __forceinline__ void gemm_phase(PG8_LAS unsigned char* lds, const Gemm g, const Sched& S, const Epi& E) {
    int tid_ = threadIdx.x; asm volatile("" : "+v"(tid_));
    const int tid = tid_, wid = __builtin_amdgcn_readfirstlane(tid >> 6), lane = tid & 63, wr = wid >> 2, wc = wid & 3, fr = lane & 15, fq = lane >> 4;
    const int K = g.K, nt = K / BK;
    unsigned voffA[2], voffB[2];
#pragma unroll
    for (int i = 0; i < 2; ++i) { int R, C; stage_rc(tid * 16 + i * 8192, R, C); const int Rb = Epi::PERM ? ((R & ~31) + perm32(R & 31)) : R;
        voffA[i] = (unsigned)(R * K + C) * 2u; voffB[i] = (unsigned)(Rb * K + C) * 2u; }
    const size_t kstep = (size_t)(BK * 2);
    const size_t hstep = (size_t)HALF * K * 2;
    const size_t tstep = 2 * hstep;
    const unsigned ldsw = (unsigned)wid * 1024u;
    const int aoff = lds_byte(wr * 64 + fr, fq * 8), boff = lds_byte(wc * 32 + fr, fq * 8);
#define PG8_SA(b, h) (((b) * 2 + (h)) * HTB)
#define PG8_SB(b, h) ((4 + (b) * 2 + (h)) * HTB)
#define PG8_STAGE(bufoff, gbase, voff) do { _Pragma("unroll") for (int _i = 0; _i < 2; ++_i) \
        __builtin_amdgcn_global_load_lds((const unsigned*)((const char*)(gbase) + (voff)[_i]), (PG8_LAS unsigned*)(lds + (bufoff) + ldsw + _i * 8192), 16, 0, 0); } while (0)
#define PG8_LDA(dst, b, h) do { _Pragma("unroll") for (int m = 0; m < 4; ++m) _Pragma("unroll") for (int k = 0; k < 2; ++k) dst[m][k] = *(const PG8_LAS bf16x8*)(lds + PG8_SA(b, h) + aoff + m * 2048 + k * 1024); } while (0)
#define PG8_LDB(dst, b, h) do { _Pragma("unroll") for (int n = 0; n < 2; ++n) _Pragma("unroll") for (int k = 0; k < 2; ++k) dst[n][k] = *(const PG8_LAS bf16x8*)(lds + PG8_SB(b, h) + boff + n * 2048 + k * 1024); } while (0)
#define PG8_MMA(ai, bj, At, Bt) do { __builtin_amdgcn_s_setprio(1); _Pragma("unroll") for (int m = 0; m < 4; ++m) _Pragma("unroll") for (int n = 0; n < 2; ++n) _Pragma("unroll") for (int k = 0; k < 2; ++k) \
        acc[ai][bj][m][n] = __builtin_amdgcn_mfma_f32_16x16x32_bf16(Bt[n][k], At[m][k], acc[ai][bj][m][n], 0, 0, 0); __builtin_amdgcn_s_setprio(0); } while (0)
#define PG8_WAIT_V(n) asm volatile("s_waitcnt vmcnt(" #n ")" ::: "memory")
#define PG8_WAIT_L(n) asm volatile("s_waitcnt lgkmcnt(" #n ")" ::: "memory")
#define PG8_BAR __builtin_amdgcn_s_barrier()
#define PG8_SCHED __builtin_amdgcn_sched_barrier(0)
    Unit cur, nxt; int ui = 0;
    if (!S.next(0, cur)) return;
    f32x4 acc[2][2][4][2];
#pragma unroll
    for (int a = 0; a < 2; ++a)
#pragma unroll
        for (int b = 0; b < 2; ++b)
#pragma unroll
            for (int m = 0; m < 4; ++m)
#pragma unroll
                for (int n = 0; n < 2; ++n) acc[a][b][m][n] = (f32x4){0.f, 0.f, 0.f, 0.f};
    bf16x8 At[4][2], B0[2][2], B1[2][2];
    const char* cA = (const char*)g.A + (size_t)cur.pm * tstep; const char* cB = (const char*)g.Bt + (size_t)cur.pn * tstep;
    S.a_ready(cur);
    if constexpr (SP2) {
        PG8_STAGE(PG8_SB(0, 0), cB, voffB); PG8_STAGE(PG8_SB(0, 1), cB + hstep, voffB); PG8_STAGE(PG8_SA(0, 0), cA, voffA); PG8_STAGE(PG8_SA(0, 1), cA + hstep, voffA);
        if (wr == 1) PG8_BAR;
        PG8_WAIT_V(2); PG8_BAR;
        PG8_STAGE(PG8_SB(1, 0), cB + kstep, voffB); PG8_STAGE(PG8_SA(1, 0), cA + kstep, voffA); PG8_STAGE(PG8_SB(1, 1), cB + hstep + kstep, voffB);
        PG8_WAIT_V(6); PG8_BAR;
    } else {
        PG8_STAGE(PG8_SB(0, 0), cB, voffB); PG8_STAGE(PG8_SA(0, 0), cA, voffA); PG8_STAGE(PG8_SB(0, 1), cB + hstep, voffB); PG8_STAGE(PG8_SA(0, 1), cA + hstep, voffA);
        if (wr == 1) PG8_BAR;
        PG8_WAIT_V(4); PG8_BAR;
        PG8_STAGE(PG8_SB(1, 0), cB + kstep, voffB); PG8_STAGE(PG8_SA(1, 0), cA + kstep, voffA); PG8_STAGE(PG8_SB(1, 1), cB + hstep + kstep, voffB);
        PG8_WAIT_V(6); PG8_BAR;
    }
    for (;;) {
        const bool has_next = S.next(ui + 1, nxt);
        const char* nA = has_next ? (const char*)g.A + (size_t)nxt.pm * tstep : cA; const char* nB = has_next ? (const char*)g.Bt + (size_t)nxt.pn * tstep : cB;
        for (int t = 0; t < nt; t += 2) {
            const bool last = (t == nt - 2);
            const char* a1 = cA + (size_t)(t + 1) * kstep;
            const char* a2 = last ? nA : cA + (size_t)(t + 2) * kstep; const char* b2 = last ? nB : cB + (size_t)(t + 2) * kstep;
            const char* a3 = a2 + kstep; const char* b3 = b2 + kstep;
            if (last && has_next) S.a_ready(nxt);
            if constexpr (SP2) {
            PG8_LDB(B0, 0, 0); PG8_LDB(B1, 0, 1); PG8_SCHED; PG8_LDA(At, 0, 0); PG8_STAGE(PG8_SA(1, 1), a1 + hstep, voffA);
            PG8_WAIT_V(8); PG8_WAIT_L(0); PG8_BAR; PG8_MMA(0, 0, At, B0); PG8_MMA(0, 1, At, B1); PG8_BAR; PG8_SCHED;
            PG8_LDA(At, 0, 1); PG8_STAGE(PG8_SB(0, 0), b2, voffB); PG8_STAGE(PG8_SB(0, 1), b2 + hstep, voffB); PG8_STAGE(PG8_SA(0, 0), a2, voffA);
            PG8_WAIT_V(8); PG8_WAIT_L(0); PG8_BAR; PG8_MMA(1, 0, At, B0); PG8_MMA(1, 1, At, B1); PG8_BAR; PG8_SCHED;
            PG8_LDB(B0, 1, 0); PG8_LDB(B1, 1, 1); PG8_SCHED; PG8_LDA(At, 1, 0); PG8_STAGE(PG8_SA(0, 1), a2 + hstep, voffA);
            PG8_WAIT_V(8); PG8_WAIT_L(0); PG8_BAR; PG8_MMA(0, 0, At, B0); PG8_MMA(0, 1, At, B1); PG8_BAR; PG8_SCHED;
            PG8_LDA(At, 1, 1); PG8_STAGE(PG8_SB(1, 0), b3, voffB); PG8_STAGE(PG8_SB(1, 1), b3 + hstep, voffB); PG8_STAGE(PG8_SA(1, 0), a3, voffA);
            PG8_WAIT_V(8); PG8_WAIT_L(0); PG8_BAR; PG8_MMA(1, 0, At, B0); PG8_MMA(1, 1, At, B1); PG8_BAR; PG8_SCHED;
            } else {
            PG8_LDB(B0, 0, 0); PG8_SCHED; PG8_LDA(At, 0, 0); PG8_STAGE(PG8_SA(1, 1), a1 + hstep, voffA);
            PG8_WAIT_L(8); PG8_BAR; PG8_WAIT_L(0); PG8_MMA(0, 0, At, B0); PG8_BAR; PG8_SCHED;
            PG8_LDB(B1, 0, 1); PG8_STAGE(PG8_SB(0, 0), b2, voffB);
            PG8_BAR; PG8_WAIT_L(0); PG8_MMA(0, 1, At, B1); PG8_BAR;
            PG8_LDA(At, 0, 1); PG8_STAGE(PG8_SA(0, 0), a2, voffA);
            PG8_BAR; PG8_WAIT_L(0); PG8_MMA(1, 0, At, B0); PG8_BAR; PG8_SCHED;
            PG8_STAGE(PG8_SB(0, 1), b2 + hstep, voffB);
            PG8_WAIT_V(6); PG8_BAR; PG8_MMA(1, 1, At, B1); PG8_BAR;
            PG8_LDB(B0, 1, 0); PG8_SCHED; PG8_LDA(At, 1, 0); PG8_STAGE(PG8_SA(0, 1), a2 + hstep, voffA);
            PG8_WAIT_L(8); PG8_BAR; PG8_WAIT_L(0); PG8_MMA(0, 0, At, B0); PG8_BAR; PG8_SCHED;
            PG8_LDB(B1, 1, 1); PG8_STAGE(PG8_SB(1, 0), b3, voffB);
            PG8_BAR; PG8_WAIT_L(0); PG8_MMA(0, 1, At, B1); PG8_BAR;
            PG8_LDA(At, 1, 1); PG8_STAGE(PG8_SA(1, 0), a3, voffA);
            PG8_BAR; PG8_WAIT_L(0); PG8_MMA(1, 0, At, B0); PG8_BAR; PG8_SCHED;
            PG8_STAGE(PG8_SB(1, 1), b3 + hstep, voffB);
            PG8_WAIT_V(6); PG8_BAR; PG8_MMA(1, 1, At, B1); PG8_BAR;
            }
        }
        if constexpr (ALIGN_EPI) { if (wr == 0) PG8_BAR; }
        if constexpr (!Epi::AFTER_DRAIN) { E(acc, cur, wr, wc, fr, fq); S.done(cur); }
        if (!has_next) break;
#pragma unroll
        for (int a = 0; a < 2; ++a)
#pragma unroll
            for (int b = 0; b < 2; ++b)
#pragma unroll
                for (int m = 0; m < 4; ++m)
#pragma unroll
                    for (int n = 0; n < 2; ++n) acc[a][b][m][n] = (f32x4){0.f, 0.f, 0.f, 0.f};
        cur = nxt; cA = nA; cB = nB; ++ui;
        if constexpr (ALIGN_EPI) { if (wr == 1) PG8_BAR; }
    }
    PG8_WAIT_V(0);
    if constexpr (!ALIGN_EPI) { if (wr == 0) PG8_BAR; }
    PG8_BAR;
    if constexpr (Epi::AFTER_DRAIN) { E.fused(acc, cur, wr, wc, fr, fq, lds, wid, lane); S.done(cur); }
#undef PG8_SA
#undef PG8_SB
#undef PG8_STAGE
#undef PG8_LDA
#undef PG8_LDB
#undef PG8_MMA
#undef PG8_WAIT_V
#undef PG8_WAIT_L
#undef PG8_BAR
#undef PG8_SCHED
}
}

#define LAS __attribute__((address_space(3)))
using pg8::bf16_t; using pg8::bf16x8; using pg8::f32x4; using pg8::u32x4; using pg8::Unit;
typedef float f32x16 __attribute__((ext_vector_type(16)));
typedef float f32x2_t __attribute__((ext_vector_type(2)));
typedef __bf16 bf16x2_t __attribute__((ext_vector_type(2)));
typedef unsigned u32x2 __attribute__((ext_vector_type(2)));
#define MFMA32(a, b, c) __builtin_amdgcn_mfma_f32_32x32x16_bf16((a), (b), (c), 0, 0, 0)

constexpr int BATCH = 4, SEQ = 8192, DM = 1024, MTOK = BATCH * SEQ, FF = 4096, NQKV0 = 3072, NQKV1 = 2304, D1 = 768;
constexpr float ALPHA = 1.41421356237309505f, LN_EPS = 1e-5f, QSCALE = 0.125f * 1.4426950408889634f;
constexpr int NWAVES = 8, NTHR = 512;
constexpr int LIST_CAP = 126976;

constexpr size_t MiB = 1u << 20;
constexpr size_t WS_CTL = 0, CTL_BYTES = 2 * MiB;
constexpr size_t WS_KM = 128 * 1024, WS_BAR = 16 * 1024;
constexpr size_t WS_COS = 505 * MiB, WS_SIN = 506 * MiB;
constexpr size_t WS_C12 = 640 * 1024, WS_ST = 1 * MiB;
constexpr int NC12 = 4096 + 4096 + 2304, C_WIN0 = 0, C_WIN1 = 4096, C_QKV1 = 8192;
constexpr size_t WS_WQKV0 = 3 * MiB, WS_WO0 = 9 * MiB, WS_WQKV1 = 11 * MiB, WS_WO1 = 15 * MiB + 512 * 1024, WS_WIN0 = 17 * MiB, WS_WOUT0 = 25 * MiB, WS_WIN1 = 33 * MiB, WS_WOUT1 = 41 * MiB;
constexpr size_t WS_HB = 49 * MiB;
constexpr size_t WS_Q = 113 * MiB, WS_K = 177 * MiB, WS_VT = 241 * MiB, WS_PO = 305 * MiB, WS_PL = 497 * MiB;
constexpr size_t WS_H = 113 * MiB, WS_Z = 369 * MiB, WS_HB2 = 433 * MiB;
constexpr size_t WS_Q1 = 113 * MiB, WS_K1 = 161 * MiB, WS_VT1 = 209 * MiB, WS_PO1 = 257 * MiB, WS_PL1 = 305 * MiB;
constexpr size_t WS_DUMP = 401 * MiB, WS_END = 507 * MiB;
constexpr size_t OUT_PO3 = 0, OUT_LIST = 64 * MiB;

#ifndef DUPU
#define DUPU 1
#endif
#ifndef DUPQ0
#define DUPQ0 1
#endif
#ifndef DUPQ1
#define DUPQ1 1
#endif
#ifndef DUPG
#define DUPG 1
#endif
#ifndef G_ALIGN
#define G_ALIGN true
#endif
#ifndef G_SP2
#define G_SP2 true
#endif
#ifndef PHM
#define PHM 0xFFFFFFFFu
#endif
constexpr int RING_BYTES = 131072, LDS_BYTES = 147456, LDS_MISC = LDS_BYTES - 1024;

__device__ __forceinline__ unsigned pk2(float lo, float hi) { f32x2_t v = {lo, hi}; bf16x2_t b = __builtin_convertvector(v, bf16x2_t); return __builtin_bit_cast(unsigned, b); }
__device__ __forceinline__ float bf_lo(unsigned u) { return __uint_as_float(u << 16); }
__device__ __forceinline__ float bf_hi(unsigned u) { return __uint_as_float(u & 0xffff0000u); }
__device__ __forceinline__ int crow(int i, int hh) { return (i & 3) + 8 * (i >> 2) + 4 * hh; }
__device__ __forceinline__ float wave_sum(float v) {
#pragma unroll
    for (int o = 1; o < 64; o <<= 1) v += __shfl_xor(v, o);
    return v;
}
#define LDS_WAIT() asm volatile("s_waitcnt lgkmcnt(0)" ::: "memory")
__device__ __forceinline__ int qkv_phys(int c) { return (c & ~255) + ((c & 32) ? 128 : 0) + (((c >> 6) & 3) << 5) + (c & 31); }
__device__ __forceinline__ int swz16(int r) { return (r & ~12) | ((r & 4) << 1) | ((r & 8) >> 1); }

#define ROW_STATS(st_, row_, mu_, rs_) do { const f32x2_t sv_ = *(const f32x2_t*)((st_) + (size_t)(row_) * 2); (mu_) = sv_.x * (1.0f / DM); (rs_) = 1.0f / sqrtf(sv_.y * (1.0f / DM) - (mu_) * (mu_) + LN_EPS); } while (0)
template <int LAYER> struct EpiQKV {
    static constexpr bool PERM = true, AFTER_DRAIN = false;
    bf16_t* Q; bf16_t* Kb; bf16_t* VT; float* KM; const float* cs; const float* sn; const float* st; const float* c1; const float* c2;
    __device__ __forceinline__ void operator()(const f32x4 (&acc)[2][2][4][2], const Unit& u, int wr, int wc, int fr, int fq) const {
        constexpr int NT = LAYER == 0 ? 4 : 3, PITCH = NT * 256, NH = NT * 4;
        const int which = u.pn / NT, hg = u.pn - which * NT, head = hg * 4 + wc, e0 = 8 * fq;
        const int dsh = LAYER == 0 ? 0 : 2 * hg;
        const int rowb = u.pm * 256 + wr * 64 + fr;
        f32x4 c1v[2][2], c2v[2][2]; f32x2_t svc = {0.f, 0.f}, svn = {0.f, 0.f};
        if (LAYER == 1) {
#pragma unroll
            for (int bj = 0; bj < 2; ++bj)
#pragma unroll
                for (int n = 0; n < 2; ++n) { const int cc = u.pn * 256 + bj * 128 + wc * 32 + e0 + 4 * n; c1v[bj][n] = *(const f32x4*)(c1 + cc); c2v[bj][n] = *(const f32x4*)(c2 + cc); }
            svc = *(const f32x2_t*)(st + (size_t)rowb * 2);
        }
#define QKV_AFF(a_, bj_, n_) (LAYER == 1 ? ((a_) - mu * c1v[bj_][n_]) * rstd + c2v[bj_][n_] : (a_))
        if (which < 2) {
            bf16_t* dst = which == 0 ? Q : Kb; const float sc = which == 0 ? QSCALE : 1.f;
            f32x4 ks[2][2];
#pragma unroll
            for (int a = 0; a < 2; ++a)
#pragma unroll
                for (int b = 0; b < 2; ++b) ks[a][b] = (f32x4){0.f, 0.f, 0.f, 0.f};
            f32x4 tc[4], tn[4];
            { const int t = rowb & 8191; tc[0] = *(const f32x4*)(cs + t * 32 + e0); tc[1] = *(const f32x4*)(cs + t * 32 + e0 + 4); tc[2] = *(const f32x4*)(sn + t * 32 + e0); tc[3] = *(const f32x4*)(sn + t * 32 + e0 + 4); }
#pragma unroll
            for (int q = 0; q < 8; ++q) {
                const int ai = q >> 2, m = q & 3;
                const int row = rowb + ai * 128 + m * 16, b = row >> 13, t = row & 8191;
                if (q + 1 < 8) { const int t2 = (rowb + ((q + 1) >> 2) * 128 + ((q + 1) & 3) * 16) & 8191;
                    tn[0] = *(const f32x4*)(cs + t2 * 32 + e0); tn[1] = *(const f32x4*)(cs + t2 * 32 + e0 + 4); tn[2] = *(const f32x4*)(sn + t2 * 32 + e0); tn[3] = *(const f32x4*)(sn + t2 * 32 + e0 + 4);
                    if (LAYER == 1) svn = *(const f32x2_t*)(st + (size_t)(rowb + ((q + 1) >> 2) * 128 + ((q + 1) & 3) * 16) * 2); }
                const int rr = ((t & ((1 << dsh) - 1)) << (13 - dsh)) | (t >> dsh);
                const f32x4 c0 = tc[0], c1_ = tc[1], s0 = tc[2], s1 = tc[3];
                const float mu = LAYER == 1 ? svc.x * (1.0f / DM) : 0.f, rstd = LAYER == 1 ? 1.0f / sqrtf(svc.y * (1.0f / DM) - mu * mu + LN_EPS) : 1.f;
                const f32x4 x1a = QKV_AFF(acc[ai][0][m][0], 0, 0), x1b = QKV_AFF(acc[ai][0][m][1], 0, 1), x2a = QKV_AFF(acc[ai][1][m][0], 1, 0), x2b = QKV_AFF(acc[ai][1][m][1], 1, 1);
                const f32x4 o1a = (x1a * c0 - x2a * s0) * sc, o1b = (x1b * c1_ - x2b * s1) * sc, o2a = (x2a * c0 + x1a * s0) * sc, o2b = (x2b * c1_ + x1b * s1) * sc;
                bf16_t* p = dst + (size_t)(b * 8192 + rr) * PITCH + head * 64 + e0;
                u32x4 w; w.x = pk2(o1a[0], o1a[1]); w.y = pk2(o1a[2], o1a[3]); w.z = pk2(o1b[0], o1b[1]); w.w = pk2(o1b[2], o1b[3]);
                *(u32x4*)p = w;
                w.x = pk2(o2a[0], o2a[1]); w.y = pk2(o2a[2], o2a[3]); w.z = pk2(o2b[0], o2b[1]); w.w = pk2(o2b[2], o2b[3]);
                *(u32x4*)(p + 32) = w;
                if (LAYER == 0 && which == 1) { ks[0][0] += o1a; ks[0][1] += o1b; ks[1][0] += o2a; ks[1][1] += o2b; }
                asm volatile("" ::: "memory");
#pragma unroll
                for (int k = 0; k < 4; ++k) tc[k] = tn[k];
                svc = svn;
            }
            if (LAYER == 0 && which == 1) {
                const int b = u.pm >> 5, blk = u.pm & 31;
                float* kmp = KM + ((size_t)((b * 16 + head) * 32 + blk)) * 64; float kmv = 0.f;
#pragma unroll
                for (int a = 0; a < 2; ++a)
#pragma unroll
                    for (int n = 0; n < 2; ++n)
#pragma unroll
                        for (int i = 0; i < 4; ++i) {
                            float v = ks[a][n][i];
                            v += __shfl_xor(v, 1); v += __shfl_xor(v, 2); v += __shfl_xor(v, 4); v += __shfl_xor(v, 8);
                            if (fr == a * 8 + n * 4 + i) kmv = v;
                        }
                __hip_atomic_fetch_add(kmp + (fr >> 3) * 32 + e0 + (fr & 7), kmv * (1.0f / 256.0f), __ATOMIC_RELAXED, __HIP_MEMORY_SCOPE_AGENT);
            }
        } else {
#pragma unroll
            for (int q = 0; q < 8; ++q) {
                const int ai = q >> 2, m = q & 3;
                const int row = rowb + ai * 128 + m * 16, b = row >> 13, t = row & 8191;
                const int rr = ((t & ((1 << dsh) - 1)) << (13 - dsh)) | (t >> dsh);
                bf16_t* p = VT + ((size_t)(b * NH + head) * 64 + e0) * 8192 + swz16(rr);
                if (LAYER == 1 && q + 1 < 8) svn = *(const f32x2_t*)(st + (size_t)(rowb + ((q + 1) >> 2) * 128 + ((q + 1) & 3) * 16) * 2);
                const float mu = LAYER == 1 ? svc.x * (1.0f / DM) : 0.f, rstd = LAYER == 1 ? 1.0f / sqrtf(svc.y * (1.0f / DM) - mu * mu + LN_EPS) : 1.f;
#pragma unroll
                for (int bj = 0; bj < 2; ++bj)
#pragma unroll
                    for (int n = 0; n < 2; ++n) { const f32x4 yv = QKV_AFF(acc[ai][bj][m][n], bj, n);
#pragma unroll
                        for (int i = 0; i < 4; ++i) p[(size_t)(bj * 32 + 4 * n + i) * 8192] = (bf16_t)(pk2(yv[i], 0.f) & 0xffffu); }
                svc = svn;
            }
        }
#undef QKV_AFF
    }
};
struct EpiSqRelu {
    static constexpr bool PERM = true, AFTER_DRAIN = false;
    bf16_t* O; int ldc; const float* st; const float* c1; const float* c2;
    __device__ __forceinline__ void operator()(const f32x4 (&acc)[2][2][4][2], const Unit& u, int wr, int wc, int fr, int fq) const {
        const int row0 = u.pm * 256 + wr * 64 + fr, col0 = u.pn * 256 + wc * 32 + 8 * fq;
        f32x4 c1v[2][2], c2v[2][2]; float mus[8], rss[8];
#pragma unroll
        for (int bj = 0; bj < 2; ++bj)
#pragma unroll
            for (int n = 0; n < 2; ++n) { c1v[bj][n] = *(const f32x4*)(c1 + col0 + bj * 128 + 4 * n); c2v[bj][n] = *(const f32x4*)(c2 + col0 + bj * 128 + 4 * n); }
#pragma unroll
        for (int q = 0; q < 8; ++q) ROW_STATS(st, row0 + (q >> 2) * 128 + (q & 3) * 16, mus[q], rss[q]);
#pragma unroll
        for (int ai = 0; ai < 2; ++ai)
#pragma unroll
            for (int m = 0; m < 4; ++m) { const int row = row0 + ai * 128 + m * 16; bf16_t* rowp = O + (size_t)row * ldc + col0;
                const float mu = mus[ai * 4 + m], rstd = rss[ai * 4 + m];
#pragma unroll
                for (int bj = 0; bj < 2; ++bj) { f32x4 v0 = (acc[ai][bj][m][0] - mu * c1v[bj][0]) * rstd + c2v[bj][0], v1 = (acc[ai][bj][m][1] - mu * c1v[bj][1]) * rstd + c2v[bj][1];
#pragma unroll
                    for (int i = 0; i < 4; ++i) { const float a = fmaxf(v0[i], 0.f), b = fmaxf(v1[i], 0.f); v0[i] = a * a; v1[i] = b * b; }
                    u32x4 w; w.x = pk2(v0[0], v0[1]); w.y = pk2(v0[2], v0[3]); w.z = pk2(v1[0], v1[1]); w.w = pk2(v1[2], v1[3]);
                    __builtin_nontemporal_store(w, (u32x4*)(rowp + bj * 128)); } }
    }
};
template <int MODE> struct EpiResid {
    static constexpr bool PERM = true, AFTER_DRAIN = false;
    const bf16_t* R; bf16_t* Z; const float* stp; float* stc; const float* g; const float* b;
    __device__ __forceinline__ void operator()(const f32x4 (&acc)[2][2][4][2], const Unit& u, int wr, int wc, int fr, int fq) const {
        const int row0 = u.pm * 256 + wr * 64 + fr, col0 = u.pn * 256 + wc * 32 + 8 * fq;
        const bf16_t* src = MODE == 1 ? (const bf16_t*)Z : R;
        f32x4 gv[2][2], bv[2][2]; f32x2_t svc = {0.f, 0.f}, svn = {0.f, 0.f};
        u32x4 rc[2], rn[2]; float sq[8];
#define RES_LD(p_) (MODE == 0 ? __builtin_nontemporal_load((const u32x4*)(p_)) : *(const u32x4*)(p_))
        rc[0] = RES_LD(src + (size_t)row0 * DM + col0); rc[1] = RES_LD(src + (size_t)row0 * DM + col0 + 128);
        if (MODE == 1) {
#pragma unroll
            for (int bj = 0; bj < 2; ++bj)
#pragma unroll
                for (int n = 0; n < 2; ++n) { gv[bj][n] = *(const f32x4*)(g + col0 + bj * 128 + 4 * n); bv[bj][n] = *(const f32x4*)(b + col0 + bj * 128 + 4 * n); }
            svc = *(const f32x2_t*)(stp + (size_t)row0 * 2);
        }
#pragma unroll
        for (int q = 0; q < 8; ++q) {
            const int ai = q >> 2, m = q & 3, row = row0 + ai * 128 + m * 16; const size_t off = (size_t)row * DM + col0;
            if (q + 1 < 8) { const int row2 = row0 + ((q + 1) >> 2) * 128 + ((q + 1) & 3) * 16; const size_t off2 = (size_t)row2 * DM + col0; rn[0] = RES_LD(src + off2); rn[1] = RES_LD(src + off2 + 128);
                if (MODE == 1) svn = *(const f32x2_t*)(stp + (size_t)row2 * 2); }
            const float mu = MODE == 1 ? svc.x * (1.0f / DM) : 0.f, rstd = MODE == 1 ? 1.0f / sqrtf(svc.y * (1.0f / DM) - mu * mu + LN_EPS) : 1.f;
            float s1 = 0.f, s2 = 0.f;
#pragma unroll
            for (int bj = 0; bj < 2; ++bj) { const u32x4 rv = rc[bj];
                f32x4 h0 = (f32x4){bf_lo(rv.x), bf_hi(rv.x), bf_lo(rv.y), bf_hi(rv.y)}, h1 = (f32x4){bf_lo(rv.z), bf_hi(rv.z), bf_lo(rv.w), bf_hi(rv.w)};
                if (MODE == 1) { h0 = (h0 - mu) * rstd * gv[bj][0] + bv[bj][0]; h1 = (h1 - mu) * rstd * gv[bj][1] + bv[bj][1]; }
                const f32x4 z0 = ALPHA * h0 + acc[ai][bj][m][0], z1 = ALPHA * h1 + acc[ai][bj][m][1];
                u32x4 w; w.x = pk2(z0[0], z0[1]); w.y = pk2(z0[2], z0[3]); w.z = pk2(z1[0], z1[1]); w.w = pk2(z1[2], z1[3]);
                *(u32x4*)(Z + off + bj * 128) = w;
                const float r0 = bf_lo(w.x), r1 = bf_hi(w.x), r2 = bf_lo(w.y), r3 = bf_hi(w.y), r4 = bf_lo(w.z), r5 = bf_hi(w.z), r6 = bf_lo(w.w), r7 = bf_hi(w.w);
                s1 += ((r0 + r1) + (r2 + r3)) + ((r4 + r5) + (r6 + r7));
                s2 += ((r0 * r0 + r1 * r1) + (r2 * r2 + r3 * r3)) + ((r4 * r4 + r5 * r5) + (r6 * r6 + r7 * r7)); }
            s1 += __shfl_xor(s1, 16); s1 += __shfl_xor(s1, 32); s2 += __shfl_xor(s2, 16); s2 += __shfl_xor(s2, 32);
            sq[q] = (fq & 1) ? s2 : s1;
            asm volatile("" ::: "memory");
            rc[0] = rn[0]; rc[1] = rn[1]; svc = svn;
        }
#pragma unroll
        for (int p = 0; p < 4; ++p) {
            const int qa = 2 * p, qb = 2 * p + 1;
            const float val = (fq < 2) ? sq[qa] : sq[qb];
            const int rowp = row0 + ((fq < 2) ? ((qa >> 2) * 128 + (qa & 3) * 16) : ((qb >> 2) * 128 + (qb & 3) * 16));
            __hip_atomic_fetch_add(stc + (size_t)rowp * 2 + (fq & 1), val, __ATOMIC_RELAXED, __HIP_MEMORY_SCOPE_AGENT);
        }
    }
};

template <bool PERMQ, bool SCALED> __device__ __forceinline__ void transpose_item(const float* W, int K, int N, bf16_t* WT, LAS float* scr, int item, int lane, const float* gk, const float* bk, float* c1, float* c2) {
    const int nblk = N / 32, kb = item / nblk, nb = item % nblk, k0 = 64 * kb, n0 = 32 * nb;
    float p1 = 0.f, p2 = 0.f;
#pragma unroll 8
    for (int i = 0; i < 32; ++i) { const int kk = 2 * i + (lane >> 5); float v = __builtin_nontemporal_load(W + (size_t)(k0 + kk) * N + n0 + (lane & 31));
        if (SCALED) { p2 += v * bk[k0 + kk]; v *= gk[k0 + kk]; p1 += bf_lo(pk2(v, 0.f)); }
        scr[kk * 33 + (lane & 31)] = v; }
    LDS_WAIT();
    if (SCALED) { p1 += __shfl_xor(p1, 32); p2 += __shfl_xor(p2, 32);
        if (lane < 32) { const int oc = PERMQ ? qkv_phys(n0 + lane) : (n0 + lane); __hip_atomic_fetch_add(c1 + oc, p1, __ATOMIC_RELAXED, __HIP_MEMORY_SCOPE_AGENT); __hip_atomic_fetch_add(c2 + oc, p2, __ATOMIC_RELAXED, __HIP_MEMORY_SCOPE_AGENT); } }
    const int c = lane & 7;
#pragma unroll
    for (int j = 0; j < 4; ++j) { const int n = (lane >> 3) + 8 * j; const LAS float* sp = scr + (8 * c) * 33 + n;
        u32x4 o; o.x = pk2(sp[0 * 33], sp[1 * 33]); o.y = pk2(sp[2 * 33], sp[3 * 33]); o.z = pk2(sp[4 * 33], sp[5 * 33]); o.w = pk2(sp[6 * 33], sp[7 * 33]);
        const int orow = PERMQ ? qkv_phys(n0 + n) : (n0 + n);
        *(u32x4*)(WT + (size_t)orow * K + k0 + 8 * c) = o; }
    LDS_WAIT();
}

template <bool F32OUT> __device__ __forceinline__ void ln_phase(const bf16_t* Z, const float* g, const float* bt, bf16_t* ob, float* of, int gw, int ngw, int lane) {
    f32x4 gv[4], bv[4];
#pragma unroll
    for (int q = 0; q < 2; ++q) { gv[2 * q] = *(const f32x4*)(g + 512 * q + 8 * lane); gv[2 * q + 1] = *(const f32x4*)(g + 512 * q + 8 * lane + 4);
                                  bv[2 * q] = *(const f32x4*)(bt + 512 * q + 8 * lane); bv[2 * q + 1] = *(const f32x4*)(bt + 512 * q + 8 * lane + 4); }
    for (int row = gw; row < MTOK; row += ngw) {
        const bf16_t* zr = Z + (size_t)row * DM + 8 * lane;
        const u32x4 a = __builtin_nontemporal_load((const u32x4*)zr), b = __builtin_nontemporal_load((const u32x4*)(zr + 512));
        float v[16] = {bf_lo(a.x), bf_hi(a.x), bf_lo(a.y), bf_hi(a.y), bf_lo(a.z), bf_hi(a.z), bf_lo(a.w), bf_hi(a.w),
                       bf_lo(b.x), bf_hi(b.x), bf_lo(b.y), bf_hi(b.y), bf_lo(b.z), bf_hi(b.z), bf_lo(b.w), bf_hi(b.w)};
        float s = 0.f;
#pragma unroll
        for (int i = 0; i < 16; ++i) s += v[i];
        const float mean = wave_sum(s) * (1.0f / DM);
        float q = 0.f;
#pragma unroll
        for (int i = 0; i < 16; ++i) { v[i] -= mean; q += v[i] * v[i]; }
        const float rstd = 1.0f / sqrtf(wave_sum(q) * (1.0f / DM) + LN_EPS);
#pragma unroll
        for (int i = 0; i < 16; ++i) v[i] = v[i] * rstd * gv[i >> 2][i & 3] + bv[i >> 2][i & 3];
        if (F32OUT) {
            float* orow = of + (size_t)row * DM + 8 * lane;
            __builtin_nontemporal_store((f32x4){v[0], v[1], v[2], v[3]}, (f32x4*)orow); __builtin_nontemporal_store((f32x4){v[4], v[5], v[6], v[7]}, (f32x4*)(orow + 4));
            __builtin_nontemporal_store((f32x4){v[8], v[9], v[10], v[11]}, (f32x4*)(orow + 512)); __builtin_nontemporal_store((f32x4){v[12], v[13], v[14], v[15]}, (f32x4*)(orow + 516));
        } else {
            bf16_t* orow = ob + (size_t)row * DM + 8 * lane;
            u32x4 w; w.x = pk2(v[0], v[1]); w.y = pk2(v[2], v[3]); w.z = pk2(v[4], v[5]); w.w = pk2(v[6], v[7]); *(u32x4*)orow = w;
            w.x = pk2(v[8], v[9]); w.y = pk2(v[10], v[11]); w.z = pk2(v[12], v[13]); w.w = pk2(v[14], v[15]); *(u32x4*)(orow + 512) = w;
        }
    }
}

constexpr int KPB = 144;
template <int NKT, int MODE, int GT>
__device__ __forceinline__ void attn_rows(const LAS unsigned char* Kl, const LAS unsigned char* Vl, const int vpb, const bf16x8 (&qf)[4], const int r, const int hh, const int p0, const int p1,
                                          f32x16 (&o)[2], float& lse2) {
    constexpr int NG = (NKT + GT - 1) / GT;
    float mrun = -INFINITY, lrun = 0.f;
#pragma unroll
    for (int i = 0; i < 16; ++i) { o[0][i] = 0.f; o[1][i] = 0.f; }
#pragma unroll
    for (int grp = 0; grp < NG; ++grp) {
        constexpr int dummy = 0; (void)dummy;
        const int kt0 = grp * GT;
        const int nt = (NKT - kt0) < GT ? (NKT - kt0) : GT;
        const bool gact = MODE == 0 ? true : (MODE == 1 ? (kt0 <= p0) : (p1 != 0 || (p0 + kt0 + nt - 1 >= 4)));
        if (gact) {
            bf16x8 kf[GT][4];
#pragma unroll
            for (int q = 0; q < GT; ++q)
#pragma unroll
                for (int ks = 0; ks < 4; ++ks) if (q < nt) kf[q][ks] = *(const LAS bf16x8*)(Kl + ((kt0 + q) * 32 + r) * KPB + ks * 32 + hh * 16);
            f32x16 s[GT];
#pragma unroll
            for (int q = 0; q < GT; ++q)
#pragma unroll
                for (int i = 0; i < 16; ++i) s[q][i] = 0.f;
#pragma unroll
            for (int ks = 0; ks < 4; ++ks)
#pragma unroll
                for (int q = 0; q < GT; ++q) if (q < nt) s[q] = MFMA32(kf[q][ks], qf[ks], s[q]);
            bf16x8 vf[GT][2][2];
#pragma unroll
            for (int q = 0; q < GT; ++q)
#pragma unroll
                for (int s2 = 0; s2 < 2; ++s2)
#pragma unroll
                    for (int dt = 0; dt < 2; ++dt) if (q < nt) vf[q][s2][dt] = *(const LAS bf16x8*)(Vl + (dt * 32 + r) * vpb + ((kt0 + q) * 32 + s2 * 16 + hh * 8) * 2);
            if (MODE == 1) { if (p0 < 8) {
#pragma unroll
                for (int q = 0; q < GT; ++q) if (q < nt) { const int lim = (p0 - (kt0 + q)) * 32 + r;
#pragma unroll
                    for (int i = 0; i < 16; ++i) if (crow(i, hh) > lim) s[q][i] = -INFINITY; } } }
            if (MODE == 2) {
#pragma unroll
                for (int q = 0; q < GT; ++q) if (q < nt) { const int kt = kt0 + q;
                    if (kt == 0) {
#pragma unroll
                        for (int i = 0; i < 16; ++i) if (crow(i, hh) < r) s[q][i] = -INFINITY; }
                    if (kt == NKT - 1) {
#pragma unroll
                        for (int i = 0; i < 16; ++i) if (crow(i, hh) > r) s[q][i] = -INFINITY; } }
                if (p1 == 0) {
#pragma unroll
                    for (int q = 0; q < GT; ++q) if (q < nt) { if (p0 + kt0 + q < 4) {
#pragma unroll
                        for (int i = 0; i < 16; ++i) s[q][i] = -INFINITY; } } }
            }
            float mx = -INFINITY;
#pragma unroll
            for (int q = 0; q < GT; ++q) if (q < nt) {
#pragma unroll
                for (int i = 0; i < 16; ++i) mx = fmaxf(mx, s[q][i]); }
            mx = fmaxf(mx, __shfl_xor(mx, 32));
            const float mnew = fmaxf(mrun, mx);
            const float sc = __builtin_amdgcn_exp2f(mrun - mnew);
            mrun = mnew; lrun *= sc;
            if (grp > 0) {
#pragma unroll
                for (int i = 0; i < 16; ++i) { o[0][i] *= sc; o[1][i] *= sc; }
            }
#pragma unroll
            for (int q = 0; q < GT; ++q) if (q < nt) {
#pragma unroll
                for (int i = 0; i < 16; ++i) { const float p = __builtin_amdgcn_exp2f(s[q][i] - mnew); s[q][i] = p; lrun += p; }
#pragma unroll
                for (int s2 = 0; s2 < 2; ++s2) {
                    u32x4 pw; pw.x = pk2(s[q][8 * s2], s[q][8 * s2 + 1]); pw.y = pk2(s[q][8 * s2 + 2], s[q][8 * s2 + 3]); pw.z = pk2(s[q][8 * s2 + 4], s[q][8 * s2 + 5]); pw.w = pk2(s[q][8 * s2 + 6], s[q][8 * s2 + 7]);
                    const bf16x8 pf = __builtin_bit_cast(bf16x8, pw);
#pragma unroll
                    for (int dt = 0; dt < 2; ++dt) o[dt] = MFMA32(vf[q][s2][dt], pf, o[dt]);
                }
            }
        }
    }
    const float l = lrun + __shfl_xor(lrun, 32);
    const float inv = 1.0f / l;
#pragma unroll
    for (int i = 0; i < 16; ++i) { o[0][i] *= inv; o[1][i] *= inv; }
    lse2 = mrun + __builtin_amdgcn_logf(l);
}
__device__ __forceinline__ void store_o(bf16_t* dst, const f32x16 (&o)[2], int hh) {
#pragma unroll
    for (int dt = 0; dt < 2; ++dt)
#pragma unroll
        for (int g4 = 0; g4 < 4; ++g4) { u32x2 w; w.x = pk2(o[dt][4 * g4], o[dt][4 * g4 + 1]); w.y = pk2(o[dt][4 * g4 + 2], o[dt][4 * g4 + 3]); *(u32x2*)(dst + dt * 32 + 8 * g4 + 4 * hh) = w; }
}

constexpr int STG_PITCH = 144, STG_WAVE = 32 * STG_PITCH;
__device__ __forceinline__ void stage_o(LAS unsigned char* stg, const f32x16 (&o)[2], int r, int hh) {
#pragma unroll
    for (int dt = 0; dt < 2; ++dt)
#pragma unroll
        for (int g4 = 0; g4 < 4; ++g4) { u32x2 w; w.x = pk2(o[dt][4 * g4], o[dt][4 * g4 + 1]); w.y = pk2(o[dt][4 * g4 + 2], o[dt][4 * g4 + 3]); *(LAS u32x2*)(stg + r * STG_PITCH + dt * 64 + g4 * 16 + hh * 8) = w; }
    LDS_WAIT();
}
constexpr int STG8_PITCH = 80; constexpr float PO8_SCALE = 16.0f;
__device__ __forceinline__ void stage_o8(LAS unsigned char* stg, const f32x16 (&o)[2], int r, int hh) {
#pragma unroll
    for (int dt = 0; dt < 2; ++dt)
#pragma unroll
        for (int g4 = 0; g4 < 4; ++g4) {
            int w = __builtin_amdgcn_cvt_pk_fp8_f32(o[dt][4 * g4] * PO8_SCALE, o[dt][4 * g4 + 1] * PO8_SCALE, 0, false);
            w = __builtin_amdgcn_cvt_pk_fp8_f32(o[dt][4 * g4 + 2] * PO8_SCALE, o[dt][4 * g4 + 3] * PO8_SCALE, w, true);
            *(LAS int*)(stg + r * STG8_PITCH + dt * 32 + g4 * 8 + hh * 4) = w; }
    LDS_WAIT();
}
#define XB_TMO      128
#define XB_XCNT(j)  (256  + 64 * (j))
#define XB_XSUB(j)  (1280 + 64 * (j))
#define XB_XGEN(j)  (2304 + 64 * (j))
#define XB_TOP      3328
#define XB_TOPGEN   3392
#define XCD_BAR_WORDS 3456
#define XB_SPIN_CAP (1u << 18)

__device__ __forceinline__ unsigned xb_ld(unsigned* p)              { return __hip_atomic_load(p, __ATOMIC_RELAXED, __HIP_MEMORY_SCOPE_AGENT); }
__device__ __forceinline__ unsigned xb_add(unsigned* p, unsigned v) { return __hip_atomic_fetch_add(p, v, __ATOMIC_RELAXED, __HIP_MEMORY_SCOPE_AGENT); }
__device__ __forceinline__ unsigned xb_xcc_id() { return (unsigned)__builtin_amdgcn_s_getreg((3 << 11) | 20) & 0xFu; }
#define XB_SPIN(cond, bar) do { unsigned _sp = 0; while (cond) { __builtin_amdgcn_s_sleep(1); \
    if ((++_sp & 255u) == 0u) { if (xb_ld(&(bar)[XB_TMO])) break; if (_sp > XB_SPIN_CAP) { atomicAdd(&(bar)[XB_TMO], 1u); break; } } } } while (0)

struct XcdBarrier {
    unsigned* bar; unsigned x;
    volatile LAS unsigned* st;
};

__device__ __forceinline__ XcdBarrier xcd_barrier_post(unsigned* bar, volatile LAS unsigned* st) {
    XcdBarrier b; b.bar = bar; b.x = xb_xcc_id(); b.st = st;
    if (threadIdx.x == 0) (void)xb_add(&bar[XB_XCNT(b.x)], 1u);
    return b;
}
__device__ __forceinline__ void xcd_barrier_complete(unsigned* bar, unsigned x, unsigned& nloc, unsigned& nx) {
    const unsigned G = gridDim.x * gridDim.y * gridDim.z;
    unsigned sum, cnt, mine, sp = 0u;
    for (;;) {
        sum = 0u; cnt = 0u; mine = 0u;
#pragma unroll
        for (unsigned j = 0; j < 16; ++j) { const unsigned c = xb_ld(&bar[XB_XCNT(j)]); sum += c; cnt += (c > 0u) ? 1u : 0u; mine = (j == x) ? c : mine; }
        if (sum == G) break;
        __builtin_amdgcn_s_sleep(1);
        if ((++sp & 255u) == 0u) { if (xb_ld(&bar[XB_TMO])) break; if (sp > XB_SPIN_CAP) { atomicAdd(&bar[XB_TMO], 1u); break; } }
    }
    nloc = mine > 0u ? mine : 1u; nx = cnt > 0u ? cnt : 1u;
}

__device__ __forceinline__ void xcd_barrier(const XcdBarrier& b) {
    asm volatile("s_waitcnt vmcnt(0)" ::: "memory");
    __syncthreads();
    if (threadIdx.x == 0) {
        unsigned* bar = b.bar;
        __builtin_amdgcn_s_waitcnt(0);
        unsigned nloc = b.st[0], nx = b.st[1];
        if (nloc == 0u) { xcd_barrier_complete(bar, b.x, nloc, nx); b.st[0] = nloc; b.st[1] = nx; }
        const unsigned old = xb_add(&bar[XB_XSUB(b.x)], 1u);
        const unsigned gen = old / nloc;
        if (old + 1u == (gen + 1u) * nloc) {
            __builtin_amdgcn_fence(__ATOMIC_RELEASE, "agent");
            asm volatile("s_waitcnt vmcnt(0)" ::: "memory");
            const unsigned og = xb_add(&bar[XB_TOP], 1u);
            const unsigned tg = og / nx;
            if (og + 1u == (tg + 1u) * nx) xb_add(&bar[XB_TOPGEN], 1u);
            else XB_SPIN(xb_ld(&bar[XB_TOPGEN]) == tg, bar);
            __builtin_amdgcn_fence(__ATOMIC_ACQUIRE, "agent");
            xb_add(&bar[XB_XGEN(b.x)], 1u);
            asm volatile("s_waitcnt vmcnt(0)" ::: "memory");
        } else {
            XB_SPIN(xb_ld(&bar[XB_XGEN(b.x)]) == gen, bar);
            __builtin_amdgcn_fence(__ATOMIC_ACQUIRE, "agent");
            asm volatile("s_waitcnt vmcnt(0)" ::: "memory");
        }
    }
    __syncthreads();
}

struct Args { const float* in[11]; float* out; unsigned char* ws; int pad0, pad1; };

__global__ void __launch_bounds__(NTHR) hybrid_fwd(Args args) {
    extern __shared__ __attribute__((aligned(16))) unsigned char lds_raw[];
    LAS unsigned char* lds = (LAS unsigned char*)lds_raw;
    cg::grid_group grid = cg::this_grid();
    int tid = threadIdx.x, lane = tid & 63, wave = __builtin_amdgcn_readfirstlane(tid >> 6);
    const int G = gridDim.x, ngw = G * NWAVES; int gw = blockIdx.x * NWAVES + wave;
#define GRID_SYNC_CG() do { grid.sync(); asm volatile("" : "+v"(tid), "+v"(lane)); } while (0)
#define GRID_SYNC() do { xcd_barrier(xbar); asm volatile("" : "+v"(tid), "+v"(lane)); } while (0)
    if (tid < 2) ((LAS unsigned*)(lds + LDS_MISC + 256))[tid] = 0u;
    __syncthreads();
    const XcdBarrier xbar = xcd_barrier_post((unsigned*)(args.ws + WS_BAR), (volatile LAS unsigned*)(lds + LDS_MISC + 256));
    unsigned char* ws = args.ws;
    const float* x = args.in[0];
    bf16_t* Wqkv0 = (bf16_t*)(ws + WS_WQKV0); bf16_t* Wo0 = (bf16_t*)(ws + WS_WO0); bf16_t* Wqkv1 = (bf16_t*)(ws + WS_WQKV1); bf16_t* Wo1 = (bf16_t*)(ws + WS_WO1);
    float* cosT = (float*)(ws + WS_COS); float* sinT = (float*)(ws + WS_SIN);
    bf16_t* HB = (bf16_t*)(ws + WS_HB); bf16_t* Zb = (bf16_t*)(ws + WS_Z); bf16_t* Hm = (bf16_t*)(ws + WS_H);
    float* C1 = (float*)(ws + WS_C12); float* C2 = C1 + NC12; float* ST = (float*)(ws + WS_ST);
    unsigned* gcnt = (unsigned*)(ws + WS_CTL); float* KM = (float*)(ws + WS_KM);
    unsigned* LIST = (unsigned*)((unsigned char*)args.out + OUT_LIST); bf16_t* PO3 = (bf16_t*)((unsigned char*)args.out + OUT_PO3);

    if (PHM & 1u) {
        LAS float* scr = (LAS float*)(lds + wave * 16384);
        constexpr int I_QKV0 = (DM / 64) * (NQKV0 / 32), I_WO0 = (DM / 64) * (DM / 32), I_QKV1 = (DM / 64) * (NQKV1 / 32), I_WO1 = (D1 / 64) * (DM / 32), I_IN = (DM / 64) * (FF / 32), I_OUT = (FF / 64) * (DM / 32);
        constexpr int NITEMS = I_QKV0 + I_WO0 + I_QKV1 + I_WO1 + 2 * I_IN + 2 * I_OUT;
        for (int it = gw; it < NITEMS; it += ngw) {
            int rI = it;
            if (rI < I_QKV0) { transpose_item<true, false>(args.in[1], DM, NQKV0, Wqkv0, scr, rI, lane, nullptr, nullptr, nullptr, nullptr); continue; } rI -= I_QKV0;
            if (rI < I_WO0) { transpose_item<false, false>(args.in[2], DM, DM, Wo0, scr, rI, lane, nullptr, nullptr, nullptr, nullptr); continue; } rI -= I_WO0;
            if (rI < I_QKV1) { transpose_item<true, true>(args.in[3], DM, NQKV1, Wqkv1, scr, rI, lane, args.in[9], args.in[10], C1 + C_QKV1, C2 + C_QKV1); continue; } rI -= I_QKV1;
            if (rI < I_WO1) { transpose_item<false, false>(args.in[4], D1, DM, Wo1, scr, rI, lane, nullptr, nullptr, nullptr, nullptr); continue; } rI -= I_WO1;
            if (rI < 2 * I_IN) { const int l = rI / I_IN; transpose_item<false, true>(args.in[5] + (size_t)l * DM * FF, DM, FF, (bf16_t*)(ws + (l ? WS_WIN1 : WS_WIN0)), scr, rI - l * I_IN, lane, args.in[7] + l * DM, args.in[8] + l * DM, C1 + (l ? C_WIN1 : C_WIN0), C2 + (l ? C_WIN1 : C_WIN0)); continue; } rI -= 2 * I_IN;
            { const int l = rI / I_OUT; transpose_item<false, false>(args.in[6] + (size_t)l * DM * FF, FF, DM, (bf16_t*)(ws + (l ? WS_WOUT1 : WS_WOUT0)), scr, rI - l * I_OUT, lane, nullptr, nullptr, nullptr, nullptr); }
        }
        for (int idx = blockIdx.x * NTHR + tid; idx < SEQ * 32; idx += G * NTHR) {
            const int t = idx >> 5, e = idx & 31;
            const float inv = 1.0f / powf(10000.0f, (float)(2 * e) / 64.0f);
            const float ang = (float)t * inv;
            const double a = (double)ang, kk = rint(a * 0.15915494309189535), rd = fma(-kk, 6.283185307179586, a);
            const float rf = (float)rd;
            cosT[idx] = cosf(rf); sinT[idx] = sinf(rf);
        }
        for (int row = gw; row < MTOK; row += ngw) {
            const float* xr = x + (size_t)row * DM + 8 * lane;
            const f32x4 a0 = __builtin_nontemporal_load((const f32x4*)xr), a1 = __builtin_nontemporal_load((const f32x4*)(xr + 4)), b0 = __builtin_nontemporal_load((const f32x4*)(xr + 512)), b1 = __builtin_nontemporal_load((const f32x4*)(xr + 516));
            bf16_t* orow = HB + (size_t)row * DM + 8 * lane;
            u32x4 w; w.x = pk2(a0[0], a0[1]); w.y = pk2(a0[2], a0[3]); w.z = pk2(a1[0], a1[1]); w.w = pk2(a1[2], a1[3]); *(u32x4*)orow = w;
            w.x = pk2(b0[0], b0[1]); w.y = pk2(b0[2], b0[3]); w.z = pk2(b1[0], b1[1]); w.w = pk2(b1[2], b1[3]); *(u32x4*)(orow + 512) = w;
        }
    }
    __syncthreads();
    if (args.pad1 != 0) GRID_SYNC_CG();
    GRID_SYNC();

    bf16_t* Q0 = (bf16_t*)(ws + WS_Q); bf16_t* K0 = (bf16_t*)(ws + WS_K); bf16_t* VT0 = (bf16_t*)(ws + WS_VT); bf16_t* PO = (bf16_t*)(ws + WS_PO); float* PL = (float*)(ws + WS_PL);
    if (PHM & 2u) {
        pg8::Gemm g{HB, Wqkv0, MTOK, NQKV0, DM}; pg8::StaticOrder S; S.init(MTOK, NQKV0, G, (int)blockIdx.x);
        EpiQKV<0> E{Q0, K0, VT0, KM, cosT, sinT, nullptr, nullptr, nullptr};
        for (int repg = 0; repg < DUPG * DUPQ0; ++repg) pg8::gemm_phase<EpiQKV<0>, pg8::StaticOrder, G_ALIGN, G_SP2>(lds, g, S, E);
    }
    GRID_SYNC();
    if (PHM & 4u) {
        LAS unsigned* lcnt = (LAS unsigned*)(lds + LDS_MISC); LAS unsigned* lbase = lcnt + 32;
        const int r = lane & 31, hh = lane >> 5;
        for (int unit = blockIdx.x; unit < BATCH * 32 * 16; unit += G) {
            const int h = unit & 15, qb = (unit >> 4) & 31, b = unit >> 9;
            if (tid < 32) lcnt[tid] = 0u;
            __syncthreads();
            const int tq = qb * 256 + wave * 32 + r, token = b * 8192 + tq;
            bf16x8 qf[4];
#pragma unroll
            for (int ks = 0; ks < 4; ++ks) qf[ks] = *(const bf16x8*)(Q0 + (size_t)token * DM + h * 64 + ks * 16 + hh * 8);
            f32x16 gt;
#pragma unroll
            for (int i = 0; i < 16; ++i) gt[i] = 0.f;
            const float* kmr = KM + ((size_t)((b * 16 + h) * 32 + r)) * 64 + hh * 8;
#pragma unroll
            for (int ks = 0; ks < 4; ++ks) { const f32x4 k0 = *(const f32x4*)(kmr + ks * 16), k1 = *(const f32x4*)(kmr + ks * 16 + 4);
                u32x4 kw; kw.x = pk2(k0[0], k0[1]); kw.y = pk2(k0[2], k0[3]); kw.z = pk2(k1[0], k1[1]); kw.w = pk2(k1[2], k1[3]);
                gt = MFMA32(__builtin_bit_cast(bf16x8, kw), qf[ks], gt); }
            float v0 = -3.0e38f, v1 = -3.0e38f, v2 = -3.0e38f;
#define TOP_INS(val) do { float t_ = (val); const float a_ = fmaxf(v0, t_); t_ = fminf(v0, t_); v0 = a_; const float b_ = fmaxf(v1, t_); t_ = fminf(v1, t_); v1 = b_; v2 = fmaxf(v2, t_); } while (0)
#pragma unroll
            for (int i = 0; i < 16; ++i) { const int j = crow(i, hh); const float gv_ = j < qb ? gt[i] : -3.0e38f; TOP_INS(__uint_as_float((__float_as_uint(gv_) & ~31u) | (unsigned)j)); }
            { const float pv0 = __shfl_xor(v0, 32), pv1 = __shfl_xor(v1, 32), pv2 = __shfl_xor(v2, 32); TOP_INS(pv0); TOP_INS(pv1); TOP_INS(pv2); }
#undef TOP_INS
            const int i0 = (int)(__float_as_uint(v0) & 31u), i1 = (int)(__float_as_uint(v1) & 31u), i2 = (int)(__float_as_uint(v2) & 31u);
            const int nvalid = qb < 3 ? qb : 3;
            unsigned lp0 = 0, lp1 = 0, lp2 = 0;
            if (hh == 0) {
                if (0 < nvalid) lp0 = __hip_atomic_fetch_add(lcnt + i0, 1u, __ATOMIC_RELAXED, __HIP_MEMORY_SCOPE_WORKGROUP); else PL[((size_t)0 * MTOK + token) * 16 + h] = -INFINITY;
                if (1 < nvalid) lp1 = __hip_atomic_fetch_add(lcnt + i1, 1u, __ATOMIC_RELAXED, __HIP_MEMORY_SCOPE_WORKGROUP); else PL[((size_t)1 * MTOK + token) * 16 + h] = -INFINITY;
                if (2 < nvalid) lp2 = __hip_atomic_fetch_add(lcnt + i2, 1u, __ATOMIC_RELAXED, __HIP_MEMORY_SCOPE_WORKGROUP); else PL[((size_t)2 * MTOK + token) * 16 + h] = -INFINITY;
            }
            __syncthreads();
            if (tid < 32) { const unsigned c = lcnt[tid]; lbase[tid] = c ? __hip_atomic_fetch_add(gcnt + (b * 16 + h) * 32 + tid, c, __ATOMIC_RELAXED, __HIP_MEMORY_SCOPE_AGENT) : 0u; }
            __syncthreads();
            if (hh == 0) {
                unsigned* lst = LIST + (size_t)(b * 16 + h) * LIST_CAP;
                if (0 < nvalid) lst[256 * (31 * i0 - (i0 * (i0 - 1)) / 2) + lbase[i0] + lp0] = (unsigned)tq | (0u << 13);
                if (1 < nvalid) lst[256 * (31 * i1 - (i1 * (i1 - 1)) / 2) + lbase[i1] + lp1] = (unsigned)tq | (1u << 13);
                if (2 < nvalid) lst[256 * (31 * i2 - (i2 * (i2 - 1)) / 2) + lbase[i2] + lp2] = (unsigned)tq | (2u << 13);
            }
        }
    }
    __syncthreads();
    GRID_SYNC();
#ifndef DUP3
#define DUP3 1
#endif
#ifndef DUP10
#define DUP10 1
#endif
    for (int rep3 = 0; rep3 < DUP3; ++rep3) {
        const LAS unsigned char* Kl = lds; const LAS unsigned char* Vl = lds + 256 * KPB; constexpr int VPB = (256 + 8) * 2;
        const int r = lane & 31, hh = lane >> 5;
        bf16_t* dump = (bf16_t*)(ws + WS_DUMP) + (size_t)((blockIdx.x & 255) * NWAVES + wave) * 2048;
        u32x4 kreg[4], vreg[4];
#define P3_LOADKV(b_, h_, j_) do { _Pragma("unroll") for (int i = 0; i < 4; ++i) { const int c = tid + NTHR * i; \
            kreg[i] = __builtin_nontemporal_load((const u32x4*)(K0 + (size_t)((b_) * 8192 + (j_) * 256 + (c >> 3)) * DM + (h_) * 64 + (c & 7) * 8)); \
            vreg[i] = __builtin_nontemporal_load((const u32x4*)(VT0 + ((size_t)((b_) * 16 + (h_)) * 64 + (c >> 5)) * 8192 + (j_) * 256 + (c & 31) * 8)); } } while (0)
        LAS int* sh_n = (LAS int*)(lds + LDS_MISC + 512); LAS int* sh_order = sh_n + 32; LAS int* sh_myj = sh_order + 32; LAS int* sh_cnt = sh_myj + 32;
      for (int v = blockIdx.x; v < 256; v += G) {
        const int bh = (v & 7) * 8 + (v >> 5), q4 = (v >> 3) & 3, b = bh >> 4, h = bh & 15;
        __syncthreads();
        if (tid < 32) sh_n[tid] = 256 + (int)gcnt[bh * 32 + tid] + 128;
        __syncthreads();
        if (tid < 32) { const int nj = sh_n[tid]; int rank = 0;
            for (int i = 0; i < 32; ++i) { const int ni = sh_n[i]; rank += (ni > nj || (ni == nj && i < tid)) ? 1 : 0; }
            sh_order[rank] = tid; }
        __syncthreads();
        if (tid == 0) { int l0 = 0, l1 = 0, l2 = 0, l3 = 0, cnt = 0;
            for (int k = 0; k < 32; ++k) { const int jx = sh_order[k], w = sh_n[jx];
                int bin = 0, lm = l0; if (l1 < lm) { lm = l1; bin = 1; } if (l2 < lm) { lm = l2; bin = 2; } if (l3 < lm) { lm = l3; bin = 3; }
                l0 += bin == 0 ? w : 0; l1 += bin == 1 ? w : 0; l2 += bin == 2 ? w : 0; l3 += bin == 3 ? w : 0;
                if (bin == q4) { sh_myj[cnt] = jx; ++cnt; } }
            sh_cnt[0] = cnt; }
        __syncthreads();
        const int nit = sh_cnt[0];
        const bf16_t* Qbh = Q0 + (size_t)b * 8192 * DM + h * 64 + hh * 8;
        bf16x8 qf[4];
        if (nit > 0) { const int j0 = sh_myj[0]; P3_LOADKV(b, h, j0);
#pragma unroll
            for (int ks = 0; ks < 4; ++ks) qf[ks] = *(const bf16x8*)(Qbh + (size_t)(j0 * 256 + wave * 32 + r) * DM + ks * 16); }
#define RAW_BARRIER() do { asm volatile("s_waitcnt lgkmcnt(0)" ::: "memory"); __builtin_amdgcn_s_barrier(); asm volatile("" ::: "memory"); } while (0)
        for (int it = 0; it < nit; ++it) {
            const int j = sh_myj[it], jn = (it + 1 < nit) ? sh_myj[it + 1] : -1;
            RAW_BARRIER();
#pragma unroll
            for (int i = 0; i < 4; ++i) { const int c = tid + NTHR * i;
                *(LAS u32x4*)(lds + (c >> 3) * KPB + (c & 7) * 16) = kreg[i];
                *(LAS u32x4*)(lds + 256 * KPB + (c >> 5) * VPB + (c & 31) * 16) = vreg[i]; }
            RAW_BARRIER();
            if (jn >= 0) P3_LOADKV(b, h, jn);
#ifdef P3_PROBE_OWNONLY
            const int n = (rep3 + 1 < DUP3) ? 256 : 256 + (int)gcnt[bh * 32 + j], ngroups = (n + 31) >> 5;
#else
            const int n = 256 + (int)gcnt[bh * 32 + j], ngroups = (n + 31) >> 5;
#endif
            const unsigned* lst = LIST + (size_t)bh * LIST_CAP + 256 * (31 * j - (j * (j - 1)) / 2);
            int g = wave;
            int tq = j * 256 + g * 32 + r, slot = 3; bool valid = true;
            const int tqN = (jn >= 0 ? jn : j) * 256 + wave * 32 + r;
            unsigned en = 0u; bool vn = false;
            if (g + 8 < ngroups) { const int row = (g + 8) * 32 + r; vn = row < n; en = lst[vn ? row - 256 : 0]; }
            for (; g < ngroups; g += NWAVES) {
                bf16x8 q1[4]; int tq1 = tqN, slot1 = 3; unsigned en2 = 0u; bool vn2 = false;
                if (g + 8 < ngroups) { tq1 = (int)(en & 8191u); slot1 = (int)(en >> 13); }
#pragma unroll
                for (int ks = 0; ks < 4; ++ks) q1[ks] = *(const bf16x8*)(Qbh + (size_t)tq1 * DM + ks * 16);
                if (g + 16 < ngroups) { const int row = (g + 16) * 32 + r; vn2 = row < n; en2 = lst[vn2 ? row - 256 : 0]; }
                f32x16 o[2]; float lse2;
                attn_rows<8, 1, 2>(Kl, Vl, VPB, qf, r, hh, g < 8 ? g : 99, 0, o, lse2);
                {
                    LAS unsigned char* stg = lds + 73728 + wave * STG_WAVE;
                    stage_o8(stg, o, r, hh);
                    const int myinfo = tq | (slot << 13) | (valid ? (1 << 15) : 0);
                    {
                        const int R = lane >> 1, half = lane & 1;
                        const u32x4 v0 = *(const LAS u32x4*)(stg + R * STG8_PITCH + half * 32), v1 = *(const LAS u32x4*)(stg + R * STG8_PITCH + half * 32 + 16);
                        const int info = __shfl(myinfo, R), tqR = info & 8191, slotR = (info >> 13) & 3;
                        unsigned char* dstp = (slotR == 3 ? (unsigned char*)PO3 : (unsigned char*)PO + (size_t)slotR * MTOK * DM) + ((size_t)b * 8192 + tqR) * DM + h * 64 + half * 32;
                        if (!(info & (1 << 15))) dstp = (unsigned char*)dump + lane * 32;
                        __builtin_nontemporal_store(v0, (u32x4*)dstp); __builtin_nontemporal_store(v1, (u32x4*)(dstp + 16));
                    }
                    { float* plp = PL + ((size_t)slot * MTOK + (size_t)b * 8192 + tq) * 16 + h; if (!valid) plp = (float*)(dump + 1024) + lane; *plp = lse2; }
                }
#pragma unroll
                for (int ks = 0; ks < 4; ++ks) qf[ks] = q1[ks];
                tq = tq1; slot = slot1; valid = vn; en = en2; vn = vn2;
            }
        }
      }
#undef P3_LOADKV
#undef RAW_BARRIER
    }
    __syncthreads();
    GRID_SYNC();
    if (PHM & 16u) {
        const int head = lane >> 2, part = lane & 3;
        for (int token = gw; token < MTOK; token += ngw) {
            float ls[4], mxl = -INFINITY;
#pragma unroll
            for (int s = 0; s < 4; ++s) { ls[s] = PL[((size_t)s * MTOK + token) * 16 + head]; mxl = fmaxf(mxl, ls[s]); }
            float accv[16], den = 0.f;
#pragma unroll
            for (int i = 0; i < 16; ++i) accv[i] = 0.f;
#pragma unroll
            for (int s = 0; s < 4; ++s) {
                const float w = __builtin_amdgcn_exp2f(ls[s] - mxl);
                if (w > 0.f) {
                    den += w;
                    const unsigned char* src = (s == 3 ? (const unsigned char*)PO3 : (const unsigned char*)PO + (size_t)s * MTOK * DM) + (size_t)token * DM + head * 64 + part * 16;
                    const u32x4 a = *(const u32x4*)src;
                    const float ws_ = w * (1.0f / PO8_SCALE);
#pragma unroll
                    for (int k = 0; k < 4; ++k) { const f32x2_t lo = __builtin_amdgcn_cvt_pk_f32_fp8((int)a[k], false), hi = __builtin_amdgcn_cvt_pk_f32_fp8((int)a[k], true);
                        accv[4 * k] += ws_ * lo.x; accv[4 * k + 1] += ws_ * lo.y; accv[4 * k + 2] += ws_ * hi.x; accv[4 * k + 3] += ws_ * hi.y; }
                }
            }
            const float inv = 1.0f / den;
            bf16_t* dst = Q0 + (size_t)token * DM + head * 64 + part * 16;
            u32x4 w0, w1;
            w0.x = pk2(accv[0] * inv, accv[1] * inv); w0.y = pk2(accv[2] * inv, accv[3] * inv); w0.z = pk2(accv[4] * inv, accv[5] * inv); w0.w = pk2(accv[6] * inv, accv[7] * inv);
            w1.x = pk2(accv[8] * inv, accv[9] * inv); w1.y = pk2(accv[10] * inv, accv[11] * inv); w1.z = pk2(accv[12] * inv, accv[13] * inv); w1.w = pk2(accv[14] * inv, accv[15] * inv);
            *(u32x4*)dst = w0; *(u32x4*)(dst + 8) = w1;
        }
    }
    GRID_SYNC();
    if (PHM & 32u) {
        pg8::Gemm g{Q0, Wo0, MTOK, DM, DM}; pg8::StaticOrder S; S.init(MTOK, DM, G, (int)blockIdx.x);
        EpiResid<0> E{HB, Zb, nullptr, ST, nullptr, nullptr};
        for (int repg = 0; repg < DUPG; ++repg) pg8::gemm_phase<EpiResid<0>, pg8::StaticOrder, G_ALIGN, G_SP2>(lds, g, S, E);
    }
    GRID_SYNC();
    if (PHM & 64u) {
        pg8::Gemm g{Zb, (const bf16_t*)(ws + WS_WIN0), MTOK, FF, DM}; pg8::StaticOrder S; S.init(MTOK, FF, G, (int)blockIdx.x);
        EpiSqRelu E{Hm, FF, ST, C1 + C_WIN0, C2 + C_WIN0};
        for (int repg = 0; repg < DUPG * DUPU; ++repg) pg8::gemm_phase<EpiSqRelu, pg8::StaticOrder, G_ALIGN, G_SP2>(lds, g, S, E);
    }
    GRID_SYNC();
    {
        pg8::Gemm g{Hm, (const bf16_t*)(ws + WS_WOUT0), MTOK, DM, FF}; pg8::StaticOrder S; S.init(MTOK, DM, G, (int)blockIdx.x);
        EpiResid<1> E{nullptr, Zb, ST, ST + 2 * MTOK, args.in[7], args.in[8]};
        for (int repg = 0; repg < DUPG; ++repg) pg8::gemm_phase<EpiResid<1>, pg8::StaticOrder, G_ALIGN, G_SP2>(lds, g, S, E);
    }
    GRID_SYNC();

    bf16_t* Q1 = (bf16_t*)(ws + WS_Q1); bf16_t* K1 = (bf16_t*)(ws + WS_K1); bf16_t* VT1 = (bf16_t*)(ws + WS_VT1); bf16_t* PO1 = (bf16_t*)(ws + WS_PO1); float* PL1 = (float*)(ws + WS_PL1);
    if (PHM & 128u) {
        pg8::Gemm g{Zb, Wqkv1, MTOK, NQKV1, DM}; pg8::StaticOrder S; S.init(MTOK, NQKV1, G, (int)blockIdx.x);
        EpiQKV<1> E{Q1, K1, VT1, nullptr, cosT, sinT, ST + 2 * MTOK, C1 + C_QKV1, C2 + C_QKV1};
        for (int repg = 0; repg < DUPG * DUPQ1; ++repg) pg8::gemm_phase<EpiQKV<1>, pg8::StaticOrder, G_ALIGN, G_SP2>(lds, g, S, E);
    }
    GRID_SYNC();
    for (int rep10 = 0; rep10 < DUP10; ++rep10) {
        constexpr int VPB = (384 + 8) * 2; const int r = lane & 31, hh = lane >> 5;
        u32x4 kreg[6], vreg[6];
#define P10_DECODE(unit_, pp_, head_, b_, dsh_, gb_, hp_) const int pp_ = (unit_) & 31, head_ = ((unit_) >> 5) % 12, b_ = (unit_) / (32 * 12), dsh_ = 2 * (head_ >> 2), gb_ = 2 * pp_, hp_ = ((gb_ & ((64 >> dsh_) - 1)) != 0) ? 1 : 0
#define P10_LOAD(b_, head_, gb_, hp_) do { _Pragma("unroll") for (int i = 0; i < 6; ++i) { const int c = tid + NTHR * i; \
            { const int f = c >> 3, part = c & 7; kreg[i] = (u32x4){0u, 0u, 0u, 0u}; \
              if ((hp_) || f >= 128) kreg[i] = __builtin_nontemporal_load((const u32x4*)(K1 + ((size_t)(b_) * 8192 + ((gb_) - 1) * 128 + f) * D1 + (head_) * 64 + part * 8)); } \
            { const int d = c / 48, part = c - d * 48; vreg[i] = (u32x4){0u, 0u, 0u, 0u}; \
              if ((hp_) || part >= 16) vreg[i] = __builtin_nontemporal_load((const u32x4*)(VT1 + ((size_t)((b_) * 12 + (head_)) * 64 + d) * 8192 + ((gb_) - 1) * 128 + part * 8)); } } } while (0)
#define RAW_BARRIER() do { asm volatile("s_waitcnt lgkmcnt(0)" ::: "memory"); __builtin_amdgcn_s_barrier(); asm volatile("" ::: "memory"); } while (0)
        if ((int)blockIdx.x < BATCH * 12 * 32) { P10_DECODE((int)blockIdx.x, pp0, head0, b0, dsh0, gb0, hp0); P10_LOAD(b0, head0, gb0, hp0); }
        for (int unit = blockIdx.x; unit < BATCH * 12 * 32; unit += G) {
            P10_DECODE(unit, pp, head, b, dsh, gb, hasprev);
            bf16x8 qc[4];
#pragma unroll
            for (int ks = 0; ks < 4; ++ks) qc[ks] = *(const bf16x8*)(Q1 + ((size_t)b * 8192 + gb * 128 + wave * 32 + r) * D1 + head * 64 + ks * 16 + hh * 8);
            RAW_BARRIER();
#pragma unroll
            for (int i = 0; i < 6; ++i) { const int c = tid + NTHR * i;
                *(LAS u32x4*)(lds + (c >> 3) * KPB + (c & 7) * 16) = kreg[i];
                { const int d = c / 48, part = c - d * 48; *(LAS u32x4*)(lds + 384 * KPB + d * VPB + part * 16) = vreg[i]; } }
            RAW_BARRIER();
            if (unit + G < BATCH * 12 * 32) { P10_DECODE(unit + G, ppn, headn, bn, dshn, gbn, hpn); P10_LOAD(bn, headn, gbn, hpn); }
            const int rr = gb * 128 + wave * 32 + r;
            f32x16 o[2]; float lse2;
            attn_rows<5, 2, 2>(lds + wave * 32 * KPB, lds + 384 * KPB + wave * 64, VPB, qc, r, hh, wave, hasprev, o, lse2);
            const int t = ((rr & ((8192 >> dsh) - 1)) << dsh) | (rr >> (13 - dsh));
            const size_t token = (size_t)b * 8192 + t;
            {
                LAS unsigned char* stg = lds + 384 * KPB + 64 * VPB + wave * STG_WAVE;
                stage_o(stg, o, r, hh);
#pragma unroll
                for (int i = 0; i < 4; ++i) {
                    const int R = i * 8 + (lane >> 3), chunk = lane & 7;
                    const u32x4 vrow = *(const LAS u32x4*)(stg + R * STG_PITCH + chunk * 16);
                    const int tR = __shfl(t, R);
                    *(u32x4*)(PO1 + ((size_t)b * 8192 + tR) * D1 + head * 64 + chunk * 8) = vrow;
                }
            }
            PL1[token * 12 + head] = lse2;
        }
#undef P10_DECODE
#undef P10_LOAD
#undef RAW_BARRIER
    }
    __syncthreads();
    GRID_SYNC();
    {
        const int head = lane >> 2, part = lane & 3, hs = head & 3, gsel = head >> 2;
        for (int token = gw; token < MTOK; token += ngw) {
            if (lane < 48) {
                const float l0 = PL1[(size_t)token * 12 + hs], l1 = PL1[(size_t)token * 12 + 4 + hs], l2 = PL1[(size_t)token * 12 + 8 + hs];
                const float mxl = fmaxf(l0, fmaxf(l1, l2));
                const float w0 = __builtin_amdgcn_exp2f(l0 - mxl), w1 = __builtin_amdgcn_exp2f(l1 - mxl), w2 = __builtin_amdgcn_exp2f(l2 - mxl);
                const float al = (gsel == 0 ? w0 : (gsel == 1 ? w1 : w2)) / (w0 + w1 + w2);
                bf16_t* p = PO1 + (size_t)token * D1 + head * 64 + part * 16;
                u32x4 a = *(const u32x4*)p, c = *(const u32x4*)(p + 8);
                a.x = pk2(al * bf_lo(a.x), al * bf_hi(a.x)); a.y = pk2(al * bf_lo(a.y), al * bf_hi(a.y)); a.z = pk2(al * bf_lo(a.z), al * bf_hi(a.z)); a.w = pk2(al * bf_lo(a.w), al * bf_hi(a.w));
                c.x = pk2(al * bf_lo(c.x), al * bf_hi(c.x)); c.y = pk2(al * bf_lo(c.y), al * bf_hi(c.y)); c.z = pk2(al * bf_lo(c.z), al * bf_hi(c.z)); c.w = pk2(al * bf_lo(c.w), al * bf_hi(c.w));
                *(u32x4*)p = a; *(u32x4*)(p + 8) = c;
            }
        }
    }
    GRID_SYNC();
    {
        pg8::Gemm g{PO1, Wo1, MTOK, DM, D1}; pg8::StaticOrder S; S.init(MTOK, DM, G, (int)blockIdx.x);
        EpiResid<1> E{nullptr, Zb, ST + 2 * MTOK, ST + 4 * MTOK, args.in[9], args.in[10]};
        for (int repg = 0; repg < DUPG; ++repg) pg8::gemm_phase<EpiResid<1>, pg8::StaticOrder, G_ALIGN, G_SP2>(lds, g, S, E);
    }
    GRID_SYNC();
    {
        pg8::Gemm g{Zb, (const bf16_t*)(ws + WS_WIN1), MTOK, FF, DM}; pg8::StaticOrder S; S.init(MTOK, FF, G, (int)blockIdx.x);
        EpiSqRelu E{Hm, FF, ST + 4 * MTOK, C1 + C_WIN1, C2 + C_WIN1};
        for (int repg = 0; repg < DUPG * DUPU; ++repg) pg8::gemm_phase<EpiSqRelu, pg8::StaticOrder, G_ALIGN, G_SP2>(lds, g, S, E);
    }
    GRID_SYNC();
    {
        pg8::Gemm g{Hm, (const bf16_t*)(ws + WS_WOUT1), MTOK, DM, FF}; pg8::StaticOrder S; S.init(MTOK, DM, G, (int)blockIdx.x);
        EpiResid<1> E{nullptr, Zb, ST + 4 * MTOK, ST + 6 * MTOK, args.in[7] + DM, args.in[8] + DM};
        for (int repg = 0; repg < DUPG; ++repg) pg8::gemm_phase<EpiResid<1>, pg8::StaticOrder, G_ALIGN, G_SP2>(lds, g, S, E);
    }
    GRID_SYNC();
    ln_phase<true>(Zb, args.in[9] + DM, args.in[10] + DM, nullptr, args.out, gw, ngw, lane);
}

extern "C" void kernel_launch(void* const* d_in, const int* in_sizes, int n_in, void* d_out, int out_size, void* d_ws, size_t ws_size, hipStream_t stream) {
    static int grid_blocks = 0;
    if (grid_blocks == 0) {
        if (n_in != 11 || out_size != MTOK * DM || ws_size < WS_END) { fprintf(stderr, "kernel_launch: unexpected shapes (n_in %d, out %d, ws %zu)\n", n_in, out_size, ws_size); grid_blocks = -1; return; }
        int dev = 0, cus = 0, per_cu = 0;
        hipGetDevice(&dev);
        hipDeviceGetAttribute(&cus, hipDeviceAttributeMultiprocessorCount, dev);
        if (hipFuncSetAttribute((const void*)hybrid_fwd, hipFuncAttributeMaxDynamicSharedMemorySize, LDS_BYTES) != hipSuccess) { fprintf(stderr, "kernel_launch: hipFuncSetAttribute failed\n"); }
        if (hipOccupancyMaxActiveBlocksPerMultiprocessor(&per_cu, (const void*)hybrid_fwd, NTHR, LDS_BYTES) != hipSuccess || per_cu < 1) { fprintf(stderr, "kernel_launch: occupancy query says %d blocks per CU\n", per_cu); per_cu = 1; (void)hipGetLastError(); }
        if (per_cu > 1) per_cu = 1;
        grid_blocks = cus * per_cu;
    }
    if (grid_blocks < 0) return;
    (void)hipMemsetAsync((char*)d_ws + WS_CTL, 0, CTL_BYTES, stream);
    Args a{};
    for (int i = 0; i < 11; ++i) a.in[i] = (const float*)d_in[i];
    a.out = (float*)d_out; a.ws = (unsigned char*)d_ws;
    void* kargs[] = {&a};
    hipError_t e = hipLaunchCooperativeKernel((const void*)hybrid_fwd, dim3(grid_blocks), dim3(NTHR), kargs, LDS_BYTES, stream);
    if (e != hipSuccess) fprintf(stderr, "kernel_launch: cooperative launch failed: %s (grid %d)\n", hipGetErrorString(e), grid_blocks);
}
```

```cpp
#include <hip/hip_runtime.h>
#include <hip/hip_cooperative_groups.h>
#include <cstdio>
#include <cstdint>
namespace cg = cooperative_groups;
namespace pg8 {
#define PG8_LAS __attribute__((address_space(3)))
typedef unsigned short bf16_t;
typedef short bf16x8 __attribute__((ext_vector_type(8)));
typedef float f32x4 __attribute__((ext_vector_type(4)));
typedef unsigned u32x4 __attribute__((ext_vector_type(4)));
constexpr int BM = 256, BK = 64, HALF = 128, HTB = HALF * BK * 2  , STAGE_BYTES = 8 * HTB, NXCD = 8, WGM = 4;

__host__ __device__ __forceinline__ int lds_byte(int r, int c) { const int st = (r >> 4) * 2 + (c >> 5), rr = r & 15, cc = c & 31, ob = rr * 64 + cc * 2; return st * 1024 + (ob ^ (((ob >> 9) & 1) << 5)); }
__host__ __device__ __forceinline__ void stage_rc(int b, int& R, int& C) { const int st = b / 1024, sb = b % 1024, swz = sb ^ (((sb >> 9) & 1) << 5); R = (st >> 1) * 16 + swz / 64; C = (st & 1) * 32 + (swz % 64) / 2; }
__host__ __device__ __forceinline__ int perm32(int rho) { const int n = rho >> 4, i = rho & 15; return 8 * (i >> 2) + 4 * n + (i & 3); }

struct Unit { int pm, pn; };
struct Gemm { const bf16_t* A; const bf16_t* Bt; int M, N, K; };

struct StaticOrder {
    int nM, nN, nwg, G, c;
    __host__ __device__ void init(int M, int N, int G_, int c_) { nM = M / BM; nN = N / BM; nwg = nM * nN; G = G_; c = c_; }
    __host__ __device__ bool next(int i, Unit& u) const {
        const long L = (long)i * G + c; if (L >= nwg) return false;
        int wgid = (int)L; { const int q = nwg / NXCD, r = nwg % NXCD, xcd = wgid % NXCD, off = wgid / NXCD; wgid = (xcd < r ? xcd * (q + 1) : r * (q + 1) + (xcd - r) * q) + off; }
        const int nig = WGM * nN, gid = wgid / nig, fm = gid * WGM, gsz = (nM - fm) < WGM ? (nM - fm) : WGM;
        u.pm = fm + ((wgid % nig) % gsz); u.pn = (wgid % nig) / gsz; return true;
    }
    __device__ __forceinline__ void a_ready(const Unit&) const {}
    __device__ __forceinline__ void done(const Unit&) const {}
};


__device__ __forceinline__ unsigned cvt_pk_bf16(float lo, float hi) { unsigned r; asm volatile("v_cvt_pk_bf16_f32 %0, %1, %2" : "=v"(r) : "v"(lo), "v"(hi)); return r; }
typedef float f32x2 __attribute__((ext_vector_type(2)));

template <class Epi, class Sched, bool ALIGN_EPI = false, bool SP2 = false>
__device__ __forceinline__ void gemm_phase(PG8_LAS unsigned char* lds, const Gemm g, const Sched& S, const Epi& E) {
    int tid_ = threadIdx.x; asm volatile("" : "+v"(tid_));
    const int tid = tid_, wid = __builtin_amdgcn_readfirstlane(tid >> 6), lane = tid & 63, wr = wid >> 2, wc = wid & 3, fr = lane & 15, fq = lane >> 4;
    const int K = g.K, nt = K / BK;
    unsigned voffA[2], voffB[2];
#pragma unroll
    for (int i = 0; i < 2; ++i) { int R, C; stage_rc(tid * 16 + i * 8192, R, C); const int Rb = Epi::PERM ? ((R & ~31) + perm32(R & 31)) : R;
        voffA[i] = (unsigned)(R * K + C) * 2u; voffB[i] = (unsigned)(Rb * K + C) * 2u; }
    const size_t kstep = (size_t)(BK * 2);
    const size_t hstep = (size_t)HALF * K * 2;
    const size_t tstep = 2 * hstep;
    const unsigned ldsw = (unsigned)wid * 1024u;
    const int aoff = lds_byte(wr * 64 + fr, fq * 8), boff = lds_byte(wc * 32 + fr, fq * 8);
#define PG8_SA(b, h) (((b) * 2 + (h)) * HTB)
#define PG8_SB(b, h) ((4 + (b) * 2 + (h)) * HTB)
#define PG8_STAGE(bufoff, gbase, voff) do { _Pragma("unroll") for (int _i = 0; _i < 2; ++_i) \
        __builtin_amdgcn_global_load_lds((const unsigned*)((const char*)(gbase) + (voff)[_i]), (PG8_LAS unsigned*)(lds + (bufoff) + ldsw + _i * 8192), 16, 0, 0); } while (0)
#define PG8_LDA(dst, b, h) do { _Pragma("unroll") for (int m = 0; m < 4; ++m) _Pragma("unroll") for (int k = 0; k < 2; ++k) dst[m][k] = *(const PG8_LAS bf16x8*)(lds + PG8_SA(b, h) + aoff + m * 2048 + k * 1024); } while (0)
#define PG8_LDB(dst, b, h) do { _Pragma("unroll") for (int n = 0; n < 2; ++n) _Pragma("unroll") for (int k = 0; k < 2; ++k) dst[n][k] = *(const PG8_LAS bf16x8*)(lds + PG8_SB(b, h) + boff + n * 2048 + k * 1024); } while (0)
#define PG8_MMA(ai, bj, At, Bt) do { __builtin_amdgcn_s_setprio(1); _Pragma("unroll") for (int m = 0; m < 4; ++m) _Pragma("unroll") for (int n = 0; n < 2; ++n) _Pragma("unroll") for (int k = 0; k < 2; ++k) \
        acc[ai][bj][m][n] = __builtin_amdgcn_mfma_f32_16x16x32_bf16(Bt[n][k], At[m][k], acc[ai][bj][m][n], 0, 0, 0); __builtin_amdgcn_s_setprio(0); } while (0)
#define PG8_WAIT_V(n) asm volatile("s_waitcnt vmcnt(" #n ")" ::: "memory")
#define PG8_WAIT_L(n) asm volatile("s_waitcnt lgkmcnt(" #n ")" ::: "memory")
#define PG8_BAR __builtin_amdgcn_s_barrier()
#define PG8_SCHED __builtin_amdgcn_sched_barrier(0)
    Unit cur, nxt; int ui = 0;
    if (!S.next(0, cur)) return;
    f32x4 acc[2][2][4][2];
#pragma unroll
    for (int a = 0; a < 2; ++a)
#pragma unroll
        for (int b = 0; b < 2; ++b)
#pragma unroll
            for (int m = 0; m < 4; ++m)
#pragma unroll
                for (int n = 0; n < 2; ++n) acc[a][b][m][n] = (f32x4){0.f, 0.f, 0.f, 0.f};
    bf16x8 At[4][2], B0[2][2], B1[2][2];
    const char* cA = (const char*)g.A + (size_t)cur.pm * tstep; const char* cB = (const char*)g.Bt + (size_t)cur.pn * tstep;
    S.a_ready(cur);
    if constexpr (SP2) {
        PG8_STAGE(PG8_SB(0, 0), cB, voffB); PG8_STAGE(PG8_SB(0, 1), cB + hstep, voffB); PG8_STAGE(PG8_SA(0, 0), cA, voffA); PG8_STAGE(PG8_SA(0, 1), cA + hstep, voffA);
        if (wr == 1) PG8_BAR;
        PG8_WAIT_V(2); PG8_BAR;
        PG8_STAGE(PG8_SB(1, 0), cB + kstep, voffB); PG8_STAGE(PG8_SA(1, 0), cA + kstep, voffA); PG8_STAGE(PG8_SB(1, 1), cB + hstep + kstep, voffB);
        PG8_WAIT_V(6); PG8_BAR;
    } else {
        PG8_STAGE(PG8_SB(0, 0), cB, voffB); PG8_STAGE(PG8_SA(0, 0), cA, voffA); PG8_STAGE(PG8_SB(0, 1), cB + hstep, voffB); PG8_STAGE(PG8_SA(0, 1), cA + hstep, voffA);
        if (wr == 1) PG8_BAR;
        PG8_WAIT_V(4); PG8_BAR;
        PG8_STAGE(PG8_SB(1, 0), cB + kstep, voffB); PG8_STAGE(PG8_SA(1, 0), cA + kstep, voffA); PG8_STAGE(PG8_SB(1, 1), cB + hstep + kstep, voffB);
        PG8_WAIT_V(6); PG8_BAR;
    }
    for (;;) {
        const bool has_next = S.next(ui + 1, nxt);
        const char* nA = has_next ? (const char*)g.A + (size_t)nxt.pm * tstep : cA; const char* nB = has_next ? (const char*)g.Bt + (size_t)nxt.pn * tstep : cB;
        for (int t = 0; t < nt; t += 2) {
            const bool last = (t == nt - 2);
            const char* a1 = cA + (size_t)(t + 1) * kstep;
            const char* a2 = last ? nA : cA + (size_t)(t + 2) * kstep; const char* b2 = last ? nB : cB + (size_t)(t + 2) * kstep;
            const char* a3 = a2 + kstep; const char* b3 = b2 + kstep;
            if (last && has_next) S.a_ready(nxt);
            if constexpr (SP2) {
            PG8_LDB(B0, 0, 0); PG8_LDB(B1, 0, 1); PG8_SCHED; PG8_LDA(At, 0, 0); PG8_STAGE(PG8_SA(1, 1), a1 + hstep, voffA);
            PG8_WAIT_V(8); PG8_WAIT_L(0); PG8_BAR; PG8_MMA(0, 0, At, B0); PG8_MMA(0, 1, At, B1); PG8_BAR; PG8_SCHED;
            PG8_LDA(At, 0, 1); PG8_STAGE(PG8_SB(0, 0), b2, voffB); PG8_STAGE(PG8_SB(0, 1), b2 + hstep, voffB); PG8_STAGE(PG8_SA(0, 0), a2, voffA);
            PG8_WAIT_V(8); PG8_WAIT_L(0); PG8_BAR; PG8_MMA(1, 0, At, B0); PG8_MMA(1, 1, At, B1); PG8_BAR; PG8_SCHED;
            PG8_LDB(B0, 1, 0); PG8_LDB(B1, 1, 1); PG8_SCHED; PG8_LDA(At, 1, 0); PG8_STAGE(PG8_SA(0, 1), a2 + hstep, voffA);
            PG8_WAIT_V(8); PG8_WAIT_L(0); PG8_BAR; PG8_MMA(0, 0, At, B0); PG8_MMA(0, 1, At, B1); PG8_BAR; PG8_SCHED;
            PG8_LDA(At, 1, 1); PG8_STAGE(PG8_SB(1, 0), b3, voffB); PG8_STAGE(PG8_SB(1, 1), b3 + hstep, voffB); PG8_STAGE(PG8_SA(1, 0), a3, voffA);
            PG8_WAIT_V(8); PG8_WAIT_L(0); PG8_BAR; PG8_MMA(1, 0, At, B0); PG8_MMA(1, 1, At, B1); PG8_BAR; PG8_SCHED;
            } else {
            PG8_LDB(B0, 0, 0); PG8_SCHED; PG8_LDA(At, 0, 0); PG8_STAGE(PG8_SA(1, 1), a1 + hstep, voffA);
            PG8_WAIT_L(8); PG8_BAR; PG8_WAIT_L(0); PG8_MMA(0, 0, At, B0); PG8_BAR; PG8_SCHED;
            PG8_LDB(B1, 0, 1); PG8_STAGE(PG8_SB(0, 0), b2, voffB);
            PG8_BAR; PG8_WAIT_L(0); PG8_MMA(0, 1, At, B1); PG8_BAR;
            PG8_LDA(At, 0, 1); PG8_STAGE(PG8_SA(0, 0), a2, voffA);
            PG8_BAR; PG8_WAIT_L(0); PG8_MMA(1, 0, At, B0); PG8_BAR; PG8_SCHED;
            PG8_STAGE(PG8_SB(0, 1), b2 + hstep, voffB);
            PG8_WAIT_V(6); PG8_BAR; PG8_MMA(1, 1, At, B1); PG8_BAR;
            PG8_LDB(B0, 1, 0); PG8_SCHED; PG8_LDA(At, 1, 0); PG8_STAGE(PG8_SA(0, 1), a2 + hstep, voffA);
            PG8_WAIT_L(8); PG8_BAR; PG8_WAIT_L(0); PG8_MMA(0, 0, At, B0); PG8_BAR; PG8_SCHED;
            PG8_LDB(B1, 1, 1); PG8_STAGE(PG8_SB(1, 0), b3, voffB);
            PG8_BAR; PG8_WAIT_L(0); PG8_MMA(0, 1, At, B1); PG8_BAR;
            PG8_LDA(At, 1, 1); PG8_STAGE(PG8_SA(1, 0), a3, voffA);
            PG8_BAR; PG8_WAIT_L(0); PG8_MMA(1, 0, At, B0); PG8_BAR; PG8_SCHED;
            PG8_STAGE(PG8_SB(1, 1), b3 + hstep, voffB);
            PG8_WAIT_V(6); PG8_BAR; PG8_MMA(1, 1, At, B1); PG8_BAR;
            }
        }
        if constexpr (ALIGN_EPI) { if (wr == 0) PG8_BAR; }
        if constexpr (!Epi::AFTER_DRAIN) { E(acc, cur, wr, wc, fr, fq); S.done(cur); }
        if (!has_next) break;
#pragma unroll
        for (int a = 0; a < 2; ++a)
#pragma unroll
            for (int b = 0; b < 2; ++b)
#pragma unroll
                for (int m = 0; m < 4; ++m)
#pragma unroll
                    for (int n = 0; n < 2; ++n) acc[a][b][m][n] = (f32x4){0.f, 0.f, 0.f, 0.f};
        cur = nxt; cA = nA; cB = nB; ++ui;
        if constexpr (ALIGN_EPI) { if (wr == 1) PG8_BAR; }
    }
    PG8_WAIT_V(0);
    if constexpr (!ALIGN_EPI) { if (wr == 0) PG8_BAR; }
    PG8_BAR;
    if constexpr (Epi::AFTER_DRAIN) { E.fused(acc, cur, wr, wc, fr, fq, lds, wid, lane); S.done(cur); }
#undef PG8_SA
#undef PG8_SB
#undef PG8_STAGE
#undef PG8_LDA
#undef PG8_LDB
#undef PG8_MMA
#undef PG8_WAIT_V
#undef PG8_WAIT_L
#undef PG8_BAR
#undef PG8_SCHED
}
}

#define LAS __attribute__((address_space(3)))
using pg8::bf16_t; using pg8::bf16x8; using pg8::f32x4; using pg8::u32x4; using pg8::Unit;
typedef float f32x16 __attribute__((ext_vector_type(16)));
typedef float f32x2_t __attribute__((ext_vector_type(2)));
typedef __bf16 bf16x2_t __attribute__((ext_vector_type(2)));
typedef unsigned u32x2 __attribute__((ext_vector_type(2)));
#define MFMA32(a, b, c) __builtin_amdgcn_mfma_f32_32x32x16_bf16((a), (b), (c), 0, 0, 0)

constexpr int BATCH = 4, SEQ = 8192, DM = 1024, MTOK = BATCH * SEQ, FF = 4096, NQKV0 = 3072, NQKV1 = 2304, D1 = 768;
constexpr float ALPHA = 1.41421356237309505f, LN_EPS = 1e-5f, QSCALE = 0.125f * 1.4426950408889634f;
constexpr int NWAVES = 8, NTHR = 512;
constexpr int LIST_CAP = 126976;

constexpr size_t MiB = 1u << 20;
constexpr size_t WS_CTL = 0, CTL_BYTES = 2 * MiB;
constexpr size_t WS_KM = 128 * 1024, WS_BAR = 16 * 1024;
constexpr size_t WS_COS = 505 * MiB, WS_SIN = 506 * MiB;
constexpr size_t WS_C12 = 640 * 1024, WS_ST = 1 * MiB;
constexpr int NC12 = 4096 + 4096 + 2304, C_WIN0 = 0, C_WIN1 = 4096, C_QKV1 = 8192;
constexpr size_t WS_WQKV0 = 3 * MiB, WS_WO0 = 9 * MiB, WS_WQKV1 = 11 * MiB, WS_WO1 = 15 * MiB + 512 * 1024, WS_WIN0 = 17 * MiB, WS_WOUT0 = 25 * MiB, WS_WIN1 = 33 * MiB, WS_WOUT1 = 41 * MiB;
constexpr size_t WS_HB = 49 * MiB;
constexpr size_t WS_Q = 113 * MiB, WS_K = 177 * MiB, WS_VT = 241 * MiB, WS_PO = 305 * MiB, WS_PL = 497 * MiB;
constexpr size_t WS_H = 113 * MiB, WS_Z = 369 * MiB, WS_HB2 = 433 * MiB;
constexpr size_t WS_Q1 = 113 * MiB, WS_K1 = 161 * MiB, WS_VT1 = 209 * MiB, WS_PO1 = 257 * MiB, WS_PL1 = 305 * MiB;
constexpr size_t WS_DUMP = 401 * MiB, WS_END = 507 * MiB;
constexpr size_t OUT_PO3 = 0, OUT_LIST = 64 * MiB;

#ifndef DUPU
#define DUPU 1
#endif
#ifndef DUPQ0
#define DUPQ0 1
#endif
#ifndef DUPQ1
#define DUPQ1 1
#endif
#ifndef DUPG
#define DUPG 1
#endif
#ifndef G_ALIGN
#define G_ALIGN true
#endif
#ifndef G_SP2
#define G_SP2 true
#endif
#ifndef PHM
#define PHM 0xFFFFFFFFu
#endif
constexpr int RING_BYTES = 131072, LDS_BYTES = 147456, LDS_MISC = LDS_BYTES - 1024;

__device__ __forceinline__ unsigned pk2(float lo, float hi) { f32x2_t v = {lo, hi}; bf16x2_t b = __builtin_convertvector(v, bf16x2_t); return __builtin_bit_cast(unsigned, b); }
__device__ __forceinline__ float bf_lo(unsigned u) { return __uint_as_float(u << 16); }
__device__ __forceinline__ float bf_hi(unsigned u) { return __uint_as_float(u & 0xffff0000u); }
__device__ __forceinline__ int crow(int i, int hh) { return (i & 3) + 8 * (i >> 2) + 4 * hh; }
__device__ __forceinline__ float wave_sum(float v) {
#pragma unroll
    for (int o = 1; o < 64; o <<= 1) v += __shfl_xor(v, o);
    return v;
}
#define LDS_WAIT() asm volatile("s_waitcnt lgkmcnt(0)" ::: "memory")
__device__ __forceinline__ int qkv_phys(int c) { return (c & ~255) + ((c & 32) ? 128 : 0) + (((c >> 6) & 3) << 5) + (c & 31); }
__device__ __forceinline__ int swz16(int r) { return (r & ~12) | ((r & 4) << 1) | ((r & 8) >> 1); }

#define ROW_STATS(st_, row_, mu_, rs_) do { const f32x2_t sv_ = *(const f32x2_t*)((st_) + (size_t)(row_) * 2); (mu_) = sv_.x * (1.0f / DM); (rs_) = 1.0f / sqrtf(sv_.y * (1.0f / DM) - (mu_) * (mu_) + LN_EPS); } while (0)
template <int LAYER> struct EpiQKV {
    static constexpr bool PERM = true, AFTER_DRAIN = false;
    bf16_t* Q; bf16_t* Kb; bf16_t* VT; float* KM; const float* cs; const float* sn; const float* st; const float* c1; const float* c2;
    __device__ __forceinline__ void operator()(const f32x4 (&acc)[2][2][4][2], const Unit& u, int wr, int wc, int fr, int fq) const {
        constexpr int NT = LAYER == 0 ? 4 : 3, PITCH = NT * 256, NH = NT * 4;
        const int which = u.pn / NT, hg = u.pn - which * NT, head = hg * 4 + wc, e0 = 8 * fq;
        const int dsh = LAYER == 0 ? 0 : 2 * hg;
        const int rowb = u.pm * 256 + wr * 64 + fr;
        f32x4 c1v[2][2], c2v[2][2]; f32x2_t svc = {0.f, 0.f}, svn = {0.f, 0.f};
        if (LAYER == 1) {
#pragma unroll
            for (int bj = 0; bj < 2; ++bj)
#pragma unroll
                for (int n = 0; n < 2; ++n) { const int cc = u.pn * 256 + bj * 128 + wc * 32 + e0 + 4 * n; c1v[bj][n] = *(const f32x4*)(c1 + cc); c2v[bj][n] = *(const f32x4*)(c2 + cc); }
            svc = *(const f32x2_t*)(st + (size_t)rowb * 2);
        }
#define QKV_AFF(a_, bj_, n_) (LAYER == 1 ? ((a_) - mu * c1v[bj_][n_]) * rstd + c2v[bj_][n_] : (a_))
        if (which < 2) {
            bf16_t* dst = which == 0 ? Q : Kb; const float sc = which == 0 ? QSCALE : 1.f;
            f32x4 ks[2][2];
#pragma unroll
            for (int a = 0; a < 2; ++a)
#pragma unroll
                for (int b = 0; b < 2; ++b) ks[a][b] = (f32x4){0.f, 0.f, 0.f, 0.f};
            f32x4 tc[4], tn[4];
            { const int t = rowb & 8191; tc[0] = *(const f32x4*)(cs + t * 32 + e0); tc[1] = *(const f32x4*)(cs + t * 32 + e0 + 4); tc[2] = *(const f32x4*)(sn + t * 32 + e0); tc[3] = *(const f32x4*)(sn + t * 32 + e0 + 4); }
#pragma unroll
            for (int q = 0; q < 8; ++q) {
                const int ai = q >> 2, m = q & 3;
                const int row = rowb + ai * 128 + m * 16, b = row >> 13, t = row & 8191;
                if (q + 1 < 8) { const int t2 = (rowb + ((q + 1) >> 2) * 128 + ((q + 1) & 3) * 16) & 8191;
                    tn[0] = *(const f32x4*)(cs + t2 * 32 + e0); tn[1] = *(const f32x4*)(cs + t2 * 32 + e0 + 4); tn[2] = *(const f32x4*)(sn + t2 * 32 + e0); tn[3] = *(const f32x4*)(sn + t2 * 32 + e0 + 4);
                    if (LAYER == 1) svn = *(const f32x2_t*)(st + (size_t)(rowb + ((q + 1) >> 2) * 128 + ((q + 1) & 3) * 16) * 2); }
                const int rr = ((t & ((1 << dsh) - 1)) << (13 - dsh)) | (t >> dsh);
                const f32x4 c0 = tc[0], c1_ = tc[1], s0 = tc[2], s1 = tc[3];
                const float mu = LAYER == 1 ? svc.x * (1.0f / DM) : 0.f, rstd = LAYER == 1 ? 1.0f / sqrtf(svc.y * (1.0f / DM) - mu * mu + LN_EPS) : 1.f;
                const f32x4 x1a = QKV_AFF(acc[ai][0][m][0], 0, 0), x1b = QKV_AFF(acc[ai][0][m][1], 0, 1), x2a = QKV_AFF(acc[ai][1][m][0], 1, 0), x2b = QKV_AFF(acc[ai][1][m][1], 1, 1);
                const f32x4 o1a = (x1a * c0 - x2a * s0) * sc, o1b = (x1b * c1_ - x2b * s1) * sc, o2a = (x2a * c0 + x1a * s0) * sc, o2b = (x2b * c1_ + x1b * s1) * sc;
                bf16_t* p = dst + (size_t)(b * 8192 + rr) * PITCH + head * 64 + e0;
                u32x4 w; w.x = pk2(o1a[0], o1a[1]); w.y = pk2(o1a[2], o1a[3]); w.z = pk2(o1b[0], o1b[1]); w.w = pk2(o1b[2], o1b[3]);
                *(u32x4*)p = w;
                w.x = pk2(o2a[0], o2a[1]); w.y = pk2(o2a[2], o2a[3]); w.z = pk2(o2b[0], o2b[1]); w.w = pk2(o2b[2], o2b[3]);
                *(u32x4*)(p + 32) = w;
                if (LAYER == 0 && which == 1) { ks[0][0] += o1a; ks[0][1] += o1b; ks[1][0] += o2a; ks[1][1] += o2b; }
                asm volatile("" ::: "memory");
#pragma unroll
                for (int k = 0; k < 4; ++k) tc[k] = tn[k];
                svc = svn;
            }
            if (LAYER == 0 && which == 1) {
                const int b = u.pm >> 5, blk = u.pm & 31;
                float* kmp = KM + ((size_t)((b * 16 + head) * 32 + blk)) * 64; float kmv = 0.f;
#pragma unroll
                for (int a = 0; a < 2; ++a)
#pragma unroll
                    for (int n = 0; n < 2; ++n)
#pragma unroll
                        for (int i = 0; i < 4; ++i) {
                            float v = ks[a][n][i];
                            v += __shfl_xor(v, 1); v += __shfl_xor(v, 2); v += __shfl_xor(v, 4); v += __shfl_xor(v, 8);
                            if (fr == a * 8 + n * 4 + i) kmv = v;
                        }
                __hip_atomic_fetch_add(kmp + (fr >> 3) * 32 + e0 + (fr & 7), kmv * (1.0f / 256.0f), __ATOMIC_RELAXED, __HIP_MEMORY_SCOPE_AGENT);
            }
        } else {
#pragma unroll
            for (int q = 0; q < 8; ++q) {
                const int ai = q >> 2, m = q & 3;
                const int row = rowb + ai * 128 + m * 16, b = row >> 13, t = row & 8191;
                const int rr = ((t & ((1 << dsh) - 1)) << (13 - dsh)) | (t >> dsh);
                bf16_t* p = VT + ((size_t)(b * NH + head) * 64 + e0) * 8192 + swz16(rr);
                if (LAYER == 1 && q + 1 < 8) svn = *(const f32x2_t*)(st + (size_t)(rowb + ((q + 1) >> 2) * 128 + ((q + 1) & 3) * 16) * 2);
                const float mu = LAYER == 1 ? svc.x * (1.0f / DM) : 0.f, rstd = LAYER == 1 ? 1.0f / sqrtf(svc.y * (1.0f / DM) - mu * mu + LN_EPS) : 1.f;
#pragma unroll
                for (int bj = 0; bj < 2; ++bj)
#pragma unroll
                    for (int n = 0; n < 2; ++n) { const f32x4 yv = QKV_AFF(acc[ai][bj][m][n], bj, n);
#pragma unroll
                        for (int i = 0; i < 4; ++i) p[(size_t)(bj * 32 + 4 * n + i) * 8192] = (bf16_t)(pk2(yv[i], 0.f) & 0xffffu); }
                svc = svn;
            }
        }
#undef QKV_AFF
    }
};
struct EpiSqRelu {
    static constexpr bool PERM = true, AFTER_DRAIN = false;
    bf16_t* O; int ldc; const float* st; const float* c1; const float* c2;
    __device__ __forceinline__ void operator()(const f32x4 (&acc)[2][2][4][2], const Unit& u, int wr, int wc, int fr, int fq) const {
        const int row0 = u.pm * 256 + wr * 64 + fr, col0 = u.pn * 256 + wc * 32 + 8 * fq;
        f32x4 c1v[2][2], c2v[2][2]; float mus[8], rss[8];
#pragma unroll
        for (int bj = 0; bj < 2; ++bj)
#pragma unroll
            for (int n = 0; n < 2; ++n) { c1v[bj][n] = *(const f32x4*)(c1 + col0 + bj * 128 + 4 * n); c2v[bj][n] = *(const f32x4*)(c2 + col0 + bj * 128 + 4 * n); }
#pragma unroll
        for (int q = 0; q < 8; ++q) ROW_STATS(st, row0 + (q >> 2) * 128 + (q & 3) * 16, mus[q], rss[q]);
#pragma unroll
        for (int ai = 0; ai < 2; ++ai)
#pragma unroll
            for (int m = 0; m < 4; ++m) { const int row = row0 + ai * 128 + m * 16; bf16_t* rowp = O + (size_t)row * ldc + col0;
                const float mu = mus[ai * 4 + m], rstd = rss[ai * 4 + m];
#pragma unroll
                for (int bj = 0; bj < 2; ++bj) { f32x4 v0 = (acc[ai][bj][m][0] - mu * c1v[bj][0]) * rstd + c2v[bj][0], v1 = (acc[ai][bj][m][1] - mu * c1v[bj][1]) * rstd + c2v[bj][1];
#pragma unroll
                    for (int i = 0; i < 4; ++i) { const float a = fmaxf(v0[i], 0.f), b = fmaxf(v1[i], 0.f); v0[i] = a * a; v1[i] = b * b; }
                    u32x4 w; w.x = pk2(v0[0], v0[1]); w.y = pk2(v0[2], v0[3]); w.z = pk2(v1[0], v1[1]); w.w = pk2(v1[2], v1[3]);
                    __builtin_nontemporal_store(w, (u32x4*)(rowp + bj * 128)); } }
    }
};
template <int MODE> struct EpiResid {
    static constexpr bool PERM = true, AFTER_DRAIN = false;
    const bf16_t* R; bf16_t* Z; const float* stp; float* stc; const float* g; const float* b;
    __device__ __forceinline__ void operator()(const f32x4 (&acc)[2][2][4][2], const Unit& u, int wr, int wc, int fr, int fq) const {
        const int row0 = u.pm * 256 + wr * 64 + fr, col0 = u.pn * 256 + wc * 32 + 8 * fq;
        const bf16_t* src = MODE == 1 ? (const bf16_t*)Z : R;
        f32x4 gv[2][2], bv[2][2]; f32x2_t svc = {0.f, 0.f}, svn = {0.f, 0.f};
        u32x4 rc[2], rn[2]; float sq[8];
#define RES_LD(p_) (MODE == 0 ? __builtin_nontemporal_load((const u32x4*)(p_)) : *(const u32x4*)(p_))
        rc[0] = RES_LD(src + (size_t)row0 * DM + col0); rc[1] = RES_LD(src + (size_t)row0 * DM + col0 + 128);
        if (MODE == 1) {
#pragma unroll
            for (int bj = 0; bj < 2; ++bj)
#pragma unroll
                for (int n = 0; n < 2; ++n) { gv[bj][n] = *(const f32x4*)(g + col0 + bj * 128 + 4 * n); bv[bj][n] = *(const f32x4*)(b + col0 + bj * 128 + 4 * n); }
            svc = *(const f32x2_t*)(stp + (size_t)row0 * 2);
        }
#pragma unroll
        for (int q = 0; q < 8; ++q) {
            const int ai = q >> 2, m = q & 3, row = row0 + ai * 128 + m * 16; const size_t off = (size_t)row * DM + col0;
            if (q + 1 < 8) { const int row2 = row0 + ((q + 1) >> 2) * 128 + ((q + 1) & 3) * 16; const size_t off2 = (size_t)row2 * DM + col0; rn[0] = RES_LD(src + off2); rn[1] = RES_LD(src + off2 + 128);
                if (MODE == 1) svn = *(const f32x2_t*)(stp + (size_t)row2 * 2); }
            const float mu = MODE == 1 ? svc.x * (1.0f / DM) : 0.f, rstd = MODE == 1 ? 1.0f / sqrtf(svc.y * (1.0f / DM) - mu * mu + LN_EPS) : 1.f;
            float s1 = 0.f, s2 = 0.f;
#pragma unroll
            for (int bj = 0; bj < 2; ++bj) { const u32x4 rv = rc[bj];
                f32x4 h0 = (f32x4){bf_lo(rv.x), bf_hi(rv.x), bf_lo(rv.y), bf_hi(rv.y)}, h1 = (f32x4){bf_lo(rv.z), bf_hi(rv.z), bf_lo(rv.w), bf_hi(rv.w)};
                if (MODE == 1) { h0 = (h0 - mu) * rstd * gv[bj][0] + bv[bj][0]; h1 = (h1 - mu) * rstd * gv[bj][1] + bv[bj][1]; }
                const f32x4 z0 = ALPHA * h0 + acc[ai][bj][m][0], z1 = ALPHA * h1 + acc[ai][bj][m][1];
                u32x4 w; w.x = pk2(z0[0], z0[1]); w.y = pk2(z0[2], z0[3]); w.z = pk2(z1[0], z1[1]); w.w = pk2(z1[2], z1[3]);
                *(u32x4*)(Z + off + bj * 128) = w;
                const float r0 = bf_lo(w.x), r1 = bf_hi(w.x), r2 = bf_lo(w.y), r3 = bf_hi(w.y), r4 = bf_lo(w.z), r5 = bf_hi(w.z), r6 = bf_lo(w.w), r7 = bf_hi(w.w);
                s1 += ((r0 + r1) + (r2 + r3)) + ((r4 + r5) + (r6 + r7));
                s2 += ((r0 * r0 + r1 * r1) + (r2 * r2 + r3 * r3)) + ((r4 * r4 + r5 * r5) + (r6 * r6 + r7 * r7)); }
            s1 += __shfl_xor(s1, 16); s1 += __shfl_xor(s1, 32); s2 += __shfl_xor(s2, 16); s2 += __shfl_xor(s2, 32);
            sq[q] = (fq & 1) ? s2 : s1;
            asm volatile("" ::: "memory");
            rc[0] = rn[0]; rc[1] = rn[1]; svc = svn;
        }
#pragma unroll
        for (int p = 0; p < 4; ++p) {
            const int qa = 2 * p, qb = 2 * p + 1;
            const float val = (fq < 2) ? sq[qa] : sq[qb];
            const int rowp = row0 + ((fq < 2) ? ((qa >> 2) * 128 + (qa & 3) * 16) : ((qb >> 2) * 128 + (qb & 3) * 16));
            __hip_atomic_fetch_add(stc + (size_t)rowp * 2 + (fq & 1), val, __ATOMIC_RELAXED, __HIP_MEMORY_SCOPE_AGENT);
        }
    }
};

template <bool PERMQ, bool SCALED> __device__ __forceinline__ void transpose_item(const float* W, int K, int N, bf16_t* WT, LAS float* scr, int item, int lane, const float* gk, const float* bk, float* c1, float* c2) {
    const int nblk = N / 32, kb = item / nblk, nb = item % nblk, k0 = 64 * kb, n0 = 32 * nb;
    float p1 = 0.f, p2 = 0.f;
#pragma unroll 8
    for (int i = 0; i < 32; ++i) { const int kk = 2 * i + (lane >> 5); float v = __builtin_nontemporal_load(W + (size_t)(k0 + kk) * N + n0 + (lane & 31));
        if (SCALED) { p2 += v * bk[k0 + kk]; v *= gk[k0 + kk]; p1 += bf_lo(pk2(v, 0.f)); }
        scr[kk * 33 + (lane & 31)] = v; }
    LDS_WAIT();
    if (SCALED) { p1 += __shfl_xor(p1, 32); p2 += __shfl_xor(p2, 32);
        if (lane < 32) { const int oc = PERMQ ? qkv_phys(n0 + lane) : (n0 + lane); __hip_atomic_fetch_add(c1 + oc, p1, __ATOMIC_RELAXED, __HIP_MEMORY_SCOPE_AGENT); __hip_atomic_fetch_add(c2 + oc, p2, __ATOMIC_RELAXED, __HIP_MEMORY_SCOPE_AGENT); } }
    const int c = lane & 7;
#pragma unroll
    for (int j = 0; j < 4; ++j) { const int n = (lane >> 3) + 8 * j; const LAS float* sp = scr + (8 * c) * 33 + n;
        u32x4 o; o.x = pk2(sp[0 * 33], sp[1 * 33]); o.y = pk2(sp[2 * 33], sp[3 * 33]); o.z = pk2(sp[4 * 33], sp[5 * 33]); o.w = pk2(sp[6 * 33], sp[7 * 33]);
        const int orow = PERMQ ? qkv_phys(n0 + n) : (n0 + n);
        *(u32x4*)(WT + (size_t)orow * K + k0 + 8 * c) = o; }
    LDS_WAIT();
}

template <bool F32OUT> __device__ __forceinline__ void ln_phase(const bf16_t* Z, const float* g, const float* bt, bf16_t* ob, float* of, int gw, int ngw, int lane) {
    f32x4 gv[4], bv[4];
#pragma unroll
    for (int q = 0; q < 2; ++q) { gv[2 * q] = *(const f32x4*)(g + 512 * q + 8 * lane); gv[2 * q + 1] = *(const f32x4*)(g + 512 * q + 8 * lane + 4);
                                  bv[2 * q] = *(const f32x4*)(bt + 512 * q + 8 * lane); bv[2 * q + 1] = *(const f32x4*)(bt + 512 * q + 8 * lane + 4); }
    for (int row = gw; row < MTOK; row += ngw) {
        const bf16_t* zr = Z + (size_t)row * DM + 8 * lane;
        const u32x4 a = __builtin_nontemporal_load((const u32x4*)zr), b = __builtin_nontemporal_load((const u32x4*)(zr + 512));
        float v[16] = {bf_lo(a.x), bf_hi(a.x), bf_lo(a.y), bf_hi(a.y), bf_lo(a.z), bf_hi(a.z), bf_lo(a.w), bf_hi(a.w),
                       bf_lo(b.x), bf_hi(b.x), bf_lo(b.y), bf_hi(b.y), bf_lo(b.z), bf_hi(b.z), bf_lo(b.w), bf_hi(b.w)};
        float s = 0.f;
#pragma unroll
        for (int i = 0; i < 16; ++i) s += v[i];
        const float mean = wave_sum(s) * (1.0f / DM);
        float q = 0.f;
#pragma unroll
        for (int i = 0; i < 16; ++i) { v[i] -= mean; q += v[i] * v[i]; }
        const float rstd = 1.0f / sqrtf(wave_sum(q) * (1.0f / DM) + LN_EPS);
#pragma unroll
        for (int i = 0; i < 16; ++i) v[i] = v[i] * rstd * gv[i >> 2][i & 3] + bv[i >> 2][i & 3];
        if (F32OUT) {
            float* orow = of + (size_t)row * DM + 8 * lane;
            __builtin_nontemporal_store((f32x4){v[0], v[1], v[2], v[3]}, (f32x4*)orow); __builtin_nontemporal_store((f32x4){v[4], v[5], v[6], v[7]}, (f32x4*)(orow + 4));
            __builtin_nontemporal_store((f32x4){v[8], v[9], v[10], v[11]}, (f32x4*)(orow + 512)); __builtin_nontemporal_store((f32x4){v[12], v[13], v[14], v[15]}, (f32x4*)(orow + 516));
        } else {
            bf16_t* orow = ob + (size_t)row * DM + 8 * lane;
            u32x4 w; w.x = pk2(v[0], v[1]); w.y = pk2(v[2], v[3]); w.z = pk2(v[4], v[5]); w.w = pk2(v[6], v[7]); *(u32x4*)orow = w;
            w.x = pk2(v[8], v[9]); w.y = pk2(v[10], v[11]); w.z = pk2(v[12], v[13]); w.w = pk2(v[14], v[15]); *(u32x4*)(orow + 512) = w;
        }
    }
}

constexpr int KPB = 144;
template <int NKT, int MODE, int GT>
__device__ __forceinline__ void attn_rows(const LAS unsigned char* Kl, const LAS unsigned char* Vl, const int vpb, const bf16x8 (&qf)[4], const int r, const int hh, const int p0, const int p1,
                                          f32x16 (&o)[2], float& lse2) {
    constexpr int NG = (NKT + GT - 1) / GT;
    float mrun = -INFINITY, lrun = 0.f;
#pragma unroll
    for (int i = 0; i < 16; ++i) { o[0][i] = 0.f; o[1][i] = 0.f; }
#pragma unroll
    for (int grp = 0; grp < NG; ++grp) {
        constexpr int dummy = 0; (void)dummy;
        const int kt0 = grp * GT;
        const int nt = (NKT - kt0) < GT ? (NKT - kt0) : GT;
        const bool gact = MODE == 0 ? true : (MODE == 1 ? (kt0 <= p0) : (p1 != 0 || (p0 + kt0 + nt - 1 >= 4)));
        if (gact) {
            bf16x8 kf[GT][4];
#pragma unroll
            for (int q = 0; q < GT; ++q)
#pragma unroll
                for (int ks = 0; ks < 4; ++ks) if (q < nt) kf[q][ks] = *(const LAS bf16x8*)(Kl + ((kt0 + q) * 32 + r) * KPB + ks * 32 + hh * 16);
            f32x16 s[GT];
#pragma unroll
            for (int q = 0; q < GT; ++q)
#pragma unroll
                for (int i = 0; i < 16; ++i) s[q][i] = 0.f;
#pragma unroll
            for (int ks = 0; ks < 4; ++ks)
#pragma unroll
                for (int q = 0; q < GT; ++q) if (q < nt) s[q] = MFMA32(kf[q][ks], qf[ks], s[q]);
            bf16x8 vf[GT][2][2];
#pragma unroll
            for (int q = 0; q < GT; ++q)
#pragma unroll
                for (int s2 = 0; s2 < 2; ++s2)
#pragma unroll
                    for (int dt = 0; dt < 2; ++dt) if (q < nt) vf[q][s2][dt] = *(const LAS bf16x8*)(Vl + (dt * 32 + r) * vpb + ((kt0 + q) * 32 + s2 * 16 + hh * 8) * 2);
            if (MODE == 1) { if (p0 < 8) {
#pragma unroll
                for (int q = 0; q < GT; ++q) if (q < nt) { const int lim = (p0 - (kt0 + q)) * 32 + r;
#pragma unroll
                    for (int i = 0; i < 16; ++i) if (crow(i, hh) > lim) s[q][i] = -INFINITY; } } }
            if (MODE == 2) {
#pragma unroll
                for (int q = 0; q < GT; ++q) if (q < nt) { const int kt = kt0 + q;
                    if (kt == 0) {
#pragma unroll
                        for (int i = 0; i < 16; ++i) if (crow(i, hh) < r) s[q][i] = -INFINITY; }
                    if (kt == NKT - 1) {
#pragma unroll
                        for (int i = 0; i < 16; ++i) if (crow(i, hh) > r) s[q][i] = -INFINITY; } }
                if (p1 == 0) {
#pragma unroll
                    for (int q = 0; q < GT; ++q) if (q < nt) { if (p0 + kt0 + q < 4) {
#pragma unroll
                        for (int i = 0; i < 16; ++i) s[q][i] = -INFINITY; } } }
            }
            float mx = -INFINITY;
#pragma unroll
            for (int q = 0; q < GT; ++q) if (q < nt) {
#pragma unroll
                for (int i = 0; i < 16; ++i) mx = fmaxf(mx, s[q][i]); }
            mx = fmaxf(mx, __shfl_xor(mx, 32));
            const float mnew = fmaxf(mrun, mx);
            const float sc = __builtin_amdgcn_exp2f(mrun - mnew);
            mrun = mnew; lrun *= sc;
            if (grp > 0) {
#pragma unroll
                for (int i = 0; i < 16; ++i) { o[0][i] *= sc; o[1][i] *= sc; }
            }
#pragma unroll
            for (int q = 0; q < GT; ++q) if (q < nt) {
#pragma unroll
                for (int i = 0; i < 16; ++i) { const float p = __builtin_amdgcn_exp2f(s[q][i] - mnew); s[q][i] = p; lrun += p; }
#pragma unroll
                for (int s2 = 0; s2 < 2; ++s2) {
                    u32x4 pw; pw.x = pk2(s[q][8 * s2], s[q][8 * s2 + 1]); pw.y = pk2(s[q][8 * s2 + 2], s[q][8 * s2 + 3]); pw.z = pk2(s[q][8 * s2 + 4], s[q][8 * s2 + 5]); pw.w = pk2(s[q][8 * s2 + 6], s[q][8 * s2 + 7]);
                    const bf16x8 pf = __builtin_bit_cast(bf16x8, pw);
#pragma unroll
                    for (int dt = 0; dt < 2; ++dt) o[dt] = MFMA32(vf[q][s2][dt], pf, o[dt]);
                }
            }
        }
    }
    const float l = lrun + __shfl_xor(lrun, 32);
    const float inv = 1.0f / l;
#pragma unroll
    for (int i = 0; i < 16; ++i) { o[0][i] *= inv; o[1][i] *= inv; }
    lse2 = mrun + __builtin_amdgcn_logf(l);
}
__device__ __forceinline__ void store_o(bf16_t* dst, const f32x16 (&o)[2], int hh) {
#pragma unroll
    for (int dt = 0; dt < 2; ++dt)
#pragma unroll
        for (int g4 = 0; g4 < 4; ++g4) { u32x2 w; w.x = pk2(o[dt][4 * g4], o[dt][4 * g4 + 1]); w.y = pk2(o[dt][4 * g4 + 2], o[dt][4 * g4 + 3]); *(u32x2*)(dst + dt * 32 + 8 * g4 + 4 * hh) = w; }
}

constexpr int STG_PITCH = 144, STG_WAVE = 32 * STG_PITCH;
__device__ __forceinline__ void stage_o(LAS unsigned char* stg, const f32x16 (&o)[2], int r, int hh) {
#pragma unroll
    for (int dt = 0; dt < 2; ++dt)
#pragma unroll
        for (int g4 = 0; g4 < 4; ++g4) { u32x2 w; w.x = pk2(o[dt][4 * g4], o[dt][4 * g4 + 1]); w.y = pk2(o[dt][4 * g4 + 2], o[dt][4 * g4 + 3]); *(LAS u32x2*)(stg + r * STG_PITCH + dt * 64 + g4 * 16 + hh * 8) = w; }
    LDS_WAIT();
}
constexpr int STG8_PITCH = 80; constexpr float PO8_SCALE = 16.0f;
__device__ __forceinline__ void stage_o8(LAS unsigned char* stg, const f32x16 (&o)[2], int r, int hh) {
#pragma unroll
    for (int dt = 0; dt < 2; ++dt)
#pragma unroll
        for (int g4 = 0; g4 < 4; ++g4) {
            int w = __builtin_amdgcn_cvt_pk_fp8_f32(o[dt][4 * g4] * PO8_SCALE, o[dt][4 * g4 + 1] * PO8_SCALE, 0, false);
            w = __builtin_amdgcn_cvt_pk_fp8_f32(o[dt][4 * g4 + 2] * PO8_SCALE, o[dt][4 * g4 + 3] * PO8_SCALE, w, true);
            *(LAS int*)(stg + r * STG8_PITCH + dt * 32 + g4 * 8 + hh * 4) = w; }
    LDS_WAIT();
}
#define XB_TMO      128
#define XB_XCNT(j)  (256  + 64 * (j))
#define XB_XSUB(j)  (1280 + 64 * (j))
#define XB_XGEN(j)  (2304 + 64 * (j))
#define XB_TOP      3328
#define XB_TOPGEN   3392
#define XCD_BAR_WORDS 3456
#define XB_SPIN_CAP (1u << 18)

__device__ __forceinline__ unsigned xb_ld(unsigned* p)              { return __hip_atomic_load(p, __ATOMIC_RELAXED, __HIP_MEMORY_SCOPE_AGENT); }
__device__ __forceinline__ unsigned xb_add(unsigned* p, unsigned v) { return __hip_atomic_fetch_add(p, v, __ATOMIC_RELAXED, __HIP_MEMORY_SCOPE_AGENT); }
__device__ __forceinline__ unsigned xb_xcc_id() { return (unsigned)__builtin_amdgcn_s_getreg((3 << 11) | 20) & 0xFu; }
#define XB_SPIN(cond, bar) do { unsigned _sp = 0; while (cond) { __builtin_amdgcn_s_sleep(1); \
    if ((++_sp & 255u) == 0u) { if (xb_ld(&(bar)[XB_TMO])) break; if (_sp > XB_SPIN_CAP) { atomicAdd(&(bar)[XB_TMO], 1u); break; } } } } while (0)

struct XcdBarrier {
    unsigned* bar; unsigned x;
    volatile LAS unsigned* st;
};

__device__ __forceinline__ XcdBarrier xcd_barrier_post(unsigned* bar, volatile LAS unsigned* st) {
    XcdBarrier b; b.bar = bar; b.x = xb_xcc_id(); b.st = st;
    if (threadIdx.x == 0) (void)xb_add(&bar[XB_XCNT(b.x)], 1u);
    return b;
}
__device__ __forceinline__ void xcd_barrier_complete(unsigned* bar, unsigned x, unsigned& nloc, unsigned& nx) {
    const unsigned G = gridDim.x * gridDim.y * gridDim.z;
    unsigned sum, cnt, mine, sp = 0u;
    for (;;) {
        sum = 0u; cnt = 0u; mine = 0u;
#pragma unroll
        for (unsigned j = 0; j < 16; ++j) { const unsigned c = xb_ld(&bar[XB_XCNT(j)]); sum += c; cnt += (c > 0u) ? 1u : 0u; mine = (j == x) ? c : mine; }
        if (sum == G) break;
        __builtin_amdgcn_s_sleep(1);
        if ((++sp & 255u) == 0u) { if (xb_ld(&bar[XB_TMO])) break; if (sp > XB_SPIN_CAP) { atomicAdd(&bar[XB_TMO], 1u); break; } }
    }
    nloc = mine > 0u ? mine : 1u; nx = cnt > 0u ? cnt : 1u;
}

__device__ __forceinline__ void xcd_barrier(const XcdBarrier& b) {
    asm volatile("s_waitcnt vmcnt(0)" ::: "memory");
    __syncthreads();
    if (threadIdx.x == 0) {
        unsigned* bar = b.bar;
        __builtin_amdgcn_s_waitcnt(0);
        unsigned nloc = b.st[0], nx = b.st[1];
        if (nloc == 0u) { xcd_barrier_complete(bar, b.x, nloc, nx); b.st[0] = nloc; b.st[1] = nx; }
        const unsigned old = xb_add(&bar[XB_XSUB(b.x)], 1u);
        const unsigned gen = old / nloc;
        if (old + 1u == (gen + 1u) * nloc) {
            __builtin_amdgcn_fence(__ATOMIC_RELEASE, "agent");
            asm volatile("s_waitcnt vmcnt(0)" ::: "memory");
            const unsigned og = xb_add(&bar[XB_TOP], 1u);
            const unsigned tg = og / nx;
            if (og + 1u == (tg + 1u) * nx) xb_add(&bar[XB_TOPGEN], 1u);
            else XB_SPIN(xb_ld(&bar[XB_TOPGEN]) == tg, bar);
            __builtin_amdgcn_fence(__ATOMIC_ACQUIRE, "agent");
            xb_add(&bar[XB_XGEN(b.x)], 1u);
            asm volatile("s_waitcnt vmcnt(0)" ::: "memory");
        } else {
            XB_SPIN(xb_ld(&bar[XB_XGEN(b.x)]) == gen, bar);
            __builtin_amdgcn_fence(__ATOMIC_ACQUIRE, "agent");
            asm volatile("s_waitcnt vmcnt(0)" ::: "memory");
        }
    }
    __syncthreads();
}

struct Args { const float* in[11]; float* out; unsigned char* ws; int pad0, pad1; };

__global__ void __launch_bounds__(NTHR) hybrid_fwd(Args args) {
    extern __shared__ __attribute__((aligned(16))) unsigned char lds_raw[];
    LAS unsigned char* lds = (LAS unsigned char*)lds_raw;
    cg::grid_group grid = cg::this_grid();
    int tid = threadIdx.x, lane = tid & 63, wave = __builtin_amdgcn_readfirstlane(tid >> 6);
    const int G = gridDim.x, ngw = G * NWAVES; int gw = blockIdx.x * NWAVES + wave;
#define GRID_SYNC_CG() do { grid.sync(); asm volatile("" : "+v"(tid), "+v"(lane)); } while (0)
#define GRID_SYNC() do { xcd_barrier(xbar); asm volatile("" : "+v"(tid), "+v"(lane)); } while (0)
    if (tid < 2) ((LAS unsigned*)(lds + LDS_MISC + 256))[tid] = 0u;
    __syncthreads();
    const XcdBarrier xbar = xcd_barrier_post((unsigned*)(args.ws + WS_BAR), (volatile LAS unsigned*)(lds + LDS_MISC + 256));
    unsigned char* ws = args.ws;
    const float* x = args.in[0];
    bf16_t* Wqkv0 = (bf16_t*)(ws + WS_WQKV0); bf16_t* Wo0 = (bf16_t*)(ws + WS_WO0); bf16_t* Wqkv1 = (bf16_t*)(ws + WS_WQKV1); bf16_t* Wo1 = (bf16_t*)(ws + WS_WO1);
    float* cosT = (float*)(ws + WS_COS); float* sinT = (float*)(ws + WS_SIN);
    bf16_t* HB = (bf16_t*)(ws + WS_HB); bf16_t* Zb = (bf16_t*)(ws + WS_Z); bf16_t* Hm = (bf16_t*)(ws + WS_H);
    float* C1 = (float*)(ws + WS_C12); float* C2 = C1 + NC12; float* ST = (float*)(ws + WS_ST);
    unsigned* gcnt = (unsigned*)(ws + WS_CTL); float* KM = (float*)(ws + WS_KM);
    unsigned* LIST = (unsigned*)((unsigned char*)args.out + OUT_LIST); bf16_t* PO3 = (bf16_t*)((unsigned char*)args.out + OUT_PO3);

    if (PHM & 1u) {
        LAS float* scr = (LAS float*)(lds + wave * 16384);
        constexpr int I_QKV0 = (DM / 64) * (NQKV0 / 32), I_WO0 = (DM / 64) * (DM / 32), I_QKV1 = (DM / 64) * (NQKV1 / 32), I_WO1 = (D1 / 64) * (DM / 32), I_IN = (DM / 64) * (FF / 32), I_OUT = (FF / 64) * (DM / 32);
        constexpr int NITEMS = I_QKV0 + I_WO0 + I_QKV1 + I_WO1 + 2 * I_IN + 2 * I_OUT;
        for (int it = gw; it < NITEMS; it += ngw) {
            int rI = it;
            if (rI < I_QKV0) { transpose_item<true, false>(args.in[1], DM, NQKV0, Wqkv0, scr, rI, lane, nullptr, nullptr, nullptr, nullptr); continue; } rI -= I_QKV0;
            if (rI < I_WO0) { transpose_item<false, false>(args.in[2], DM, DM, Wo0, scr, rI, lane, nullptr, nullptr, nullptr, nullptr); continue; } rI -= I_WO0;
            if (rI < I_QKV1) { transpose_item<true, true>(args.in[3], DM, NQKV1, Wqkv1, scr, rI, lane, args.in[9], args.in[10], C1 + C_QKV1, C2 + C_QKV1); continue; } rI -= I_QKV1;
            if (rI < I_WO1) { transpose_item<false, false>(args.in[4], D1, DM, Wo1, scr, rI, lane, nullptr, nullptr, nullptr, nullptr); continue; } rI -= I_WO1;
            if (rI < 2 * I_IN) { const int l = rI / I_IN; transpose_item<false, true>(args.in[5] + (size_t)l * DM * FF, DM, FF, (bf16_t*)(ws + (l ? WS_WIN1 : WS_WIN0)), scr, rI - l * I_IN, lane, args.in[7] + l * DM, args.in[8] + l * DM, C1 + (l ? C_WIN1 : C_WIN0), C2 + (l ? C_WIN1 : C_WIN0)); continue; } rI -= 2 * I_IN;
            { const int l = rI / I_OUT; transpose_item<false, false>(args.in[6] + (size_t)l * DM * FF, FF, DM, (bf16_t*)(ws + (l ? WS_WOUT1 : WS_WOUT0)), scr, rI - l * I_OUT, lane, nullptr, nullptr, nullptr, nullptr); }
        }
        for (int idx = blockIdx.x * NTHR + tid; idx < SEQ * 32; idx += G * NTHR) {
            const int t = idx >> 5, e = idx & 31;
            const float inv = 1.0f / powf(10000.0f, (float)(2 * e) / 64.0f);
            const float ang = (float)t * inv;
            const double a = (double)ang, kk = rint(a * 0.15915494309189535), rd = fma(-kk, 6.283185307179586, a);
            const float rf = (float)rd;
            cosT[idx] = cosf(rf); sinT[idx] = sinf(rf);
        }
        for (int row = gw; row < MTOK; row += ngw) {
            const float* xr = x + (size_t)row * DM + 8 * lane;
            const f32x4 a0 = __builtin_nontemporal_load((const f32x4*)xr), a1 = __builtin_nontemporal_load((const f32x4*)(xr + 4)), b0 = __builtin_nontemporal_load((const f32x4*)(xr + 512)), b1 = __builtin_nontemporal_load((const f32x4*)(xr + 516));
            bf16_t* orow = HB + (size_t)row * DM + 8 * lane;
            u32x4 w; w.x = pk2(a0[0], a0[1]); w.y = pk2(a0[2], a0[3]); w.z = pk2(a1[0], a1[1]); w.w = pk2(a1[2], a1[3]); *(u32x4*)orow = w;
            w.x = pk2(b0[0], b0[1]); w.y = pk2(b0[2], b0[3]); w.z = pk2(b1[0], b1[1]); w.w = pk2(b1[2], b1[3]); *(u32x4*)(orow + 512) = w;
        }
    }
    __syncthreads();
    if (args.pad1 != 0) GRID_SYNC_CG();
    GRID_SYNC();

    bf16_t* Q0 = (bf16_t*)(ws + WS_Q); bf16_t* K0 = (bf16_t*)(ws + WS_K); bf16_t* VT0 = (bf16_t*)(ws + WS_VT); bf16_t* PO = (bf16_t*)(ws + WS_PO); float* PL = (float*)(ws + WS_PL);
    if (PHM & 2u) {
        pg8::Gemm g{HB, Wqkv0, MTOK, NQKV0, DM}; pg8::StaticOrder S; S.init(MTOK, NQKV0, G, (int)blockIdx.x);
        EpiQKV<0> E{Q0, K0, VT0, KM, cosT, sinT, nullptr, nullptr, nullptr};
        for (int repg = 0; repg < DUPG * DUPQ0; ++repg) pg8::gemm_phase<EpiQKV<0>, pg8::StaticOrder, G_ALIGN, G_SP2>(lds, g, S, E);
    }
    GRID_SYNC();
    if (PHM & 4u) {
        LAS unsigned* lcnt = (LAS unsigned*)(lds + LDS_MISC); LAS unsigned* lbase = lcnt + 32;
        const int r = lane & 31, hh = lane >> 5;
        for (int unit = blockIdx.x; unit < BATCH * 32 * 16; unit += G) {
            const int h = unit & 15, qb = (unit >> 4) & 31, b = unit >> 9;
            if (tid < 32) lcnt[tid] = 0u;
            __syncthreads();
            const int tq = qb * 256 + wave * 32 + r, token = b * 8192 + tq;
            bf16x8 qf[4];
#pragma unroll
            for (int ks = 0; ks < 4; ++ks) qf[ks] = *(const bf16x8*)(Q0 + (size_t)token * DM + h * 64 + ks * 16 + hh * 8);
            f32x16 gt;
#pragma unroll
            for (int i = 0; i < 16; ++i) gt[i] = 0.f;
            const float* kmr = KM + ((size_t)((b * 16 + h) * 32 + r)) * 64 + hh * 8;
#pragma unroll
            for (int ks = 0; ks < 4; ++ks) { const f32x4 k0 = *(const f32x4*)(kmr + ks * 16), k1 = *(const f32x4*)(kmr + ks * 16 + 4);
                u32x4 kw; kw.x = pk2(k0[0], k0[1]); kw.y = pk2(k0[2], k0[3]); kw.z = pk2(k1[0], k1[1]); kw.w = pk2(k1[2], k1[3]);
                gt = MFMA32(__builtin_bit_cast(bf16x8, kw), qf[ks], gt); }
            float v0 = -3.0e38f, v1 = -3.0e38f, v2 = -3.0e38f;
#define TOP_INS(val) do { float t_ = (val); const float a_ = fmaxf(v0, t_); t_ = fminf(v0, t_); v0 = a_; const float b_ = fmaxf(v1, t_); t_ = fminf(v1, t_); v1 = b_; v2 = fmaxf(v2, t_); } while (0)
#pragma unroll
            for (int i = 0; i < 16; ++i) { const int j = crow(i, hh); const float gv_ = j < qb ? gt[i] : -3.0e38f; TOP_INS(__uint_as_float((__float_as_uint(gv_) & ~31u) | (unsigned)j)); }
            { const float pv0 = __shfl_xor(v0, 32), pv1 = __shfl_xor(v1, 32), pv2 = __shfl_xor(v2, 32); TOP_INS(pv0); TOP_INS(pv1); TOP_INS(pv2); }
#undef TOP_INS
            const int i0 = (int)(__float_as_uint(v0) & 31u), i1 = (int)(__float_as_uint(v1) & 31u), i2 = (int)(__float_as_uint(v2) & 31u);
            const int nvalid = qb < 3 ? qb : 3;
            unsigned lp0 = 0, lp1 = 0, lp2 = 0;
            if (hh == 0) {
                if (0 < nvalid) lp0 = __hip_atomic_fetch_add(lcnt + i0, 1u, __ATOMIC_RELAXED, __HIP_MEMORY_SCOPE_WORKGROUP); else PL[((size_t)0 * MTOK + token) * 16 + h] = -INFINITY;
                if (1 < nvalid) lp1 = __hip_atomic_fetch_add(lcnt + i1, 1u, __ATOMIC_RELAXED, __HIP_MEMORY_SCOPE_WORKGROUP); else PL[((size_t)1 * MTOK + token) * 16 + h] = -INFINITY;
                if (2 < nvalid) lp2 = __hip_atomic_fetch_add(lcnt + i2, 1u, __ATOMIC_RELAXED, __HIP_MEMORY_SCOPE_WORKGROUP); else PL[((size_t)2 * MTOK + token) * 16 + h] = -INFINITY;
            }
            __syncthreads();
            if (tid < 32) { const unsigned c = lcnt[tid]; lbase[tid] = c ? __hip_atomic_fetch_add(gcnt + (b * 16 + h) * 32 + tid, c, __ATOMIC_RELAXED, __HIP_MEMORY_SCOPE_AGENT) : 0u; }
            __syncthreads();
            if (hh == 0) {
                unsigned* lst = LIST + (size_t)(b * 16 + h) * LIST_CAP;
                if (0 < nvalid) lst[256 * (31 * i0 - (i0 * (i0 - 1)) / 2) + lbase[i0] + lp0] = (unsigned)tq | (0u << 13);
                if (1 < nvalid) lst[256 * (31 * i1 - (i1 * (i1 - 1)) / 2) + lbase[i1] + lp1] = (unsigned)tq | (1u << 13);
                if (2 < nvalid) lst[256 * (31 * i2 - (i2 * (i2 - 1)) / 2) + lbase[i2] + lp2] = (unsigned)tq | (2u << 13);
            }
        }
    }
    __syncthreads();
    GRID_SYNC();
#ifndef DUP3
#define DUP3 1
#endif
#ifndef DUP10
#define DUP10 1
#endif
    for (int rep3 = 0; rep3 < DUP3; ++rep3) {
        const LAS unsigned char* Kl = lds; const LAS unsigned char* Vl = lds + 256 * KPB; constexpr int VPB = (256 + 8) * 2;
        const int r = lane & 31, hh = lane >> 5;
        bf16_t* dump = (bf16_t*)(ws + WS_DUMP) + (size_t)((blockIdx.x & 255) * NWAVES + wave) * 2048;
        u32x4 kreg[4], vreg[4];
#define P3_LOADKV(b_, h_, j_) do { _Pragma("unroll") for (int i = 0; i < 4; ++i) { const int c = tid + NTHR * i; \
            kreg[i] = __builtin_nontemporal_load((const u32x4*)(K0 + (size_t)((b_) * 8192 + (j_) * 256 + (c >> 3)) * DM + (h_) * 64 + (c & 7) * 8)); \
            vreg[i] = __builtin_nontemporal_load((const u32x4*)(VT0 + ((size_t)((b_) * 16 + (h_)) * 64 + (c >> 5)) * 8192 + (j_) * 256 + (c & 31) * 8)); } } while (0)
        LAS int* sh_n = (LAS int*)(lds + LDS_MISC + 512); LAS int* sh_order = sh_n + 32; LAS int* sh_myj = sh_order + 32; LAS int* sh_cnt = sh_myj + 32;
      for (int v = blockIdx.x; v < 256; v += G) {
        const int bh = (v & 7) * 8 + (v >> 5), q4 = (v >> 3) & 3, b = bh >> 4, h = bh & 15;
        __syncthreads();
        if (tid < 32) sh_n[tid] = 256 + (int)gcnt[bh * 32 + tid] + 128;
        __syncthreads();
        if (tid < 32) { const int nj = sh_n[tid]; int rank = 0;
            for (int i = 0; i < 32; ++i) { const int ni = sh_n[i]; rank += (ni > nj || (ni == nj && i < tid)) ? 1 : 0; }
            sh_order[rank] = tid; }
        __syncthreads();
        if (tid == 0) { int l0 = 0, l1 = 0, l2 = 0, l3 = 0, cnt = 0;
            for (int k = 0; k < 32; ++k) { const int jx = sh_order[k], w = sh_n[jx];
                int bin = 0, lm = l0; if (l1 < lm) { lm = l1; bin = 1; } if (l2 < lm) { lm = l2; bin = 2; } if (l3 < lm) { lm = l3; bin = 3; }
                l0 += bin == 0 ? w : 0; l1 += bin == 1 ? w : 0; l2 += bin == 2 ? w : 0; l3 += bin == 3 ? w : 0;
                if (bin == q4) { sh_myj[cnt] = jx; ++cnt; } }
            sh_cnt[0] = cnt; }
        __syncthreads();
        const int nit = sh_cnt[0];
        const bf16_t* Qbh = Q0 + (size_t)b * 8192 * DM + h * 64 + hh * 8;
        bf16x8 qf[4];
        if (nit > 0) { const int j0 = sh_myj[0]; P3_LOADKV(b, h, j0);
#pragma unroll
            for (int ks = 0; ks < 4; ++ks) qf[ks] = *(const bf16x8*)(Qbh + (size_t)(j0 * 256 + wave * 32 + r) * DM + ks * 16); }
#define RAW_BARRIER() do { asm volatile("s_waitcnt lgkmcnt(0)" ::: "memory"); __builtin_amdgcn_s_barrier(); asm volatile("" ::: "memory"); } while (0)
        for (int it = 0; it < nit; ++it) {
            const int j = sh_myj[it], jn = (it + 1 < nit) ? sh_myj[it + 1] : -1;
            RAW_BARRIER();
#pragma unroll
            for (int i = 0; i < 4; ++i) { const int c = tid + NTHR * i;
                *(LAS u32x4*)(lds + (c >> 3) * KPB + (c & 7) * 16) = kreg[i];
                *(LAS u32x4*)(lds + 256 * KPB + (c >> 5) * VPB + (c & 31) * 16) = vreg[i]; }
            RAW_BARRIER();
            if (jn >= 0) P3_LOADKV(b, h, jn);
#ifdef P3_PROBE_OWNONLY
            const int n = (rep3 + 1 < DUP3) ? 256 : 256 + (int)gcnt[bh * 32 + j], ngroups = (n + 31) >> 5;
#else
            const int n = 256 + (int)gcnt[bh * 32 + j], ngroups = (n + 31) >> 5;
#endif
            const unsigned* lst = LIST + (size_t)bh * LIST_CAP + 256 * (31 * j - (j * (j - 1)) / 2);
            int g = wave;
            int tq = j * 256 + g * 32 + r, slot = 3; bool valid = true;
            const int tqN = (jn >= 0 ? jn : j) * 256 + wave * 32 + r;
            unsigned en = 0u; bool vn = false;
            if (g + 8 < ngroups) { const int row = (g + 8) * 32 + r; vn = row < n; en = lst[vn ? row - 256 : 0]; }
            for (; g < ngroups; g += NWAVES) {
                bf16x8 q1[4]; int tq1 = tqN, slot1 = 3; unsigned en2 = 0u; bool vn2 = false;
                if (g + 8 < ngroups) { tq1 = (int)(en & 8191u); slot1 = (int)(en >> 13); }
#pragma unroll
                for (int ks = 0; ks < 4; ++ks) q1[ks] = *(const bf16x8*)(Qbh + (size_t)tq1 * DM + ks * 16);
                if (g + 16 < ngroups) { const int row = (g + 16) * 32 + r; vn2 = row < n; en2 = lst[vn2 ? row - 256 : 0]; }
                f32x16 o[2]; float lse2;
                attn_rows<8, 1, 2>(Kl, Vl, VPB, qf, r, hh, g < 8 ? g : 99, 0, o, lse2);
                {
                    LAS unsigned char* stg = lds + 73728 + wave * STG_WAVE;
                    stage_o8(stg, o, r, hh);
                    const int myinfo = tq | (slot << 13) | (valid ? (1 << 15) : 0);
                    {
                        const int R = lane >> 1, half = lane & 1;
                        const u32x4 v0 = *(const LAS u32x4*)(stg + R * STG8_PITCH + half * 32), v1 = *(const LAS u32x4*)(stg + R * STG8_PITCH + half * 32 + 16);
                        const int info = __shfl(myinfo, R), tqR = info & 8191, slotR = (info >> 13) & 3;
                        unsigned char* dstp = (slotR == 3 ? (unsigned char*)PO3 : (unsigned char*)PO + (size_t)slotR * MTOK * DM) + ((size_t)b * 8192 + tqR) * DM + h * 64 + half * 32;
                        if (!(info & (1 << 15))) dstp = (unsigned char*)dump + lane * 32;
                        __builtin_nontemporal_store(v0, (u32x4*)dstp); __builtin_nontemporal_store(v1, (u32x4*)(dstp + 16));
                    }
                    { float* plp = PL + ((size_t)slot * MTOK + (size_t)b * 8192 + tq) * 16 + h; if (!valid) plp = (float*)(dump + 1024) + lane; *plp = lse2; }
                }
#pragma unroll
                for (int ks = 0; ks < 4; ++ks) qf[ks] = q1[ks];
                tq = tq1; slot = slot1; valid = vn; en = en2; vn = vn2;
            }
        }
      }
#undef P3_LOADKV
#undef RAW_BARRIER
    }
    __syncthreads();
    GRID_SYNC();
    if (PHM & 16u) {
        const int head = lane >> 2, part = lane & 3;
        for (int token = gw; token < MTOK; token += ngw) {
            float ls[4], mxl = -INFINITY;
#pragma unroll
            for (int s = 0; s < 4; ++s) { ls[s] = PL[((size_t)s * MTOK + token) * 16 + head]; mxl = fmaxf(mxl, ls[s]); }
            float accv[16], den = 0.f;
#pragma unroll
            for (int i = 0; i < 16; ++i) accv[i] = 0.f;
#pragma unroll
            for (int s = 0; s < 4; ++s) {
                const float w = __builtin_amdgcn_exp2f(ls[s] - mxl);
                if (w > 0.f) {
                    den += w;
                    const unsigned char* src = (s == 3 ? (const unsigned char*)PO3 : (const unsigned char*)PO + (size_t)s * MTOK * DM) + (size_t)token * DM + head * 64 + part * 16;
                    const u32x4 a = __builtin_nontemporal_load((const u32x4*)src);
                    const float ws_ = w * (1.0f / PO8_SCALE);
#pragma unroll
                    for (int k = 0; k < 4; ++k) { const f32x2_t lo = __builtin_amdgcn_cvt_pk_f32_fp8((int)a[k], false), hi = __builtin_amdgcn_cvt_pk_f32_fp8((int)a[k], true);
                        accv[4 * k] += ws_ * lo.x; accv[4 * k + 1] += ws_ * lo.y; accv[4 * k + 2] += ws_ * hi.x; accv[4 * k + 3] += ws_ * hi.y; }
                }
            }
            const float inv = 1.0f / den;
            bf16_t* dst = Q0 + (size_t)token * DM + head * 64 + part * 16;
            u32x4 w0, w1;
            w0.x = pk2(accv[0] * inv, accv[1] * inv); w0.y = pk2(accv[2] * inv, accv[3] * inv); w0.z = pk2(accv[4] * inv, accv[5] * inv); w0.w = pk2(accv[6] * inv, accv[7] * inv);
            w1.x = pk2(accv[8] * inv, accv[9] * inv); w1.y = pk2(accv[10] * inv, accv[11] * inv); w1.z = pk2(accv[12] * inv, accv[13] * inv); w1.w = pk2(accv[14] * inv, accv[15] * inv);
            *(u32x4*)dst = w0; *(u32x4*)(dst + 8) = w1;
        }
    }
    GRID_SYNC();
    if (PHM & 32u) {
        pg8::Gemm g{Q0, Wo0, MTOK, DM, DM}; pg8::StaticOrder S; S.init(MTOK, DM, G, (int)blockIdx.x);
        EpiResid<0> E{HB, Zb, nullptr, ST, nullptr, nullptr};
        for (int repg = 0; repg < DUPG; ++repg) pg8::gemm_phase<EpiResid<0>, pg8::StaticOrder, G_ALIGN, G_SP2>(lds, g, S, E);
    }
    GRID_SYNC();
    if (PHM & 64u) {
        pg8::Gemm g{Zb, (const bf16_t*)(ws + WS_WIN0), MTOK, FF, DM}; pg8::StaticOrder S; S.init(MTOK, FF, G, (int)blockIdx.x);
        EpiSqRelu E{Hm, FF, ST, C1 + C_WIN0, C2 + C_WIN0};
        for (int repg = 0; repg < DUPG * DUPU; ++repg) pg8::gemm_phase<EpiSqRelu, pg8::StaticOrder, G_ALIGN, G_SP2>(lds, g, S, E);
    }
    GRID_SYNC();
    {
        pg8::Gemm g{Hm, (const bf16_t*)(ws + WS_WOUT0), MTOK, DM, FF}; pg8::StaticOrder S; S.init(MTOK, DM, G, (int)blockIdx.x);
        EpiResid<1> E{nullptr, Zb, ST, ST + 2 * MTOK, args.in[7], args.in[8]};
        for (int repg = 0; repg < DUPG; ++repg) pg8::gemm_phase<EpiResid<1>, pg8::StaticOrder, G_ALIGN, G_SP2>(lds, g, S, E);
    }
    GRID_SYNC();

    bf16_t* Q1 = (bf16_t*)(ws + WS_Q1); bf16_t* K1 = (bf16_t*)(ws + WS_K1); bf16_t* VT1 = (bf16_t*)(ws + WS_VT1); bf16_t* PO1 = (bf16_t*)(ws + WS_PO1); float* PL1 = (float*)(ws + WS_PL1);
    if (PHM & 128u) {
        pg8::Gemm g{Zb, Wqkv1, MTOK, NQKV1, DM}; pg8::StaticOrder S; S.init(MTOK, NQKV1, G, (int)blockIdx.x);
        EpiQKV<1> E{Q1, K1, VT1, nullptr, cosT, sinT, ST + 2 * MTOK, C1 + C_QKV1, C2 + C_QKV1};
        for (int repg = 0; repg < DUPG * DUPQ1; ++repg) pg8::gemm_phase<EpiQKV<1>, pg8::StaticOrder, G_ALIGN, G_SP2>(lds, g, S, E);
    }
    GRID_SYNC();
    for (int rep10 = 0; rep10 < DUP10; ++rep10) {
        constexpr int VPB = (384 + 8) * 2; const int r = lane & 31, hh = lane >> 5;
        u32x4 kreg[6], vreg[6];
#define P10_DECODE(unit_, pp_, head_, b_, dsh_, gb_, hp_) const int pp_ = (unit_) & 31, head_ = ((unit_) >> 5) % 12, b_ = (unit_) / (32 * 12), dsh_ = 2 * (head_ >> 2), gb_ = 2 * pp_, hp_ = ((gb_ & ((64 >> dsh_) - 1)) != 0) ? 1 : 0
#define P10_LOAD(b_, head_, gb_, hp_) do { _Pragma("unroll") for (int i = 0; i < 6; ++i) { const int c = tid + NTHR * i; \
            { const int f = c >> 3, part = c & 7; kreg[i] = (u32x4){0u, 0u, 0u, 0u}; \
              if ((hp_) || f >= 128) kreg[i] = __builtin_nontemporal_load((const u32x4*)(K1 + ((size_t)(b_) * 8192 + ((gb_) - 1) * 128 + f) * D1 + (head_) * 64 + part * 8)); } \
            { const int d = c / 48, part = c - d * 48; vreg[i] = (u32x4){0u, 0u, 0u, 0u}; \
              if ((hp_) || part >= 16) vreg[i] = __builtin_nontemporal_load((const u32x4*)(VT1 + ((size_t)((b_) * 12 + (head_)) * 64 + d) * 8192 + ((gb_) - 1) * 128 + part * 8)); } } } while (0)
#define RAW_BARRIER() do { asm volatile("s_waitcnt lgkmcnt(0)" ::: "memory"); __builtin_amdgcn_s_barrier(); asm volatile("" ::: "memory"); } while (0)
        if ((int)blockIdx.x < BATCH * 12 * 32) { P10_DECODE((int)blockIdx.x, pp0, head0, b0, dsh0, gb0, hp0); P10_LOAD(b0, head0, gb0, hp0); }
        for (int unit = blockIdx.x; unit < BATCH * 12 * 32; unit += G) {
            P10_DECODE(unit, pp, head, b, dsh, gb, hasprev);
            bf16x8 qc[4];
#pragma unroll
            for (int ks = 0; ks < 4; ++ks) qc[ks] = *(const bf16x8*)(Q1 + ((size_t)b * 8192 + gb * 128 + wave * 32 + r) * D1 + head * 64 + ks * 16 + hh * 8);
            RAW_BARRIER();
#pragma unroll
            for (int i = 0; i < 6; ++i) { const int c = tid + NTHR * i;
                *(LAS u32x4*)(lds + (c >> 3) * KPB + (c & 7) * 16) = kreg[i];
                { const int d = c / 48, part = c - d * 48; *(LAS u32x4*)(lds + 384 * KPB + d * VPB + part * 16) = vreg[i]; } }
            RAW_BARRIER();
            if (unit + G < BATCH * 12 * 32) { P10_DECODE(unit + G, ppn, headn, bn, dshn, gbn, hpn); P10_LOAD(bn, headn, gbn, hpn); }
            const int rr = gb * 128 + wave * 32 + r;
            f32x16 o[2]; float lse2;
            attn_rows<5, 2, 2>(lds + wave * 32 * KPB, lds + 384 * KPB + wave * 64, VPB, qc, r, hh, wave, hasprev, o, lse2);
            const int t = ((rr & ((8192 >> dsh) - 1)) << dsh) | (rr >> (13 - dsh));
            const size_t token = (size_t)b * 8192 + t;
            {
                LAS unsigned char* stg = lds + 384 * KPB + 64 * VPB + wave * STG_WAVE;
                stage_o(stg, o, r, hh);
#pragma unroll
                for (int i = 0; i < 4; ++i) {
                    const int R = i * 8 + (lane >> 3), chunk = lane & 7;
                    const u32x4 vrow = *(const LAS u32x4*)(stg + R * STG_PITCH + chunk * 16);
                    const int tR = __shfl(t, R);
                    *(u32x4*)(PO1 + ((size_t)b * 8192 + tR) * D1 + head * 64 + chunk * 8) = vrow;
                }
            }
            PL1[token * 12 + head] = lse2;
        }
#undef P10_DECODE
#undef P10_LOAD
#undef RAW_BARRIER
    }
    __syncthreads();
    GRID_SYNC();
    {
        const int head = lane >> 2, part = lane & 3, hs = head & 3, gsel = head >> 2;
        for (int token = gw; token < MTOK; token += ngw) {
            if (lane < 48) {
                const float l0 = PL1[(size_t)token * 12 + hs], l1 = PL1[(size_t)token * 12 + 4 + hs], l2 = PL1[(size_t)token * 12 + 8 + hs];
                const float mxl = fmaxf(l0, fmaxf(l1, l2));
                const float w0 = __builtin_amdgcn_exp2f(l0 - mxl), w1 = __builtin_amdgcn_exp2f(l1 - mxl), w2 = __builtin_amdgcn_exp2f(l2 - mxl);
                const float al = (gsel == 0 ? w0 : (gsel == 1 ? w1 : w2)) / (w0 + w1 + w2);
                bf16_t* p = PO1 + (size_t)token * D1 + head * 64 + part * 16;
                u32x4 a = *(const u32x4*)p, c = *(const u32x4*)(p + 8);
                a.x = pk2(al * bf_lo(a.x), al * bf_hi(a.x)); a.y = pk2(al * bf_lo(a.y), al * bf_hi(a.y)); a.z = pk2(al * bf_lo(a.z), al * bf_hi(a.z)); a.w = pk2(al * bf_lo(a.w), al * bf_hi(a.w));
                c.x = pk2(al * bf_lo(c.x), al * bf_hi(c.x)); c.y = pk2(al * bf_lo(c.y), al * bf_hi(c.y)); c.z = pk2(al * bf_lo(c.z), al * bf_hi(c.z)); c.w = pk2(al * bf_lo(c.w), al * bf_hi(c.w));
                *(u32x4*)p = a; *(u32x4*)(p + 8) = c;
            }
        }
    }
    GRID_SYNC();
    {
        pg8::Gemm g{PO1, Wo1, MTOK, DM, D1}; pg8::StaticOrder S; S.init(MTOK, DM, G, (int)blockIdx.x);
        EpiResid<1> E{nullptr, Zb, ST + 2 * MTOK, ST + 4 * MTOK, args.in[9], args.in[10]};
        for (int repg = 0; repg < DUPG; ++repg) pg8::gemm_phase<EpiResid<1>, pg8::StaticOrder, G_ALIGN, G_SP2>(lds, g, S, E);
    }
    GRID_SYNC();
    {
        pg8::Gemm g{Zb, (const bf16_t*)(ws + WS_WIN1), MTOK, FF, DM}; pg8::StaticOrder S; S.init(MTOK, FF, G, (int)blockIdx.x);
        EpiSqRelu E{Hm, FF, ST + 4 * MTOK, C1 + C_WIN1, C2 + C_WIN1};
        for (int repg = 0; repg < DUPG * DUPU; ++repg) pg8::gemm_phase<EpiSqRelu, pg8::StaticOrder, G_ALIGN, G_SP2>(lds, g, S, E);
    }
    GRID_SYNC();
    {
        pg8::Gemm g{Hm, (const bf16_t*)(ws + WS_WOUT1), MTOK, DM, FF}; pg8::StaticOrder S; S.init(MTOK, DM, G, (int)blockIdx.x);
        EpiResid<1> E{nullptr, Zb, ST + 4 * MTOK, ST + 6 * MTOK, args.in[7] + DM, args.in[8] + DM};
        for (int repg = 0; repg < DUPG; ++repg) pg8::gemm_phase<EpiResid<1>, pg8::StaticOrder, G_ALIGN, G_SP2>(lds, g, S, E);
    }
    GRID_SYNC();
    ln_phase<true>(Zb, args.in[9] + DM, args.in[10] + DM, nullptr, args.out, gw, ngw, lane);
}

extern "C" void kernel_launch(void* const* d_in, const int* in_sizes, int n_in, void* d_out, int out_size, void* d_ws, size_t ws_size, hipStream_t stream) {
    static int grid_blocks = 0;
    if (grid_blocks == 0) {
        if (n_in != 11 || out_size != MTOK * DM || ws_size < WS_END) { fprintf(stderr, "kernel_launch: unexpected shapes (n_in %d, out %d, ws %zu)\n", n_in, out_size, ws_size); grid_blocks = -1; return; }
        int dev = 0, cus = 0, per_cu = 0;
        hipGetDevice(&dev);
        hipDeviceGetAttribute(&cus, hipDeviceAttributeMultiprocessorCount, dev);
        if (hipFuncSetAttribute((const void*)hybrid_fwd, hipFuncAttributeMaxDynamicSharedMemorySize, LDS_BYTES) != hipSuccess) { fprintf(stderr, "kernel_launch: hipFuncSetAttribute failed\n"); }
        if (hipOccupancyMaxActiveBlocksPerMultiprocessor(&per_cu, (const void*)hybrid_fwd, NTHR, LDS_BYTES) != hipSuccess || per_cu < 1) { fprintf(stderr, "kernel_launch: occupancy query says %d blocks per CU\n", per_cu); per_cu = 1; (void)hipGetLastError(); }
        if (per_cu > 1) per_cu = 1;
        grid_blocks = cus * per_cu;
    }
    if (grid_blocks < 0) return;
    (void)hipMemsetAsync((char*)d_ws + WS_CTL, 0, CTL_BYTES, stream);
    Args a{};
    for (int i = 0; i < 11; ++i) a.in[i] = (const float*)d_in[i];
    a.out = (float*)d_out; a.ws = (unsigned char*)d_ws;
    void* kargs[] = {&a};
    hipError_t e = hipLaunchCooperativeKernel((const void*)hybrid_fwd, dim3(grid_blocks), dim3(NTHR), kargs, LDS_BYTES, stream);
    if (e != hipSuccess) fprintf(stderr, "kernel_launch: cooperative launch failed: %s (grid %d)\n", hipGetErrorString(e), grid_blocks);
}
```

```cpp
#include <hip/hip_runtime.h>
#include <hip/hip_cooperative_groups.h>
#include <cstdio>
#include <cstdint>
namespace cg = cooperative_groups;
namespace pg8 {
#define PG8_LAS __attribute__((address_space(3)))
typedef unsigned short bf16_t;
typedef short bf16x8 __attribute__((ext_vector_type(8)));
typedef float f32x4 __attribute__((ext_vector_type(4)));
typedef unsigned u32x4 __attribute__((ext_vector_type(4)));
constexpr int BM = 256, BK = 64, HALF = 128, HTB = HALF * BK * 2  , STAGE_BYTES = 8 * HTB, NXCD = 8, WGM = 4;

__host__ __device__ __forceinline__ int lds_byte(int r, int c) { const int st = (r >> 4) * 2 + (c >> 5), rr = r & 15, cc = c & 31, ob = rr * 64 + cc * 2; return st * 1024 + (ob ^ (((ob >> 9) & 1) << 5)); }
__host__ __device__ __forceinline__ void stage_rc(int b, int& R, int& C) { const int st = b / 1024, sb = b % 1024, swz = sb ^ (((sb >> 9) & 1) << 5); R = (st >> 1) * 16 + swz / 64; C = (st & 1) * 32 + (swz % 64) / 2; }
__host__ __device__ __forceinline__ int perm32(int rho) { const int n = rho >> 4, i = rho & 15; return 8 * (i >> 2) + 4 * n + (i & 3); }

struct Unit { int pm, pn; };
struct Gemm { const bf16_t* A; const bf16_t* Bt; int M, N, K; };

struct StaticOrder {
    int nM, nN, nwg, G, c;
    __host__ __device__ void init(int M, int N, int G_, int c_) { nM = M / BM; nN = N / BM; nwg = nM * nN; G = G_; c = c_; }
    __host__ __device__ bool next(int i, Unit& u) const {
        const long L = (long)i * G + c; if (L >= nwg) return false;
        int wgid = (int)L; { const int q = nwg / NXCD, r = nwg % NXCD, xcd = wgid % NXCD, off = wgid / NXCD; wgid = (xcd < r ? xcd * (q + 1) : r * (q + 1) + (xcd - r) * q) + off; }
        const int nig = WGM * nN, gid = wgid / nig, fm = gid * WGM, gsz = (nM - fm) < WGM ? (nM - fm) : WGM;
        u.pm = fm + ((wgid % nig) % gsz); u.pn = (wgid % nig) / gsz; return true;
    }
    __device__ __forceinline__ void a_ready(const Unit&) const {}
    __device__ __forceinline__ void done(const Unit&) const {}
};


__device__ __forceinline__ unsigned cvt_pk_bf16(float lo, float hi) { unsigned r; asm volatile("v_cvt_pk_bf16_f32 %0, %1, %2" : "=v"(r) : "v"(lo), "v"(hi)); return r; }
typedef float f32x2 __attribute__((ext_vector_type(2)));

template <class Epi, class Sched, bool ALIGN_EPI = false, bool SP2 = false>
__device__ __forceinline__ void gemm_phase(PG8_LAS unsigned char* lds, const Gemm g, const Sched& S, const Epi& E) {
    int tid_ = threadIdx.x; asm volatile("" : "+v"(tid_));
    const int tid = tid_, wid = __builtin_amdgcn_readfirstlane(tid >> 6), lane = tid & 63, wr = wid >> 2, wc = wid & 3, fr = lane & 15, fq = lane >> 4;
    const int K = g.K, nt = K / BK;
    unsigned voffA[2], voffB[2];
#pragma unroll
    for (int i = 0; i < 2; ++i) { int R, C; stage_rc(tid * 16 + i * 8192, R, C); const int Rb = Epi::PERM ? ((R & ~31) + perm32(R & 31)) : R;
        voffA[i] = (unsigned)(R * K + C) * 2u; voffB[i] = (unsigned)(Rb * K + C) * 2u; }
    const size_t kstep = (size_t)(BK * 2);
    const size_t hstep = (size_t)HALF * K * 2;
    const size_t tstep = 2 * hstep;
    const unsigned ldsw = (unsigned)wid * 1024u;
    const int aoff = lds_byte(wr * 64 + fr, fq * 8), boff = lds_byte(wc * 32 + fr, fq * 8);
#define PG8_SA(b, h) (((b) * 2 + (h)) * HTB)
#define PG8_SB(b, h) ((4 + (b) * 2 + (h)) * HTB)
#define PG8_STAGE(bufoff, gbase, voff) do { _Pragma("unroll") for (int _i = 0; _i < 2; ++_i) \
        __builtin_amdgcn_global_load_lds((const unsigned*)((const char*)(gbase) + (voff)[_i]), (PG8_LAS unsigned*)(lds + (bufoff) + ldsw + _i * 8192), 16, 0, 0); } while (0)
#define PG8_LDA(dst, b, h) do { _Pragma("unroll") for (int m = 0; m < 4; ++m) _Pragma("unroll") for (int k = 0; k < 2; ++k) dst[m][k] = *(const PG8_LAS bf16x8*)(lds + PG8_SA(b, h) + aoff + m * 2048 + k * 1024); } while (0)
#define PG8_LDB(dst, b, h) do { _Pragma("unroll") for (int n = 0; n < 2; ++n) _Pragma("unroll") for (int k = 0; k < 2; ++k) dst[n][k] = *(const PG8_LAS bf16x8*)(lds + PG8_SB(b, h) + boff + n * 2048 + k * 1024); } while (0)
#define PG8_MMA(ai, bj, At, Bt) do { __builtin_amdgcn_s_setprio(1); _Pragma("unroll") for (int m = 0; m < 4; ++m) _Pragma("unroll") for (int n = 0; n < 2; ++n) _Pragma("unroll") for (int k = 0; k < 2; ++k) \
        acc[ai][bj][m][n] = __builtin_amdgcn_mfma_f32_16x16x32_bf16(Bt[n][k], At[m][k], acc[ai][bj][m][n], 0, 0, 0); __builtin_amdgcn_s_setprio(0); } while (0)
#define PG8_WAIT_V(n) asm volatile("s_waitcnt vmcnt(" #n ")" ::: "memory")
#define PG8_WAIT_L(n) asm volatile("s_waitcnt lgkmcnt(" #n ")" ::: "memory")
#define PG8_BAR __builtin_amdgcn_s_barrier()
#define PG8_SCHED __builtin_amdgcn_sched_barrier(0)
    Unit cur, nxt; int ui = 0;
    if (!S.next(0, cur)) return;
    f32x4 acc[2][2][4][2];
#pragma unroll
    for (int a = 0; a < 2; ++a)
#pragma unroll
        for (int b = 0; b < 2; ++b)
#pragma unroll
            for (int m = 0; m < 4; ++m)
#pragma unroll
                for (int n = 0; n < 2; ++n) acc[a][b][m][n] = (f32x4){0.f, 0.f, 0.f, 0.f};
    bf16x8 At[4][2], B0[2][2], B1[2][2];
    const char* cA = (const char*)g.A + (size_t)cur.pm * tstep; const char* cB = (const char*)g.Bt + (size_t)cur.pn * tstep;
    S.a_ready(cur);
    if constexpr (SP2) {
        PG8_STAGE(PG8_SB(0, 0), cB, voffB); PG8_STAGE(PG8_SB(0, 1), cB + hstep, voffB); PG8_STAGE(PG8_SA(0, 0), cA, voffA); PG8_STAGE(PG8_SA(0, 1), cA + hstep, voffA);
        if (wr == 1) PG8_BAR;
        PG8_WAIT_V(2); PG8_BAR;
        PG8_STAGE(PG8_SB(1, 0), cB + kstep, voffB); PG8_STAGE(PG8_SA(1, 0), cA + kstep, voffA); PG8_STAGE(PG8_SB(1, 1), cB + hstep + kstep, voffB);
        PG8_WAIT_V(6); PG8_BAR;
    } else {
        PG8_STAGE(PG8_SB(0, 0), cB, voffB); PG8_STAGE(PG8_SA(0, 0), cA, voffA); PG8_STAGE(PG8_SB(0, 1), cB + hstep, voffB); PG8_STAGE(PG8_SA(0, 1), cA + hstep, voffA);
        if (wr == 1) PG8_BAR;
        PG8_WAIT_V(4); PG8_BAR;
        PG8_STAGE(PG8_SB(1, 0), cB + kstep, voffB); PG8_STAGE(PG8_SA(1, 0), cA + kstep, voffA); PG8_STAGE(PG8_SB(1, 1), cB + hstep + kstep, voffB);
        PG8_WAIT_V(6); PG8_BAR;
    }
    for (;;) {
        const bool has_next = S.next(ui + 1, nxt);
        const char* nA = has_next ? (const char*)g.A + (size_t)nxt.pm * tstep : cA; const char* nB = has_next ? (const char*)g.Bt + (size_t)nxt.pn * tstep : cB;
        for (int t = 0; t < nt; t += 2) {
            const bool last = (t == nt - 2);
            const char* a1 = cA + (size_t)(t + 1) * kstep;
            const char* a2 = last ? nA : cA + (size_t)(t + 2) * kstep; const char* b2 = last ? nB : cB + (size_t)(t + 2) * kstep;
            const char* a3 = a2 + kstep; const char* b3 = b2 + kstep;
            if (last && has_next) S.a_ready(nxt);
            if constexpr (SP2) {
            PG8_LDB(B0, 0, 0); PG8_LDB(B1, 0, 1); PG8_SCHED; PG8_LDA(At, 0, 0); PG8_STAGE(PG8_SA(1, 1), a1 + hstep, voffA);
            PG8_WAIT_V(8); PG8_WAIT_L(0); PG8_BAR; PG8_MMA(0, 0, At, B0); PG8_MMA(0, 1, At, B1); PG8_BAR; PG8_SCHED;
            PG8_LDA(At, 0, 1); PG8_STAGE(PG8_SB(0, 0), b2, voffB); PG8_STAGE(PG8_SB(0, 1), b2 + hstep, voffB); PG8_STAGE(PG8_SA(0, 0), a2, voffA);
            PG8_WAIT_V(8); PG8_WAIT_L(0); PG8_BAR; PG8_MMA(1, 0, At, B0); PG8_MMA(1, 1, At, B1); PG8_BAR; PG8_SCHED;
            PG8_LDB(B0, 1, 0); PG8_LDB(B1, 1, 1); PG8_SCHED; PG8_LDA(At, 1, 0); PG8_STAGE(PG8_SA(0, 1), a2 + hstep, voffA);
            PG8_WAIT_V(8); PG8_WAIT_L(0); PG8_BAR; PG8_MMA(0, 0, At, B0); PG8_MMA(0, 1, At, B1); PG8_BAR; PG8_SCHED;
            PG8_LDA(At, 1, 1); PG8_STAGE(PG8_SB(1, 0), b3, voffB); PG8_STAGE(PG8_SB(1, 1), b3 + hstep, voffB); PG8_STAGE(PG8_SA(1, 0), a3, voffA);
            PG8_WAIT_V(8); PG8_WAIT_L(0); PG8_BAR; PG8_MMA(1, 0, At, B0); PG8_MMA(1, 1, At, B1); PG8_BAR; PG8_SCHED;
            } else {
            PG8_LDB(B0, 0, 0); PG8_SCHED; PG8_LDA(At, 0, 0); PG8_STAGE(PG8_SA(1, 1), a1 + hstep, voffA);
            PG8_WAIT_L(8); PG8_BAR; PG8_WAIT_L(0); PG8_MMA(0, 0, At, B0); PG8_BAR; PG8_SCHED;
            PG8_LDB(B1, 0, 1); PG8_STAGE(PG8_SB(0, 0), b2, voffB);
            PG8_BAR; PG8_WAIT_L(0); PG8_MMA(0, 1, At, B1); PG8_BAR;
            PG8_LDA(At, 0, 1); PG8_STAGE(PG8_SA(0, 0), a2, voffA);
            PG8_BAR; PG8_WAIT_L(0); PG8_MMA(1, 0, At, B0); PG8_BAR; PG8_SCHED;
            PG8_STAGE(PG8_SB(0, 1), b2 + hstep, voffB);
            PG8_WAIT_V(6); PG8_BAR; PG8_MMA(1, 1, At, B1); PG8_BAR;
            PG8_LDB(B0, 1, 0); PG8_SCHED; PG8_LDA(At, 1, 0); PG8_STAGE(PG8_SA(0, 1), a2 + hstep, voffA);
            PG8_WAIT_L(8); PG8_BAR; PG8_WAIT_L(0); PG8_MMA(0, 0, At, B0); PG8_BAR; PG8_SCHED;
            PG8_LDB(B1, 1, 1); PG8_STAGE(PG8_SB(1, 0), b3, voffB);
            PG8_BAR; PG8_WAIT_L(0); PG8_MMA(0, 1, At, B1); PG8_BAR;
            PG8_LDA(At, 1, 1); PG8_STAGE(PG8_SA(1, 0), a3, voffA);
            PG8_BAR; PG8_WAIT_L(0); PG8_MMA(1, 0, At, B0); PG8_BAR; PG8_SCHED;
            PG8_STAGE(PG8_SB(1, 1), b3 + hstep, voffB);
            PG8_WAIT_V(6); PG8_BAR; PG8_MMA(1, 1, At, B1); PG8_BAR;
            }
        }
        if constexpr (ALIGN_EPI) { if (wr == 0) PG8_BAR; }
        if constexpr (!Epi::AFTER_DRAIN) { E(acc, cur, wr, wc, fr, fq); S.done(cur); }
        if (!has_next) break;
#pragma unroll
        for (int a = 0; a < 2; ++a)
#pragma unroll
            for (int b = 0; b < 2; ++b)
#pragma unroll
                for (int m = 0; m < 4; ++m)
#pragma unroll
                    for (int n = 0; n < 2; ++n) acc[a][b][m][n] = (f32x4){0.f, 0.f, 0.f, 0.f};
        cur = nxt; cA = nA; cB = nB; ++ui;
        if constexpr (ALIGN_EPI) { if (wr == 1) PG8_BAR; }
    }
    PG8_WAIT_V(0);
    if constexpr (!ALIGN_EPI) { if (wr == 0) PG8_BAR; }
    PG8_BAR;
    if constexpr (Epi::AFTER_DRAIN) { E.fused(acc, cur, wr, wc, fr, fq, lds, wid, lane); S.done(cur); }
#undef PG8_SA
#undef PG8_SB
#undef PG8_STAGE
#undef PG8_LDA
#undef PG8_LDB
#undef PG8_MMA
#undef PG8_WAIT_V
#undef PG8_WAIT_L
#undef PG8_BAR
#undef PG8_SCHED
}
}

#define LAS __attribute__((address_space(3)))
using pg8::bf16_t; using pg8::bf16x8; using pg8::f32x4; using pg8::u32x4; using pg8::Unit;
typedef float f32x16 __attribute__((ext_vector_type(16)));
typedef float f32x2_t __attribute__((ext_vector_type(2)));
typedef __bf16 bf16x2_t __attribute__((ext_vector_type(2)));
typedef unsigned u32x2 __attribute__((ext_vector_type(2)));
#define MFMA32(a, b, c) __builtin_amdgcn_mfma_f32_32x32x16_bf16((a), (b), (c), 0, 0, 0)

constexpr int BATCH = 4, SEQ = 8192, DM = 1024, MTOK = BATCH * SEQ, FF = 4096, NQKV0 = 3072, NQKV1 = 2304, D1 = 768;
constexpr float ALPHA = 1.41421356237309505f, LN_EPS = 1e-5f, QSCALE = 0.125f * 1.4426950408889634f;
constexpr int NWAVES = 8, NTHR = 512;
constexpr int LIST_CAP = 126976;

constexpr size_t MiB = 1u << 20;
constexpr size_t WS_CTL = 0, CTL_BYTES = 2 * MiB;
constexpr size_t WS_KM = 128 * 1024, WS_BAR = 16 * 1024;
constexpr size_t WS_COS = 505 * MiB, WS_SIN = 506 * MiB;
constexpr size_t WS_C12 = 640 * 1024, WS_ST = 1 * MiB;
constexpr int NC12 = 4096 + 4096 + 2304, C_WIN0 = 0, C_WIN1 = 4096, C_QKV1 = 8192;
constexpr size_t WS_WQKV0 = 3 * MiB, WS_WO0 = 9 * MiB, WS_WQKV1 = 11 * MiB, WS_WO1 = 15 * MiB + 512 * 1024, WS_WIN0 = 17 * MiB, WS_WOUT0 = 25 * MiB, WS_WIN1 = 33 * MiB, WS_WOUT1 = 41 * MiB;
constexpr size_t WS_HB = 49 * MiB;
constexpr size_t WS_Q = 113 * MiB, WS_K = 177 * MiB, WS_VT = 241 * MiB, WS_PO = 305 * MiB, WS_PL = 497 * MiB;
constexpr size_t WS_H = 113 * MiB, WS_Z = 369 * MiB, WS_HB2 = 433 * MiB;
constexpr size_t WS_Q1 = 113 * MiB, WS_K1 = 161 * MiB, WS_VT1 = 209 * MiB, WS_PO1 = 257 * MiB, WS_PL1 = 305 * MiB;
constexpr size_t WS_DUMP = 401 * MiB, WS_END = 507 * MiB;
constexpr size_t OUT_PO3 = 0, OUT_LIST = 64 * MiB;

#ifndef DUPU
#define DUPU 1
#endif
#ifndef DUPQ0
#define DUPQ0 1
#endif
#ifndef DUPQ1
#define DUPQ1 1
#endif
#ifndef DUPG
#define DUPG 1
#endif
#ifndef G_ALIGN
#define G_ALIGN true
#endif
#ifndef G_SP2
#define G_SP2 true
#endif
#ifndef PHM
#define PHM 0xFFFFFFFFu
#endif
constexpr int RING_BYTES = 131072, LDS_BYTES = 147456, LDS_MISC = LDS_BYTES - 1024;

__device__ __forceinline__ unsigned pk2(float lo, float hi) { f32x2_t v = {lo, hi}; bf16x2_t b = __builtin_convertvector(v, bf16x2_t); return __builtin_bit_cast(unsigned, b); }
__device__ __forceinline__ float bf_lo(unsigned u) { return __uint_as_float(u << 16); }
__device__ __forceinline__ float bf_hi(unsigned u) { return __uint_as_float(u & 0xffff0000u); }
__device__ __forceinline__ int crow(int i, int hh) { return (i & 3) + 8 * (i >> 2) + 4 * hh; }
__device__ __forceinline__ float wave_sum(float v) {
#pragma unroll
    for (int o = 1; o < 64; o <<= 1) v += __shfl_xor(v, o);
    return v;
}
#define LDS_WAIT() asm volatile("s_waitcnt lgkmcnt(0)" ::: "memory")
__device__ __forceinline__ int qkv_phys(int c) { return (c & ~255) + ((c & 32) ? 128 : 0) + (((c >> 6) & 3) << 5) + (c & 31); }
__device__ __forceinline__ int swz16(int r) { return (r & ~12) | ((r & 4) << 1) | ((r & 8) >> 1); }

#define ROW_STATS(st_, row_, mu_, rs_) do { const f32x2_t sv_ = *(const f32x2_t*)((st_) + (size_t)(row_) * 2); (mu_) = sv_.x * (1.0f / DM); (rs_) = 1.0f / sqrtf(sv_.y * (1.0f / DM) - (mu_) * (mu_) + LN_EPS); } while (0)
template <int LAYER> struct EpiQKV {
    static constexpr bool PERM = true, AFTER_DRAIN = false;
    bf16_t* Q; bf16_t* Kb; bf16_t* VT; float* KM; const float* cs; const float* sn; const float* st; const float* c1; const float* c2;
    __device__ __forceinline__ void operator()(const f32x4 (&acc)[2][2][4][2], const Unit& u, int wr, int wc, int fr, int fq) const {
        constexpr int NT = LAYER == 0 ? 4 : 3, PITCH = NT * 256, NH = NT * 4;
        const int which = u.pn / NT, hg = u.pn - which * NT, head = hg * 4 + wc, e0 = 8 * fq;
        const int dsh = LAYER == 0 ? 0 : 2 * hg;
        const int rowb = u.pm * 256 + wr * 64 + fr;
        f32x4 c1v[2][2], c2v[2][2]; f32x2_t svc = {0.f, 0.f}, svn = {0.f, 0.f};
        if (LAYER == 1) {
#pragma unroll
            for (int bj = 0; bj < 2; ++bj)
#pragma unroll
                for (int n = 0; n < 2; ++n) { const int cc = u.pn * 256 + bj * 128 + wc * 32 + e0 + 4 * n; c1v[bj][n] = *(const f32x4*)(c1 + cc); c2v[bj][n] = *(const f32x4*)(c2 + cc); }
            svc = *(const f32x2_t*)(st + (size_t)rowb * 2);
        }
#define QKV_AFF(a_, bj_, n_) (LAYER == 1 ? ((a_) - mu * c1v[bj_][n_]) * rstd + c2v[bj_][n_] : (a_))
        if (which < 2) {
            bf16_t* dst = which == 0 ? Q : Kb; const float sc = which == 0 ? QSCALE : 1.f;
            f32x4 ks[2][2];
#pragma unroll
            for (int a = 0; a < 2; ++a)
#pragma unroll
                for (int b = 0; b < 2; ++b) ks[a][b] = (f32x4){0.f, 0.f, 0.f, 0.f};
            f32x4 tc[4], tn[4];
            { const int t = rowb & 8191; tc[0] = *(const f32x4*)(cs + t * 32 + e0); tc[1] = *(const f32x4*)(cs + t * 32 + e0 + 4); tc[2] = *(const f32x4*)(sn + t * 32 + e0); tc[3] = *(const f32x4*)(sn + t * 32 + e0 + 4); }
#pragma unroll
            for (int q = 0; q < 8; ++q) {
                const int ai = q >> 2, m = q & 3;
                const int row = rowb + ai * 128 + m * 16, b = row >> 13, t = row & 8191;
                if (q + 1 < 8) { const int t2 = (rowb + ((q + 1) >> 2) * 128 + ((q + 1) & 3) * 16) & 8191;
                    tn[0] = *(const f32x4*)(cs + t2 * 32 + e0); tn[1] = *(const f32x4*)(cs + t2 * 32 + e0 + 4); tn[2] = *(const f32x4*)(sn + t2 * 32 + e0); tn[3] = *(const f32x4*)(sn + t2 * 32 + e0 + 4);
                    if (LAYER == 1) svn = *(const f32x2_t*)(st + (size_t)(rowb + ((q + 1) >> 2) * 128 + ((q + 1) & 3) * 16) * 2); }
                const int rr = ((t & ((1 << dsh) - 1)) << (13 - dsh)) | (t >> dsh);
                const f32x4 c0 = tc[0], c1_ = tc[1], s0 = tc[2], s1 = tc[3];
                const float mu = LAYER == 1 ? svc.x * (1.0f / DM) : 0.f, rstd = LAYER == 1 ? 1.0f / sqrtf(svc.y * (1.0f / DM) - mu * mu + LN_EPS) : 1.f;
                const f32x4 x1a = QKV_AFF(acc[ai][0][m][0], 0, 0), x1b = QKV_AFF(acc[ai][0][m][1], 0, 1), x2a = QKV_AFF(acc[ai][1][m][0], 1, 0), x2b = QKV_AFF(acc[ai][1][m][1], 1, 1);
                const f32x4 o1a = (x1a * c0 - x2a * s0) * sc, o1b = (x1b * c1_ - x2b * s1) * sc, o2a = (x2a * c0 + x1a * s0) * sc, o2b = (x2b * c1_ + x1b * s1) * sc;
                bf16_t* p = dst + (size_t)(b * 8192 + rr) * PITCH + head * 64 + e0;
                u32x4 w; w.x = pk2(o1a[0], o1a[1]); w.y = pk2(o1a[2], o1a[3]); w.z = pk2(o1b[0], o1b[1]); w.w = pk2(o1b[2], o1b[3]);
                *(u32x4*)p = w;
                w.x = pk2(o2a[0], o2a[1]); w.y = pk2(o2a[2], o2a[3]); w.z = pk2(o2b[0], o2b[1]); w.w = pk2(o2b[2], o2b[3]);
                *(u32x4*)(p + 32) = w;
                if (LAYER == 0 && which == 1) { ks[0][0] += o1a; ks[0][1] += o1b; ks[1][0] += o2a; ks[1][1] += o2b; }
                asm volatile("" ::: "memory");
#pragma unroll
                for (int k = 0; k < 4; ++k) tc[k] = tn[k];
                svc = svn;
            }
            if (LAYER == 0 && which == 1) {
                const int b = u.pm >> 5, blk = u.pm & 31;
                float* kmp = KM + ((size_t)((b * 16 + head) * 32 + blk)) * 64; float kmv = 0.f;
#pragma unroll
                for (int a = 0; a < 2; ++a)
#pragma unroll
                    for (int n = 0; n < 2; ++n)
#pragma unroll
                        for (int i = 0; i < 4; ++i) {
                            float v = ks[a][n][i];
                            v += __shfl_xor(v, 1); v += __shfl_xor(v, 2); v += __shfl_xor(v, 4); v += __shfl_xor(v, 8);
                            if (fr == a * 8 + n * 4 + i) kmv = v;
                        }
                __hip_atomic_fetch_add(kmp + (fr >> 3) * 32 + e0 + (fr & 7), kmv * (1.0f / 256.0f), __ATOMIC_RELAXED, __HIP_MEMORY_SCOPE_AGENT);
            }
        } else {
#pragma unroll
            for (int q = 0; q < 8; ++q) {
                const int ai = q >> 2, m = q & 3;
                const int row = rowb + ai * 128 + m * 16, b = row >> 13, t = row & 8191;
                const int rr = ((t & ((1 << dsh) - 1)) << (13 - dsh)) | (t >> dsh);
                bf16_t* p = VT + ((size_t)(b * NH + head) * 64 + e0) * 8192 + swz16(rr);
                if (LAYER == 1 && q + 1 < 8) svn = *(const f32x2_t*)(st + (size_t)(rowb + ((q + 1) >> 2) * 128 + ((q + 1) & 3) * 16) * 2);
                const float mu = LAYER == 1 ? svc.x * (1.0f / DM) : 0.f, rstd = LAYER == 1 ? 1.0f / sqrtf(svc.y * (1.0f / DM) - mu * mu + LN_EPS) : 1.f;
#pragma unroll
                for (int bj = 0; bj < 2; ++bj)
#pragma unroll
                    for (int n = 0; n < 2; ++n) { const f32x4 yv = QKV_AFF(acc[ai][bj][m][n], bj, n);
#pragma unroll
                        for (int i = 0; i < 4; ++i) p[(size_t)(bj * 32 + 4 * n + i) * 8192] = (bf16_t)(pk2(yv[i], 0.f) & 0xffffu); }
                svc = svn;
            }
        }
#undef QKV_AFF
    }
};
struct EpiSqRelu {
    static constexpr bool PERM = true, AFTER_DRAIN = false;
    bf16_t* O; int ldc; const float* st; const float* c1; const float* c2;
    __device__ __forceinline__ void operator()(const f32x4 (&acc)[2][2][4][2], const Unit& u, int wr, int wc, int fr, int fq) const {
        const int row0 = u.pm * 256 + wr * 64 + fr, col0 = u.pn * 256 + wc * 32 + 8 * fq;
        f32x4 c1v[2][2], c2v[2][2]; float mus[8], rss[8];
#pragma unroll
        for (int bj = 0; bj < 2; ++bj)
#pragma unroll
            for (int n = 0; n < 2; ++n) { c1v[bj][n] = *(const f32x4*)(c1 + col0 + bj * 128 + 4 * n); c2v[bj][n] = *(const f32x4*)(c2 + col0 + bj * 128 + 4 * n); }
#pragma unroll
        for (int q = 0; q < 8; ++q) ROW_STATS(st, row0 + (q >> 2) * 128 + (q & 3) * 16, mus[q], rss[q]);
#pragma unroll
        for (int ai = 0; ai < 2; ++ai)
#pragma unroll
            for (int m = 0; m < 4; ++m) { const int row = row0 + ai * 128 + m * 16; bf16_t* rowp = O + (size_t)row * ldc + col0;
                const float mu = mus[ai * 4 + m], rstd = rss[ai * 4 + m];
#pragma unroll
                for (int bj = 0; bj < 2; ++bj) { f32x4 v0 = (acc[ai][bj][m][0] - mu * c1v[bj][0]) * rstd + c2v[bj][0], v1 = (acc[ai][bj][m][1] - mu * c1v[bj][1]) * rstd + c2v[bj][1];
#pragma unroll
                    for (int i = 0; i < 4; ++i) { const float a = fmaxf(v0[i], 0.f), b = fmaxf(v1[i], 0.f); v0[i] = a * a; v1[i] = b * b; }
                    u32x4 w; w.x = pk2(v0[0], v0[1]); w.y = pk2(v0[2], v0[3]); w.z = pk2(v1[0], v1[1]); w.w = pk2(v1[2], v1[3]);
                    __builtin_nontemporal_store(w, (u32x4*)(rowp + bj * 128)); } }
    }
};
template <int MODE> struct EpiResid {
    static constexpr bool PERM = true, AFTER_DRAIN = false;
    const bf16_t* R; bf16_t* Z; const float* stp; float* stc; const float* g; const float* b;
    __device__ __forceinline__ void operator()(const f32x4 (&acc)[2][2][4][2], const Unit& u, int wr, int wc, int fr, int fq) const {
        const int row0 = u.pm * 256 + wr * 64 + fr, col0 = u.pn * 256 + wc * 32 + 8 * fq;
        const bf16_t* src = MODE == 1 ? (const bf16_t*)Z : R;
        f32x4 gv[2][2], bv[2][2]; f32x2_t svc = {0.f, 0.f}, svn = {0.f, 0.f};
        u32x4 rc[2], rn[2]; float sq[8];
#define RES_LD(p_) (MODE == 0 ? __builtin_nontemporal_load((const u32x4*)(p_)) : *(const u32x4*)(p_))
        rc[0] = RES_LD(src + (size_t)row0 * DM + col0); rc[1] = RES_LD(src + (size_t)row0 * DM + col0 + 128);
        if (MODE == 1) {
#pragma unroll
            for (int bj = 0; bj < 2; ++bj)
#pragma unroll
                for (int n = 0; n < 2; ++n) { gv[bj][n] = *(const f32x4*)(g + col0 + bj * 128 + 4 * n); bv[bj][n] = *(const f32x4*)(b + col0 + bj * 128 + 4 * n); }
            svc = *(const f32x2_t*)(stp + (size_t)row0 * 2);
        }
#pragma unroll
        for (int q = 0; q < 8; ++q) {
            const int ai = q >> 2, m = q & 3, row = row0 + ai * 128 + m * 16; const size_t off = (size_t)row * DM + col0;
            if (q + 1 < 8) { const int row2 = row0 + ((q + 1) >> 2) * 128 + ((q + 1) & 3) * 16; const size_t off2 = (size_t)row2 * DM + col0; rn[0] = RES_LD(src + off2); rn[1] = RES_LD(src + off2 + 128);
                if (MODE == 1) svn = *(const f32x2_t*)(stp + (size_t)row2 * 2); }
            const float mu = MODE == 1 ? svc.x * (1.0f / DM) : 0.f, rstd = MODE == 1 ? 1.0f / sqrtf(svc.y * (1.0f / DM) - mu * mu + LN_EPS) : 1.f;
            float s1 = 0.f, s2 = 0.f;
#pragma unroll
            for (int bj = 0; bj < 2; ++bj) { const u32x4 rv = rc[bj];
                f32x4 h0 = (f32x4){bf_lo(rv.x), bf_hi(rv.x), bf_lo(rv.y), bf_hi(rv.y)}, h1 = (f32x4){bf_lo(rv.z), bf_hi(rv.z), bf_lo(rv.w), bf_hi(rv.w)};
                if (MODE == 1) { h0 = (h0 - mu) * rstd * gv[bj][0] + bv[bj][0]; h1 = (h1 - mu) * rstd * gv[bj][1] + bv[bj][1]; }
                const f32x4 z0 = ALPHA * h0 + acc[ai][bj][m][0], z1 = ALPHA * h1 + acc[ai][bj][m][1];
                u32x4 w; w.x = pk2(z0[0], z0[1]); w.y = pk2(z0[2], z0[3]); w.z = pk2(z1[0], z1[1]); w.w = pk2(z1[2], z1[3]);
                *(u32x4*)(Z + off + bj * 128) = w;
                const float r0 = bf_lo(w.x), r1 = bf_hi(w.x), r2 = bf_lo(w.y), r3 = bf_hi(w.y), r4 = bf_lo(w.z), r5 = bf_hi(w.z), r6 = bf_lo(w.w), r7 = bf_hi(w.w);
                s1 += ((r0 + r1) + (r2 + r3)) + ((r4 + r5) + (r6 + r7));
                s2 += ((r0 * r0 + r1 * r1) + (r2 * r2 + r3 * r3)) + ((r4 * r4 + r5 * r5) + (r6 * r6 + r7 * r7)); }
            s1 += __shfl_xor(s1, 16); s1 += __shfl_xor(s1, 32); s2 += __shfl_xor(s2, 16); s2 += __shfl_xor(s2, 32);
            sq[q] = (fq & 1) ? s2 : s1;
            asm volatile("" ::: "memory");
            rc[0] = rn[0]; rc[1] = rn[1]; svc = svn;
        }
#pragma unroll
        for (int p = 0; p < 4; ++p) {
            const int qa = 2 * p, qb = 2 * p + 1;
            const float val = (fq < 2) ? sq[qa] : sq[qb];
            const int rowp = row0 + ((fq < 2) ? ((qa >> 2) * 128 + (qa & 3) * 16) : ((qb >> 2) * 128 + (qb & 3) * 16));
            __hip_atomic_fetch_add(stc + (size_t)rowp * 2 + (fq & 1), val, __ATOMIC_RELAXED, __HIP_MEMORY_SCOPE_AGENT);
        }
    }
};

template <bool PERMQ, bool SCALED> __device__ __forceinline__ void transpose_item(const float* W, int K, int N, bf16_t* WT, LAS float* scr, int item, int lane, const float* gk, const float* bk, float* c1, float* c2) {
    const int nblk = N / 32, kb = item / nblk, nb = item % nblk, k0 = 64 * kb, n0 = 32 * nb;
    float p1 = 0.f, p2 = 0.f;
#pragma unroll 8
    for (int i = 0; i < 32; ++i) { const int kk = 2 * i + (lane >> 5); float v = __builtin_nontemporal_load(W + (size_t)(k0 + kk) * N + n0 + (lane & 31));
        if (SCALED) { p2 += v * bk[k0 + kk]; v *= gk[k0 + kk]; p1 += bf_lo(pk2(v, 0.f)); }
        scr[kk * 33 + (lane & 31)] = v; }
    LDS_WAIT();
    if (SCALED) { p1 += __shfl_xor(p1, 32); p2 += __shfl_xor(p2, 32);
        if (lane < 32) { const int oc = PERMQ ? qkv_phys(n0 + lane) : (n0 + lane); __hip_atomic_fetch_add(c1 + oc, p1, __ATOMIC_RELAXED, __HIP_MEMORY_SCOPE_AGENT); __hip_atomic_fetch_add(c2 + oc, p2, __ATOMIC_RELAXED, __HIP_MEMORY_SCOPE_AGENT); } }
    const int c = lane & 7;
#pragma unroll
    for (int j = 0; j < 4; ++j) { const int n = (lane >> 3) + 8 * j; const LAS float* sp = scr + (8 * c) * 33 + n;
        u32x4 o; o.x = pk2(sp[0 * 33], sp[1 * 33]); o.y = pk2(sp[2 * 33], sp[3 * 33]); o.z = pk2(sp[4 * 33], sp[5 * 33]); o.w = pk2(sp[6 * 33], sp[7 * 33]);
        const int orow = PERMQ ? qkv_phys(n0 + n) : (n0 + n);
        *(u32x4*)(WT + (size_t)orow * K + k0 + 8 * c) = o; }
    LDS_WAIT();
}

template <bool F32OUT> __device__ __forceinline__ void ln_phase(const bf16_t* Z, const float* g, const float* bt, bf16_t* ob, float* of, int gw, int ngw, int lane) {
    f32x4 gv[4], bv[4];
#pragma unroll
    for (int q = 0; q < 2; ++q) { gv[2 * q] = *(const f32x4*)(g + 512 * q + 8 * lane); gv[2 * q + 1] = *(const f32x4*)(g + 512 * q + 8 * lane + 4);
                                  bv[2 * q] = *(const f32x4*)(bt + 512 * q + 8 * lane); bv[2 * q + 1] = *(const f32x4*)(bt + 512 * q + 8 * lane + 4); }
    for (int row = gw; row < MTOK; row += ngw) {
        const bf16_t* zr = Z + (size_t)row * DM + 8 * lane;
        const u32x4 a = __builtin_nontemporal_load((const u32x4*)zr), b = __builtin_nontemporal_load((const u32x4*)(zr + 512));
        float v[16] = {bf_lo(a.x), bf_hi(a.x), bf_lo(a.y), bf_hi(a.y), bf_lo(a.z), bf_hi(a.z), bf_lo(a.w), bf_hi(a.w),
                       bf_lo(b.x), bf_hi(b.x), bf_lo(b.y), bf_hi(b.y), bf_lo(b.z), bf_hi(b.z), bf_lo(b.w), bf_hi(b.w)};
        float s = 0.f;
#pragma unroll
        for (int i = 0; i < 16; ++i) s += v[i];
        const float mean = wave_sum(s) * (1.0f / DM);
        float q = 0.f;
#pragma unroll
        for (int i = 0; i < 16; ++i) { v[i] -= mean; q += v[i] * v[i]; }
        const float rstd = 1.0f / sqrtf(wave_sum(q) * (1.0f / DM) + LN_EPS);
#pragma unroll
        for (int i = 0; i < 16; ++i) v[i] = v[i] * rstd * gv[i >> 2][i & 3] + bv[i >> 2][i & 3];
        if (F32OUT) {
            float* orow = of + (size_t)row * DM + 8 * lane;
            __builtin_nontemporal_store((f32x4){v[0], v[1], v[2], v[3]}, (f32x4*)orow); __builtin_nontemporal_store((f32x4){v[4], v[5], v[6], v[7]}, (f32x4*)(orow + 4));
            __builtin_nontemporal_store((f32x4){v[8], v[9], v[10], v[11]}, (f32x4*)(orow + 512)); __builtin_nontemporal_store((f32x4){v[12], v[13], v[14], v[15]}, (f32x4*)(orow + 516));
        } else {
            bf16_t* orow = ob + (size_t)row * DM + 8 * lane;
            u32x4 w; w.x = pk2(v[0], v[1]); w.y = pk2(v[2], v[3]); w.z = pk2(v[4], v[5]); w.w = pk2(v[6], v[7]); *(u32x4*)orow = w;
            w.x = pk2(v[8], v[9]); w.y = pk2(v[10], v[11]); w.z = pk2(v[12], v[13]); w.w = pk2(v[14], v[15]); *(u32x4*)(orow + 512) = w;
        }
    }
}

constexpr int KPB = 144;
template <int NKT, int MODE, int GT>
__device__ __forceinline__ void attn_rows(const LAS unsigned char* Kl, const LAS unsigned char* Vl, const int vpb, const bf16x8 (&qf)[4], const int r, const int hh, const int p0, const int p1,
                                          f32x16 (&o)[2], float& lse2) {
    constexpr int NG = (NKT + GT - 1) / GT;
    float mrun = -INFINITY, lrun = 0.f;
#pragma unroll
    for (int i = 0; i < 16; ++i) { o[0][i] = 0.f; o[1][i] = 0.f; }
#pragma unroll
    for (int grp = 0; grp < NG; ++grp) {
        constexpr int dummy = 0; (void)dummy;
        const int kt0 = grp * GT;
        const int nt = (NKT - kt0) < GT ? (NKT - kt0) : GT;
        const bool gact = MODE == 0 ? true : (MODE == 1 ? (kt0 <= p0) : (p1 != 0 || (p0 + kt0 + nt - 1 >= 4)));
        if (gact) {
            bf16x8 kf[GT][4];
#pragma unroll
            for (int q = 0; q < GT; ++q)
#pragma unroll
                for (int ks = 0; ks < 4; ++ks) if (q < nt) kf[q][ks] = *(const LAS bf16x8*)(Kl + ((kt0 + q) * 32 + r) * KPB + ks * 32 + hh * 16);
            f32x16 s[GT];
#pragma unroll
            for (int q = 0; q < GT; ++q)
#pragma unroll
                for (int i = 0; i < 16; ++i) s[q][i] = 0.f;
#pragma unroll
            for (int ks = 0; ks < 4; ++ks)
#pragma unroll
                for (int q = 0; q < GT; ++q) if (q < nt) s[q] = MFMA32(kf[q][ks], qf[ks], s[q]);
            bf16x8 vf[GT][2][2];
#pragma unroll
            for (int q = 0; q < GT; ++q)
#pragma unroll
                for (int s2 = 0; s2 < 2; ++s2)
#pragma unroll
                    for (int dt = 0; dt < 2; ++dt) if (q < nt) vf[q][s2][dt] = *(const LAS bf16x8*)(Vl + (dt * 32 + r) * vpb + ((kt0 + q) * 32 + s2 * 16 + hh * 8) * 2);
            if (MODE == 1) { if (p0 < 8) {
#pragma unroll
                for (int q = 0; q < GT; ++q) if (q < nt) { const int lim = (p0 - (kt0 + q)) * 32 + r;
#pragma unroll
                    for (int i = 0; i < 16; ++i) if (crow(i, hh) > lim) s[q][i] = -INFINITY; } } }
            if (MODE == 2) {
#pragma unroll
                for (int q = 0; q < GT; ++q) if (q < nt) { const int kt = kt0 + q;
                    if (kt == 0) {
#pragma unroll
                        for (int i = 0; i < 16; ++i) if (crow(i, hh) < r) s[q][i] = -INFINITY; }
                    if (kt == NKT - 1) {
#pragma unroll
                        for (int i = 0; i < 16; ++i) if (crow(i, hh) > r) s[q][i] = -INFINITY; } }
                if (p1 == 0) {
#pragma unroll
                    for (int q = 0; q < GT; ++q) if (q < nt) { if (p0 + kt0 + q < 4) {
#pragma unroll
                        for (int i = 0; i < 16; ++i) s[q][i] = -INFINITY; } } }
            }
            float mx = -INFINITY;
#pragma unroll
            for (int q = 0; q < GT; ++q) if (q < nt) {
#pragma unroll
                for (int i = 0; i < 16; ++i) mx = fmaxf(mx, s[q][i]); }
            mx = fmaxf(mx, __shfl_xor(mx, 32));
            const float mnew = fmaxf(mrun, mx);
            const float sc = __builtin_amdgcn_exp2f(mrun - mnew);
            mrun = mnew; lrun *= sc;
            if (grp > 0) {
#pragma unroll
                for (int i = 0; i < 16; ++i) { o[0][i] *= sc; o[1][i] *= sc; }
            }
#pragma unroll
            for (int q = 0; q < GT; ++q) if (q < nt) {
#pragma unroll
                for (int i = 0; i < 16; ++i) { const float p = __builtin_amdgcn_exp2f(s[q][i] - mnew); s[q][i] = p; lrun += p; }
#pragma unroll
                for (int s2 = 0; s2 < 2; ++s2) {
                    u32x4 pw; pw.x = pk2(s[q][8 * s2], s[q][8 * s2 + 1]); pw.y = pk2(s[q][8 * s2 + 2], s[q][8 * s2 + 3]); pw.z = pk2(s[q][8 * s2 + 4], s[q][8 * s2 + 5]); pw.w = pk2(s[q][8 * s2 + 6], s[q][8 * s2 + 7]);
                    const bf16x8 pf = __builtin_bit_cast(bf16x8, pw);
#pragma unroll
                    for (int dt = 0; dt < 2; ++dt) o[dt] = MFMA32(vf[q][s2][dt], pf, o[dt]);
                }
            }
        }
    }
    const float l = lrun + __shfl_xor(lrun, 32);
    const float inv = 1.0f / l;
#pragma unroll
    for (int i = 0; i < 16; ++i) { o[0][i] *= inv; o[1][i] *= inv; }
    lse2 = mrun + __builtin_amdgcn_logf(l);
}
__device__ __forceinline__ void store_o(bf16_t* dst, const f32x16 (&o)[2], int hh) {
#pragma unroll
    for (int dt = 0; dt < 2; ++dt)
#pragma unroll
        for (int g4 = 0; g4 < 4; ++g4) { u32x2 w; w.x = pk2(o[dt][4 * g4], o[dt][4 * g4 + 1]); w.y = pk2(o[dt][4 * g4 + 2], o[dt][4 * g4 + 3]); *(u32x2*)(dst + dt * 32 + 8 * g4 + 4 * hh) = w; }
}

constexpr int STG_PITCH = 144, STG_WAVE = 32 * STG_PITCH;
__device__ __forceinline__ void stage_o(LAS unsigned char* stg, const f32x16 (&o)[2], int r, int hh) {
#pragma unroll
    for (int dt = 0; dt < 2; ++dt)
#pragma unroll
        for (int g4 = 0; g4 < 4; ++g4) { u32x2 w; w.x = pk2(o[dt][4 * g4], o[dt][4 * g4 + 1]); w.y = pk2(o[dt][4 * g4 + 2], o[dt][4 * g4 + 3]); *(LAS u32x2*)(stg + r * STG_PITCH + dt * 64 + g4 * 16 + hh * 8) = w; }
    LDS_WAIT();
}
constexpr int STG8_PITCH = 80; constexpr float PO8_SCALE = 16.0f;
__device__ __forceinline__ void stage_o8(LAS unsigned char* stg, const f32x16 (&o)[2], int r, int hh) {
#pragma unroll
    for (int dt = 0; dt < 2; ++dt)
#pragma unroll
        for (int g4 = 0; g4 < 4; ++g4) {
            int w = __builtin_amdgcn_cvt_pk_fp8_f32(o[dt][4 * g4] * PO8_SCALE, o[dt][4 * g4 + 1] * PO8_SCALE, 0, false);
            w = __builtin_amdgcn_cvt_pk_fp8_f32(o[dt][4 * g4 + 2] * PO8_SCALE, o[dt][4 * g4 + 3] * PO8_SCALE, w, true);
            *(LAS int*)(stg + r * STG8_PITCH + dt * 32 + g4 * 8 + hh * 4) = w; }
    LDS_WAIT();
}
#define XB_TMO      128
#define XB_XCNT(j)  (256  + 64 * (j))
#define XB_XSUB(j)  (1280 + 64 * (j))
#define XB_XGEN(j)  (2304 + 64 * (j))
#define XB_TOP      3328
#define XB_TOPGEN   3392
#define XCD_BAR_WORDS 3456
#define XB_SPIN_CAP (1u << 18)

__device__ __forceinline__ unsigned xb_ld(unsigned* p)              { return __hip_atomic_load(p, __ATOMIC_RELAXED, __HIP_MEMORY_SCOPE_AGENT); }
__device__ __forceinline__ unsigned xb_add(unsigned* p, unsigned v) { return __hip_atomic_fetch_add(p, v, __ATOMIC_RELAXED, __HIP_MEMORY_SCOPE_AGENT); }
__device__ __forceinline__ unsigned xb_xcc_id() { return (unsigned)__builtin_amdgcn_s_getreg((3 << 11) | 20) & 0xFu; }
#define XB_SPIN(cond, bar) do { unsigned _sp = 0; while (cond) { __builtin_amdgcn_s_sleep(1); \
    if ((++_sp & 255u) == 0u) { if (xb_ld(&(bar)[XB_TMO])) break; if (_sp > XB_SPIN_CAP) { atomicAdd(&(bar)[XB_TMO], 1u); break; } } } } while (0)

struct XcdBarrier {
    unsigned* bar; unsigned x;
    volatile LAS unsigned* st;
};

__device__ __forceinline__ XcdBarrier xcd_barrier_post(unsigned* bar, volatile LAS unsigned* st) {
    XcdBarrier b; b.bar = bar; b.x = xb_xcc_id(); b.st = st;
    if (threadIdx.x == 0) (void)xb_add(&bar[XB_XCNT(b.x)], 1u);
    return b;
}
__device__ __forceinline__ void xcd_barrier_complete(unsigned* bar, unsigned x, unsigned& nloc, unsigned& nx) {
    const unsigned G = gridDim.x * gridDim.y * gridDim.z;
    unsigned sum, cnt, mine, sp = 0u;
    for (;;) {
        sum = 0u; cnt = 0u; mine = 0u;
#pragma unroll
        for (unsigned j = 0; j < 16; ++j) { const unsigned c = xb_ld(&bar[XB_XCNT(j)]); sum += c; cnt += (c > 0u) ? 1u : 0u; mine = (j == x) ? c : mine; }
        if (sum == G) break;
        __builtin_amdgcn_s_sleep(1);
        if ((++sp & 255u) == 0u) { if (xb_ld(&bar[XB_TMO])) break; if (sp > XB_SPIN_CAP) { atomicAdd(&bar[XB_TMO], 1u); break; } }
    }
    nloc = mine > 0u ? mine : 1u; nx = cnt > 0u ? cnt : 1u;
}

__device__ __forceinline__ void xcd_barrier(const XcdBarrier& b) {
    asm volatile("s_waitcnt vmcnt(0)" ::: "memory");
    __syncthreads();
    if (threadIdx.x == 0) {
        unsigned* bar = b.bar;
        __builtin_amdgcn_s_waitcnt(0);
        unsigned nloc = b.st[0], nx = b.st[1];
        if (nloc == 0u) { xcd_barrier_complete(bar, b.x, nloc, nx); b.st[0] = nloc; b.st[1] = nx; }
        const unsigned old = xb_add(&bar[XB_XSUB(b.x)], 1u);
        const unsigned gen = old / nloc;
        if (old + 1u == (gen + 1u) * nloc) {
            __builtin_amdgcn_fence(__ATOMIC_RELEASE, "agent");
            asm volatile("s_waitcnt vmcnt(0)" ::: "memory");
            const unsigned og = xb_add(&bar[XB_TOP], 1u);
            const unsigned tg = og / nx;
            if (og + 1u == (tg + 1u) * nx) xb_add(&bar[XB_TOPGEN], 1u);
            else XB_SPIN(xb_ld(&bar[XB_TOPGEN]) == tg, bar);
            __builtin_amdgcn_fence(__ATOMIC_ACQUIRE, "agent");
            xb_add(&bar[XB_XGEN(b.x)], 1u);
            asm volatile("s_waitcnt vmcnt(0)" ::: "memory");
        } else {
            XB_SPIN(xb_ld(&bar[XB_XGEN(b.x)]) == gen, bar);
            __builtin_amdgcn_fence(__ATOMIC_ACQUIRE, "agent");
            asm volatile("s_waitcnt vmcnt(0)" ::: "memory");
        }
    }
    __syncthreads();
}

struct Args { const float* in[11]; float* out; unsigned char* ws; int pad0, pad1; };

__global__ void __launch_bounds__(NTHR) hybrid_fwd(Args args) {
    extern __shared__ __attribute__((aligned(16))) unsigned char lds_raw[];
    LAS unsigned char* lds = (LAS unsigned char*)lds_raw;
    cg::grid_group grid = cg::this_grid();
    int tid = threadIdx.x, lane = tid & 63, wave = __builtin_amdgcn_readfirstlane(tid >> 6);
    const int G = gridDim.x, ngw = G * NWAVES; int gw = blockIdx.x * NWAVES + wave;
    const bool xloc = (G == 256);
#define GRID_SYNC_CG() do { grid.sync(); asm volatile("" : "+v"(tid), "+v"(lane)); } while (0)
#define GRID_SYNC() do { xcd_barrier(xbar); asm volatile("" : "+v"(tid), "+v"(lane)); } while (0)
    if (tid < 2) ((LAS unsigned*)(lds + LDS_MISC + 256))[tid] = 0u;
    __syncthreads();
    const XcdBarrier xbar = xcd_barrier_post((unsigned*)(args.ws + WS_BAR), (volatile LAS unsigned*)(lds + LDS_MISC + 256));
    unsigned char* ws = args.ws;
    const float* x = args.in[0];
    bf16_t* Wqkv0 = (bf16_t*)(ws + WS_WQKV0); bf16_t* Wo0 = (bf16_t*)(ws + WS_WO0); bf16_t* Wqkv1 = (bf16_t*)(ws + WS_WQKV1); bf16_t* Wo1 = (bf16_t*)(ws + WS_WO1);
    float* cosT = (float*)(ws + WS_COS); float* sinT = (float*)(ws + WS_SIN);
    bf16_t* HB = (bf16_t*)(ws + WS_HB); bf16_t* Zb = (bf16_t*)(ws + WS_Z); bf16_t* Hm = (bf16_t*)(ws + WS_H);
    float* C1 = (float*)(ws + WS_C12); float* C2 = C1 + NC12; float* ST = (float*)(ws + WS_ST);
    unsigned* gcnt = (unsigned*)(ws + WS_CTL); float* KM = (float*)(ws + WS_KM);
    unsigned* LIST = (unsigned*)((unsigned char*)args.out + OUT_LIST); bf16_t* PO3 = (bf16_t*)((unsigned char*)args.out + OUT_PO3);

    if (PHM & 1u) {
        LAS float* scr = (LAS float*)(lds + wave * 16384);
        constexpr int I_QKV0 = (DM / 64) * (NQKV0 / 32), I_WO0 = (DM / 64) * (DM / 32), I_QKV1 = (DM / 64) * (NQKV1 / 32), I_WO1 = (D1 / 64) * (DM / 32), I_IN = (DM / 64) * (FF / 32), I_OUT = (FF / 64) * (DM / 32);
        constexpr int NITEMS = I_QKV0 + I_WO0 + I_QKV1 + I_WO1 + 2 * I_IN + 2 * I_OUT;
        for (int it = gw; it < NITEMS; it += ngw) {
            int rI = it;
            if (rI < I_QKV0) { transpose_item<true, false>(args.in[1], DM, NQKV0, Wqkv0, scr, rI, lane, nullptr, nullptr, nullptr, nullptr); continue; } rI -= I_QKV0;
            if (rI < I_WO0) { transpose_item<false, false>(args.in[2], DM, DM, Wo0, scr, rI, lane, nullptr, nullptr, nullptr, nullptr); continue; } rI -= I_WO0;
            if (rI < I_QKV1) { transpose_item<true, true>(args.in[3], DM, NQKV1, Wqkv1, scr, rI, lane, args.in[9], args.in[10], C1 + C_QKV1, C2 + C_QKV1); continue; } rI -= I_QKV1;
            if (rI < I_WO1) { transpose_item<false, false>(args.in[4], D1, DM, Wo1, scr, rI, lane, nullptr, nullptr, nullptr, nullptr); continue; } rI -= I_WO1;
            if (rI < 2 * I_IN) { const int l = rI / I_IN; transpose_item<false, true>(args.in[5] + (size_t)l * DM * FF, DM, FF, (bf16_t*)(ws + (l ? WS_WIN1 : WS_WIN0)), scr, rI - l * I_IN, lane, args.in[7] + l * DM, args.in[8] + l * DM, C1 + (l ? C_WIN1 : C_WIN0), C2 + (l ? C_WIN1 : C_WIN0)); continue; } rI -= 2 * I_IN;
            { const int l = rI / I_OUT; transpose_item<false, false>(args.in[6] + (size_t)l * DM * FF, FF, DM, (bf16_t*)(ws + (l ? WS_WOUT1 : WS_WOUT0)), scr, rI - l * I_OUT, lane, nullptr, nullptr, nullptr, nullptr); }
        }
        for (int idx = blockIdx.x * NTHR + tid; idx < SEQ * 32; idx += G * NTHR) {
            const int t = idx >> 5, e = idx & 31;
            const float inv = 1.0f / powf(10000.0f, (float)(2 * e) / 64.0f);
            const float ang = (float)t * inv;
            const double a = (double)ang, kk = rint(a * 0.15915494309189535), rd = fma(-kk, 6.283185307179586, a);
            const float rf = (float)rd;
            cosT[idx] = cosf(rf); sinT[idx] = sinf(rf);
        }
        for (int row = gw; row < MTOK; row += ngw) {
            const float* xr = x + (size_t)row * DM + 8 * lane;
            const f32x4 a0 = __builtin_nontemporal_load((const f32x4*)xr), a1 = __builtin_nontemporal_load((const f32x4*)(xr + 4)), b0 = __builtin_nontemporal_load((const f32x4*)(xr + 512)), b1 = __builtin_nontemporal_load((const f32x4*)(xr + 516));
            bf16_t* orow = HB + (size_t)row * DM + 8 * lane;
            u32x4 w; w.x = pk2(a0[0], a0[1]); w.y = pk2(a0[2], a0[3]); w.z = pk2(a1[0], a1[1]); w.w = pk2(a1[2], a1[3]); *(u32x4*)orow = w;
            w.x = pk2(b0[0], b0[1]); w.y = pk2(b0[2], b0[3]); w.z = pk2(b1[0], b1[1]); w.w = pk2(b1[2], b1[3]); *(u32x4*)(orow + 512) = w;
        }
    }
    __syncthreads();
    if (args.pad1 != 0) GRID_SYNC_CG();
    GRID_SYNC();

    bf16_t* Q0 = (bf16_t*)(ws + WS_Q); bf16_t* K0 = (bf16_t*)(ws + WS_K); bf16_t* VT0 = (bf16_t*)(ws + WS_VT); bf16_t* PO = (bf16_t*)(ws + WS_PO); float* PL = (float*)(ws + WS_PL);
    if (PHM & 2u) {
        pg8::Gemm g{HB, Wqkv0, MTOK, NQKV0, DM}; pg8::StaticOrder S; S.init(MTOK, NQKV0, G, (int)blockIdx.x);
        EpiQKV<0> E{Q0, K0, VT0, KM, cosT, sinT, nullptr, nullptr, nullptr};
        for (int repg = 0; repg < DUPG * DUPQ0; ++repg) pg8::gemm_phase<EpiQKV<0>, pg8::StaticOrder, G_ALIGN, G_SP2>(lds, g, S, E);
    }
    GRID_SYNC();
    if (PHM & 4u) {
        LAS unsigned* lcnt = (LAS unsigned*)(lds + LDS_MISC); LAS unsigned* lbase = lcnt + 32;
        const int r = lane & 31, hh = lane >> 5;
        for (int unit = blockIdx.x, uk = 0; unit < BATCH * 32 * 16; unit += G, ++uk) {
            int h = unit & 15, qb = (unit >> 4) & 31, b = unit >> 9;
            if (xloc) { const int nl = (int)(blockIdx.x >> 3) * 8 + uk, bh_ = 8 * (int)(blockIdx.x & 7) + (nl >> 5); qb = nl & 31; b = bh_ >> 4; h = bh_ & 15; }
            if (tid < 32) lcnt[tid] = 0u;
            __syncthreads();
            const int tq = qb * 256 + wave * 32 + r, token = b * 8192 + tq;
            bf16x8 qf[4];
#pragma unroll
            for (int ks = 0; ks < 4; ++ks) qf[ks] = *(const bf16x8*)(Q0 + (size_t)token * DM + h * 64 + ks * 16 + hh * 8);
            f32x16 gt;
#pragma unroll
            for (int i = 0; i < 16; ++i) gt[i] = 0.f;
            const float* kmr = KM + ((size_t)((b * 16 + h) * 32 + r)) * 64 + hh * 8;
#pragma unroll
            for (int ks = 0; ks < 4; ++ks) { const f32x4 k0 = *(const f32x4*)(kmr + ks * 16), k1 = *(const f32x4*)(kmr + ks * 16 + 4);
                u32x4 kw; kw.x = pk2(k0[0], k0[1]); kw.y = pk2(k0[2], k0[3]); kw.z = pk2(k1[0], k1[1]); kw.w = pk2(k1[2], k1[3]);
                gt = MFMA32(__builtin_bit_cast(bf16x8, kw), qf[ks], gt); }
            float v0 = -3.0e38f, v1 = -3.0e38f, v2 = -3.0e38f;
#define TOP_INS(val) do { float t_ = (val); const float a_ = fmaxf(v0, t_); t_ = fminf(v0, t_); v0 = a_; const float b_ = fmaxf(v1, t_); t_ = fminf(v1, t_); v1 = b_; v2 = fmaxf(v2, t_); } while (0)
#pragma unroll
            for (int i = 0; i < 16; ++i) { const int j = crow(i, hh); const float gv_ = j < qb ? gt[i] : -3.0e38f; TOP_INS(__uint_as_float((__float_as_uint(gv_) & ~31u) | (unsigned)j)); }
            { const float pv0 = __shfl_xor(v0, 32), pv1 = __shfl_xor(v1, 32), pv2 = __shfl_xor(v2, 32); TOP_INS(pv0); TOP_INS(pv1); TOP_INS(pv2); }
#undef TOP_INS
            const int i0 = (int)(__float_as_uint(v0) & 31u), i1 = (int)(__float_as_uint(v1) & 31u), i2 = (int)(__float_as_uint(v2) & 31u);
            const int nvalid = qb < 3 ? qb : 3;
            unsigned lp0 = 0, lp1 = 0, lp2 = 0;
            if (hh == 0) {
                if (0 < nvalid) lp0 = __hip_atomic_fetch_add(lcnt + i0, 1u, __ATOMIC_RELAXED, __HIP_MEMORY_SCOPE_WORKGROUP); else PL[((size_t)0 * MTOK + token) * 16 + h] = -INFINITY;
                if (1 < nvalid) lp1 = __hip_atomic_fetch_add(lcnt + i1, 1u, __ATOMIC_RELAXED, __HIP_MEMORY_SCOPE_WORKGROUP); else PL[((size_t)1 * MTOK + token) * 16 + h] = -INFINITY;
                if (2 < nvalid) lp2 = __hip_atomic_fetch_add(lcnt + i2, 1u, __ATOMIC_RELAXED, __HIP_MEMORY_SCOPE_WORKGROUP); else PL[((size_t)2 * MTOK + token) * 16 + h] = -INFINITY;
            }
            __syncthreads();
            if (tid < 32) { const unsigned c = lcnt[tid]; lbase[tid] = c ? __hip_atomic_fetch_add(gcnt + (b * 16 + h) * 32 + tid, c, __ATOMIC_RELAXED, __HIP_MEMORY_SCOPE_AGENT) : 0u; }
            __syncthreads();
            if (hh == 0) {
                unsigned* lst = LIST + (size_t)(b * 16 + h) * LIST_CAP;
                if (0 < nvalid) lst[256 * (31 * i0 - (i0 * (i0 - 1)) / 2) + lbase[i0] + lp0] = (unsigned)tq | (0u << 13);
                if (1 < nvalid) lst[256 * (31 * i1 - (i1 * (i1 - 1)) / 2) + lbase[i1] + lp1] = (unsigned)tq | (1u << 13);
                if (2 < nvalid) lst[256 * (31 * i2 - (i2 * (i2 - 1)) / 2) + lbase[i2] + lp2] = (unsigned)tq | (2u << 13);
            }
        }
    }
    __syncthreads();
    GRID_SYNC();
#ifndef DUP3
#define DUP3 1
#endif
#ifndef DUP10
#define DUP10 1
#endif
    for (int rep3 = 0; rep3 < DUP3; ++rep3) {
        const LAS unsigned char* Kl = lds; const LAS unsigned char* Vl = lds + 256 * KPB; constexpr int VPB = (256 + 8) * 2;
        const int r = lane & 31, hh = lane >> 5;
        bf16_t* dump = (bf16_t*)(ws + WS_DUMP) + (size_t)((blockIdx.x & 255) * NWAVES + wave) * 2048;
        u32x4 kreg[4], vreg[4];
#define P3_LOADKV(b_, h_, j_) do { _Pragma("unroll") for (int i = 0; i < 4; ++i) { const int c = tid + NTHR * i; \
            kreg[i] = __builtin_nontemporal_load((const u32x4*)(K0 + (size_t)((b_) * 8192 + (j_) * 256 + (c >> 3)) * DM + (h_) * 64 + (c & 7) * 8)); \
            vreg[i] = __builtin_nontemporal_load((const u32x4*)(VT0 + ((size_t)((b_) * 16 + (h_)) * 64 + (c >> 5)) * 8192 + (j_) * 256 + (c & 31) * 8)); } } while (0)
        LAS int* sh_n = (LAS int*)(lds + LDS_MISC + 512); LAS int* sh_order = sh_n + 32; LAS int* sh_myj = sh_order + 32; LAS int* sh_cnt = sh_myj + 32;
      for (int v = blockIdx.x; v < 256; v += G) {
        const int bh = (v & 7) * 8 + (v >> 5), q4 = (v >> 3) & 3, b = bh >> 4, h = bh & 15;
        __syncthreads();
        if (tid < 32) sh_n[tid] = 256 + (int)gcnt[bh * 32 + tid] + 128;
        __syncthreads();
        if (tid < 32) { const int nj = sh_n[tid]; int rank = 0;
            for (int i = 0; i < 32; ++i) { const int ni = sh_n[i]; rank += (ni > nj || (ni == nj && i < tid)) ? 1 : 0; }
            sh_order[rank] = tid; }
        __syncthreads();
        if (tid == 0) { int l0 = 0, l1 = 0, l2 = 0, l3 = 0, cnt = 0;
            for (int k = 0; k < 32; ++k) { const int jx = sh_order[k], w = sh_n[jx];
                int bin = 0, lm = l0; if (l1 < lm) { lm = l1; bin = 1; } if (l2 < lm) { lm = l2; bin = 2; } if (l3 < lm) { lm = l3; bin = 3; }
                l0 += bin == 0 ? w : 0; l1 += bin == 1 ? w : 0; l2 += bin == 2 ? w : 0; l3 += bin == 3 ? w : 0;
                if (bin == q4) { sh_myj[cnt] = jx; ++cnt; } }
            sh_cnt[0] = cnt; }
        __syncthreads();
        const int nit = sh_cnt[0];
        const bf16_t* Qbh = Q0 + (size_t)b * 8192 * DM + h * 64 + hh * 8;
        bf16x8 qf[4];
        if (nit > 0) { const int j0 = sh_myj[0]; P3_LOADKV(b, h, j0);
#pragma unroll
            for (int ks = 0; ks < 4; ++ks) qf[ks] = *(const bf16x8*)(Qbh + (size_t)(j0 * 256 + wave * 32 + r) * DM + ks * 16); }
#define RAW_BARRIER() do { asm volatile("s_waitcnt lgkmcnt(0)" ::: "memory"); __builtin_amdgcn_s_barrier(); asm volatile("" ::: "memory"); } while (0)
        for (int it = 0; it < nit; ++it) {
            const int j = sh_myj[it], jn = (it + 1 < nit) ? sh_myj[it + 1] : -1;
            RAW_BARRIER();
#pragma unroll
            for (int i = 0; i < 4; ++i) { const int c = tid + NTHR * i;
                *(LAS u32x4*)(lds + (c >> 3) * KPB + (c & 7) * 16) = kreg[i];
                *(LAS u32x4*)(lds + 256 * KPB + (c >> 5) * VPB + (c & 31) * 16) = vreg[i]; }
            RAW_BARRIER();
            if (jn >= 0) P3_LOADKV(b, h, jn);
#ifdef P3_PROBE_OWNONLY
            const int n = (rep3 + 1 < DUP3) ? 256 : 256 + (int)gcnt[bh * 32 + j], ngroups = (n + 31) >> 5;
#else
            const int n = 256 + (int)gcnt[bh * 32 + j], ngroups = (n + 31) >> 5;
#endif
            const unsigned* lst = LIST + (size_t)bh * LIST_CAP + 256 * (31 * j - (j * (j - 1)) / 2);
            int g = wave;
            int tq = j * 256 + g * 32 + r, slot = 3; bool valid = true;
            const int tqN = (jn >= 0 ? jn : j) * 256 + wave * 32 + r;
            unsigned en = 0u; bool vn = false;
            if (g + 8 < ngroups) { const int row = (g + 8) * 32 + r; vn = row < n; en = lst[vn ? row - 256 : 0]; }
            for (; g < ngroups; g += NWAVES) {
                bf16x8 q1[4]; int tq1 = tqN, slot1 = 3; unsigned en2 = 0u; bool vn2 = false;
                if (g + 8 < ngroups) { tq1 = (int)(en & 8191u); slot1 = (int)(en >> 13); }
#pragma unroll
                for (int ks = 0; ks < 4; ++ks) q1[ks] = *(const bf16x8*)(Qbh + (size_t)tq1 * DM + ks * 16);
                if (g + 16 < ngroups) { const int row = (g + 16) * 32 + r; vn2 = row < n; en2 = lst[vn2 ? row - 256 : 0]; }
                f32x16 o[2]; float lse2;
                attn_rows<8, 1, 2>(Kl, Vl, VPB, qf, r, hh, g < 8 ? g : 99, 0, o, lse2);
                {
                    LAS unsigned char* stg = lds + 73728 + wave * STG_WAVE;
                    stage_o8(stg, o, r, hh);
                    const int myinfo = tq | (slot << 13) | (valid ? (1 << 15) : 0);
                    {
                        const int R = lane >> 1, half = lane & 1;
                        const u32x4 v0 = *(const LAS u32x4*)(stg + R * STG8_PITCH + half * 32), v1 = *(const LAS u32x4*)(stg + R * STG8_PITCH + half * 32 + 16);
                        const int info = __shfl(myinfo, R), tqR = info & 8191, slotR = (info >> 13) & 3;
                        unsigned char* dstp = (slotR == 3 ? (unsigned char*)PO3 : (unsigned char*)PO + (size_t)slotR * MTOK * DM) + ((size_t)b * 8192 + tqR) * DM + h * 64 + half * 32;
                        if (!(info & (1 << 15))) dstp = (unsigned char*)dump + lane * 32;
                        __builtin_nontemporal_store(v0, (u32x4*)dstp); __builtin_nontemporal_store(v1, (u32x4*)(dstp + 16));
                    }
                    { float* plp = PL + ((size_t)slot * MTOK + (size_t)b * 8192 + tq) * 16 + h; if (!valid) plp = (float*)(dump + 1024) + lane; *plp = lse2; }
                }
#pragma unroll
                for (int ks = 0; ks < 4; ++ks) qf[ks] = q1[ks];
                tq = tq1; slot = slot1; valid = vn; en = en2; vn = vn2;
            }
        }
      }
#undef P3_LOADKV
#undef RAW_BARRIER
    }
    __syncthreads();
    GRID_SYNC();
    if (PHM & 16u) {
        const int head = lane >> 2, part = lane & 3;
        for (int token = gw; token < MTOK; token += ngw) {
            float ls[4], mxl = -INFINITY;
#pragma unroll
            for (int s = 0; s < 4; ++s) { ls[s] = PL[((size_t)s * MTOK + token) * 16 + head]; mxl = fmaxf(mxl, ls[s]); }
            float accv[16], den = 0.f;
#pragma unroll
            for (int i = 0; i < 16; ++i) accv[i] = 0.f;
#pragma unroll
            for (int s = 0; s < 4; ++s) {
                const float w = __builtin_amdgcn_exp2f(ls[s] - mxl);
                if (w > 0.f) {
                    den += w;
                    const unsigned char* src = (s == 3 ? (const unsigned char*)PO3 : (const unsigned char*)PO + (size_t)s * MTOK * DM) + (size_t)token * DM + head * 64 + part * 16;
                    const u32x4 a = __builtin_nontemporal_load((const u32x4*)src);
                    const float ws_ = w * (1.0f / PO8_SCALE);
#pragma unroll
                    for (int k = 0; k < 4; ++k) { const f32x2_t lo = __builtin_amdgcn_cvt_pk_f32_fp8((int)a[k], false), hi = __builtin_amdgcn_cvt_pk_f32_fp8((int)a[k], true);
                        accv[4 * k] += ws_ * lo.x; accv[4 * k + 1] += ws_ * lo.y; accv[4 * k + 2] += ws_ * hi.x; accv[4 * k + 3] += ws_ * hi.y; }
                }
            }
            const float inv = 1.0f / den;
            bf16_t* dst = Q0 + (size_t)token * DM + head * 64 + part * 16;
            u32x4 w0, w1;
            w0.x = pk2(accv[0] * inv, accv[1] * inv); w0.y = pk2(accv[2] * inv, accv[3] * inv); w0.z = pk2(accv[4] * inv, accv[5] * inv); w0.w = pk2(accv[6] * inv, accv[7] * inv);
            w1.x = pk2(accv[8] * inv, accv[9] * inv); w1.y = pk2(accv[10] * inv, accv[11] * inv); w1.z = pk2(accv[12] * inv, accv[13] * inv); w1.w = pk2(accv[14] * inv, accv[15] * inv);
            *(u32x4*)dst = w0; *(u32x4*)(dst + 8) = w1;
        }
    }
    GRID_SYNC();
    if (PHM & 32u) {
        pg8::Gemm g{Q0, Wo0, MTOK, DM, DM}; pg8::StaticOrder S; S.init(MTOK, DM, G, (int)blockIdx.x);
        EpiResid<0> E{HB, Zb, nullptr, ST, nullptr, nullptr};
        for (int repg = 0; repg < DUPG; ++repg) pg8::gemm_phase<EpiResid<0>, pg8::StaticOrder, G_ALIGN, G_SP2>(lds, g, S, E);
    }
    GRID_SYNC();
    if (PHM & 64u) {
        pg8::Gemm g{Zb, (const bf16_t*)(ws + WS_WIN0), MTOK, FF, DM}; pg8::StaticOrder S; S.init(MTOK, FF, G, (int)blockIdx.x);
        EpiSqRelu E{Hm, FF, ST, C1 + C_WIN0, C2 + C_WIN0};
        for (int repg = 0; repg < DUPG * DUPU; ++repg) pg8::gemm_phase<EpiSqRelu, pg8::StaticOrder, G_ALIGN, G_SP2>(lds, g, S, E);
    }
    GRID_SYNC();
    {
        pg8::Gemm g{Hm, (const bf16_t*)(ws + WS_WOUT0), MTOK, DM, FF}; pg8::StaticOrder S; S.init(MTOK, DM, G, (int)blockIdx.x);
        EpiResid<1> E{nullptr, Zb, ST, ST + 2 * MTOK, args.in[7], args.in[8]};
        for (int repg = 0; repg < DUPG; ++repg) pg8::gemm_phase<EpiResid<1>, pg8::StaticOrder, G_ALIGN, G_SP2>(lds, g, S, E);
    }
    GRID_SYNC();

    bf16_t* Q1 = (bf16_t*)(ws + WS_Q1); bf16_t* K1 = (bf16_t*)(ws + WS_K1); bf16_t* VT1 = (bf16_t*)(ws + WS_VT1); bf16_t* PO1 = (bf16_t*)(ws + WS_PO1); float* PL1 = (float*)(ws + WS_PL1);
    if (PHM & 128u) {
        pg8::Gemm g{Zb, Wqkv1, MTOK, NQKV1, DM}; pg8::StaticOrder S; S.init(MTOK, NQKV1, G, (int)blockIdx.x);
        EpiQKV<1> E{Q1, K1, VT1, nullptr, cosT, sinT, ST + 2 * MTOK, C1 + C_QKV1, C2 + C_QKV1};
        for (int repg = 0; repg < DUPG * DUPQ1; ++repg) pg8::gemm_phase<EpiQKV<1>, pg8::StaticOrder, G_ALIGN, G_SP2>(lds, g, S, E);
    }
    GRID_SYNC();
    for (int rep10 = 0; rep10 < DUP10; ++rep10) {
        constexpr int VPB = (384 + 8) * 2; const int r = lane & 31, hh = lane >> 5;
        u32x4 kreg[6], vreg[6];
#define P10_DECODE(unit_, pp_, head_, b_, dsh_, gb_, hp_) const int pp_ = (unit_) & 31, head_ = ((unit_) >> 5) % 12, b_ = (unit_) / (32 * 12), dsh_ = 2 * (head_ >> 2), gb_ = 2 * pp_, hp_ = ((gb_ & ((64 >> dsh_) - 1)) != 0) ? 1 : 0
#define P10_LOAD(b_, head_, gb_, hp_) do { _Pragma("unroll") for (int i = 0; i < 6; ++i) { const int c = tid + NTHR * i; \
            { const int f = c >> 3, part = c & 7; kreg[i] = (u32x4){0u, 0u, 0u, 0u}; \
              if ((hp_) || f >= 128) kreg[i] = __builtin_nontemporal_load((const u32x4*)(K1 + ((size_t)(b_) * 8192 + ((gb_) - 1) * 128 + f) * D1 + (head_) * 64 + part * 8)); } \
            { const int d = c / 48, part = c - d * 48; vreg[i] = (u32x4){0u, 0u, 0u, 0u}; \
              if ((hp_) || part >= 16) vreg[i] = __builtin_nontemporal_load((const u32x4*)(VT1 + ((size_t)((b_) * 12 + (head_)) * 64 + d) * 8192 + ((gb_) - 1) * 128 + part * 8)); } } } while (0)
#define RAW_BARRIER() do { asm volatile("s_waitcnt lgkmcnt(0)" ::: "memory"); __builtin_amdgcn_s_barrier(); asm volatile("" ::: "memory"); } while (0)
        if ((int)blockIdx.x < BATCH * 12 * 32) { P10_DECODE((int)blockIdx.x, pp0, head0, b0, dsh0, gb0, hp0); P10_LOAD(b0, head0, gb0, hp0); }
        for (int unit = blockIdx.x; unit < BATCH * 12 * 32; unit += G) {
            P10_DECODE(unit, pp, head, b, dsh, gb, hasprev);
            bf16x8 qc[4];
#pragma unroll
            for (int ks = 0; ks < 4; ++ks) qc[ks] = *(const bf16x8*)(Q1 + ((size_t)b * 8192 + gb * 128 + wave * 32 + r) * D1 + head * 64 + ks * 16 + hh * 8);
            RAW_BARRIER();
#pragma unroll
            for (int i = 0; i < 6; ++i) { const int c = tid + NTHR * i;
                *(LAS u32x4*)(lds + (c >> 3) * KPB + (c & 7) * 16) = kreg[i];
                { const int d = c / 48, part = c - d * 48; *(LAS u32x4*)(lds + 384 * KPB + d * VPB + part * 16) = vreg[i]; } }
            RAW_BARRIER();
            if (unit + G < BATCH * 12 * 32) { P10_DECODE(unit + G, ppn, headn, bn, dshn, gbn, hpn); P10_LOAD(bn, headn, gbn, hpn); }
            const int rr = gb * 128 + wave * 32 + r;
            f32x16 o[2]; float lse2;
            attn_rows<5, 2, 2>(lds + wave * 32 * KPB, lds + 384 * KPB + wave * 64, VPB, qc, r, hh, wave, hasprev, o, lse2);
            const int t = ((rr & ((8192 >> dsh) - 1)) << dsh) | (rr >> (13 - dsh));
            const size_t token = (size_t)b * 8192 + t;
            {
                LAS unsigned char* stg = lds + 384 * KPB + 64 * VPB + wave * STG_WAVE;
                stage_o(stg, o, r, hh);
#pragma unroll
                for (int i = 0; i < 4; ++i) {
                    const int R = i * 8 + (lane >> 3), chunk = lane & 7;
                    const u32x4 vrow = *(const LAS u32x4*)(stg + R * STG_PITCH + chunk * 16);
                    const int tR = __shfl(t, R);
                    *(u32x4*)(PO1 + ((size_t)b * 8192 + tR) * D1 + head * 64 + chunk * 8) = vrow;
                }
            }
            PL1[token * 12 + head] = lse2;
        }
#undef P10_DECODE
#undef P10_LOAD
#undef RAW_BARRIER
    }
    __syncthreads();
    GRID_SYNC();
    {
        const int head = lane >> 2, part = lane & 3, hs = head & 3, gsel = head >> 2;
        for (int token = gw; token < MTOK; token += ngw) {
            if (lane < 48) {
                const float l0 = PL1[(size_t)token * 12 + hs], l1 = PL1[(size_t)token * 12 + 4 + hs], l2 = PL1[(size_t)token * 12 + 8 + hs];
                const float mxl = fmaxf(l0, fmaxf(l1, l2));
                const float w0 = __builtin_amdgcn_exp2f(l0 - mxl), w1 = __builtin_amdgcn_exp2f(l1 - mxl), w2 = __builtin_amdgcn_exp2f(l2 - mxl);
                const float al = (gsel == 0 ? w0 : (gsel == 1 ? w1 : w2)) / (w0 + w1 + w2);
                bf16_t* p = PO1 + (size_t)token * D1 + head * 64 + part * 16;
                u32x4 a = *(const u32x4*)p, c = *(const u32x4*)(p + 8);
                a.x = pk2(al * bf_lo(a.x), al * bf_hi(a.x)); a.y = pk2(al * bf_lo(a.y), al * bf_hi(a.y)); a.z = pk2(al * bf_lo(a.z), al * bf_hi(a.z)); a.w = pk2(al * bf_lo(a.w), al * bf_hi(a.w));
                c.x = pk2(al * bf_lo(c.x), al * bf_hi(c.x)); c.y = pk2(al * bf_lo(c.y), al * bf_hi(c.y)); c.z = pk2(al * bf_lo(c.z), al * bf_hi(c.z)); c.w = pk2(al * bf_lo(c.w), al * bf_hi(c.w));
                *(u32x4*)p = a; *(u32x4*)(p + 8) = c;
            }
        }
    }
    GRID_SYNC();
    {
        pg8::Gemm g{PO1, Wo1, MTOK, DM, D1}; pg8::StaticOrder S; S.init(MTOK, DM, G, (int)blockIdx.x);
        EpiResid<1> E{nullptr, Zb, ST + 2 * MTOK, ST + 4 * MTOK, args.in[9], args.in[10]};
        for (int repg = 0; repg < DUPG; ++repg) pg8::gemm_phase<EpiResid<1>, pg8::StaticOrder, G_ALIGN, G_SP2>(lds, g, S, E);
    }
    GRID_SYNC();
    {
        pg8::Gemm g{Zb, (const bf16_t*)(ws + WS_WIN1), MTOK, FF, DM}; pg8::StaticOrder S; S.init(MTOK, FF, G, (int)blockIdx.x);
        EpiSqRelu E{Hm, FF, ST + 4 * MTOK, C1 + C_WIN1, C2 + C_WIN1};
        for (int repg = 0; repg < DUPG * DUPU; ++repg) pg8::gemm_phase<EpiSqRelu, pg8::StaticOrder, G_ALIGN, G_SP2>(lds, g, S, E);
    }
    GRID_SYNC();
    {
        pg8::Gemm g{Hm, (const bf16_t*)(ws + WS_WOUT1), MTOK, DM, FF}; pg8::StaticOrder S; S.init(MTOK, DM, G, (int)blockIdx.x);
        EpiResid<1> E{nullptr, Zb, ST + 4 * MTOK, ST + 6 * MTOK, args.in[7] + DM, args.in[8] + DM};
        for (int repg = 0; repg < DUPG; ++repg) pg8::gemm_phase<EpiResid<1>, pg8::StaticOrder, G_ALIGN, G_SP2>(lds, g, S, E);
    }
    GRID_SYNC();
    ln_phase<true>(Zb, args.in[9] + DM, args.in[10] + DM, nullptr, args.out, gw, ngw, lane);
}

extern "C" void kernel_launch(void* const* d_in, const int* in_sizes, int n_in, void* d_out, int out_size, void* d_ws, size_t ws_size, hipStream_t stream) {
    static int grid_blocks = 0;
    if (grid_blocks == 0) {
        if (n_in != 11 || out_size != MTOK * DM || ws_size < WS_END) { fprintf(stderr, "kernel_launch: unexpected shapes (n_in %d, out %d, ws %zu)\n", n_in, out_size, ws_size); grid_blocks = -1; return; }
        int dev = 0, cus = 0, per_cu = 0;
        hipGetDevice(&dev);
        hipDeviceGetAttribute(&cus, hipDeviceAttributeMultiprocessorCount, dev);
        if (hipFuncSetAttribute((const void*)hybrid_fwd, hipFuncAttributeMaxDynamicSharedMemorySize, LDS_BYTES) != hipSuccess) { fprintf(stderr, "kernel_launch: hipFuncSetAttribute failed\n"); }
        if (hipOccupancyMaxActiveBlocksPerMultiprocessor(&per_cu, (const void*)hybrid_fwd, NTHR, LDS_BYTES) != hipSuccess || per_cu < 1) { fprintf(stderr, "kernel_launch: occupancy query says %d blocks per CU\n", per_cu); per_cu = 1; (void)hipGetLastError(); }
        if (per_cu > 1) per_cu = 1;
        grid_blocks = cus * per_cu;
    }
    if (grid_blocks < 0) return;
    (void)hipMemsetAsync((char*)d_ws + WS_CTL, 0, CTL_BYTES, stream);
    Args a{};
    for (int i = 0; i < 11; ++i) a.in[i] = (const float*)d_in[i];
    a.out = (float*)d_out; a.ws = (unsigned char*)d_ws;
    void* kargs[] = {&a};
    hipError_t e = hipLaunchCooperativeKernel((const void*)hybrid_fwd, dim3(grid_blocks), dim3(NTHR), kargs, LDS_BYTES, stream);
    if (e != hipSuccess) fprintf(stderr, "kernel_launch: cooperative launch failed: %s (grid %d)\n", hipGetErrorString(e), grid_blocks);
}
```
